# Optimizing an MI355X kernel written in HIP

```python
import jax, jax.numpy as jnp
from jax import lax
import numpy as np

D_MODEL = 1024
BATCH = 16
SEQ = 256
DEPTH = 1
DEC_BATCH = 2
DEC_SEQ = 2048
PAST_LEN = 256

GRID_W = 64
HEAD_SIZE = 64
D_RWKV = D_MODEL // 2
N_HEADS_RWKV = D_RWKV // HEAD_SIZE
D_CONV = D_MODEL // 2
CONV_WIDTH = 3
LORA_DECAY = 64
LORA_ICLR = 64
D_FF = 2816
N_DIR = 2
N_MOD = 9
N_NORMS = 6
EPS_RMS = 1e-6
EPS_GN = 64e-5
HALF_STEP = 0.5
D_IN = 4 * D_RWKV + 3 * D_CONV + 2 * D_MODEL

kernel_name = "bidir_rwkv7_shortconv_macaron_prefix_dit_step"


def rms_norm(x, g):
    xf = x.astype(jnp.float32)
    y = xf * lax.rsqrt(jnp.mean(xf * xf, -1, keepdims=True) + EPS_RMS)
    return (y * g.astype(jnp.float32)).astype(x.dtype)


def modulate(h, shift, scale):
    return h * (1 + scale) + shift


def swiglu(h, w13, w2):
    gt, up = jnp.split(h @ w13, 2, -1)
    return (jax.nn.silu(gt) * up) @ w2


def token_shift(h, direction):
    if direction == 0:
        return jnp.pad(h[:, :-1], ((0, 0), (1, 0), (0, 0)))
    return jnp.pad(h[:, 1:], ((0, 0), (0, 1), (0, 0)))


def conv3_centred(u, w, b, axis):
    n = u.shape[axis]
    pad = [(0, 0)] * u.ndim
    pad[axis] = (1, 1)
    up = jnp.pad(u, pad)
    left = lax.slice_in_dim(up, 0, n, axis=axis)
    mid = lax.slice_in_dim(up, 1, n + 1, axis=axis)
    right = lax.slice_in_dim(up, 2, n + 2, axis=axis)
    return left * w[0] + mid * w[1] + right * w[2] + b


def rwkv7_scan(r, w, k, v, kk, a, s0, reverse):
    def step(S, inp):
        r_t, w_t, k_t, v_t, kk_t, a_t = inp
        sa = jnp.einsum('bhij,bhj->bhi', S, -kk_t)
        S = (S * w_t[:, :, None, :]
             + sa[..., None] * (kk_t * a_t)[:, :, None, :]
             + v_t[..., None] * k_t[:, :, None, :])
        return S, jnp.einsum('bhij,bhj->bhi', S, r_t)
    xs = tuple(jnp.moveaxis(t, 1, 0) for t in (r, w, k, v, kk, a))
    s_final, y = lax.scan(step, s0, xs, reverse=reverse)
    return jnp.moveaxis(y, 0, 1), s_final


def token_mixer(h, s0, p, latent):
    B, T, _ = h.shape
    H, N = N_HEADS_RWKV, HEAD_SIZE
    f32 = jnp.float32
    sizes = (D_RWKV,) * 4 + (D_CONV,) * 3 + (D_MODEL,) * 2
    idx = [int(i) for i in np.cumsum(sizes)[:-1]]
    r, k, v, g, cb, cc, xc, gate_a, gate_b = jnp.split(h @ p['w_in'], idx, -1)

    def heads(t):
        return t.astype(f32).reshape(B, T, H, N)
    r_h, k_h, v_h = heads(r), heads(k), heads(v)
    kk = k_h * p['k_k'].astype(f32).reshape(H, N)
    kk = kk * lax.rsqrt(jnp.sum(kk * kk, -1, keepdims=True) + 1e-12)
    k_a = p['k_a'].astype(f32).reshape(H, N)
    r_k = p['r_k'].astype(f32)
    mu = p['mu_shift']
    ys, finals, bonus = [], [], []
    for d in range(N_DIR):
        sh = token_shift(h, d) - h
        xw = h + mu[d, 0] * sh
        xa = h + mu[d, 1] * sh
        w_log = -jax.nn.softplus(-(p['decay_w0'][d] + jnp.tanh(xw @ p['decay_w1'][d]) @ p['decay_w2'][d]).astype(f32)) - 0.5
        decay = heads(jnp.exp(-jnp.exp(w_log)))
        a_d = heads(jax.nn.sigmoid((p['iclr_a0'][d] + (xa @ p['iclr_a1'][d]) @ p['iclr_a2'][d]).astype(f32)))
        k_d = k_h * (1 + (a_d - 1) * k_a)
        y_d, s_d = rwkv7_scan(r_h, decay, k_d, v_h, kk, a_d, s0[:, d].astype(f32), reverse=(d == 1))
        ys.append(y_d)
        finals.append(s_d)
        bonus.append(jnp.sum(r_h * k_d * r_k, -1, keepdims=True))
    y = ys[0] + ys[1]
    mean = jnp.mean(y, -1, keepdims=True)
    var = jnp.var(y, -1, keepdims=True)
    y = ((y - mean) * lax.rsqrt(var + EPS_GN)).reshape(B, T, D_RWKV)
    y = y * p['gn_gain'].astype(f32) + p['gn_bias'].astype(f32)
    y = y + ((bonus[0] + bonus[1]) * v_h).reshape(B, T, D_RWKV)
    y = y * jax.nn.sigmoid(g.astype(f32))
    y_a = y.astype(h.dtype) @ p['w_branch_a']
    new_state = jnp.stack(finals, 1)

    u = cc * xc
    if latent:
        rows = T // GRID_W
        conv = conv3_centred(u.reshape(B, rows, GRID_W, D_CONV), p['conv_w'], p['conv_b'], 2).reshape(B, T, D_CONV)
    else:
        conv = conv3_centred(u, p['conv_w'], p['conv_b'], 1)
    y_b = (cb * conv) @ p['w_branch_b']

    merged = jax.nn.sigmoid(gate_a) * y_a + jax.nn.sigmoid(gate_b) * y_b
    return merged @ p['w_out'], new_state


def trunk_layer(x, mod, s0, p, latent):
    m = jnp.split(mod, N_MOD, -1)
    gn = p['norm_g']
    h = modulate(rms_norm(x, gn[0]), m[0], m[1])
    x = x + HALF_STEP * m[2] * rms_norm(swiglu(h, p['ffn1_w13'], p['ffn1_w2']), gn[1])
    h = modulate(rms_norm(x, gn[2]), m[3], m[4])
    out, s_fin = token_mixer(h, s0, p, latent)
    x = x + m[5] * rms_norm(out, gn[3])
    h = modulate(rms_norm(x, gn[4]), m[6], m[7])
    x = x + HALF_STEP * m[8] * rms_norm(swiglu(h, p['ffn2_w13'], p['ffn2_w2']), gn[5])
    return x, s_fin


def setup_inputs(seed: int = 0) -> dict:
    key = jax.random.key(seed)
    ks = jax.random.split(key, 32)
    nrm = lambda k, shape, s: jax.random.normal(k, shape, jnp.float32) * s
    L, D = DEPTH, D_MODEL
    return {
        'x_prompt': nrm(ks[0], (BATCH, SEQ, D), 1.0),
        'x_sample': nrm(ks[1], (DEC_BATCH, DEC_SEQ, D), 1.0),
        'c': nrm(ks[2], (DEC_BATCH, D), 1.0),
        'state_rwkv': nrm(ks[3], (DEC_BATCH, L, N_DIR, N_HEADS_RWKV, HEAD_SIZE, HEAD_SIZE), 0.5),
        'c_ctx': nrm(ks[4], (D,), 1.0),
        'w_mod': nrm(ks[5], (L, D, N_MOD * D), 0.5 * D ** -0.5),
        'b_mod': nrm(ks[6], (L, N_MOD * D), 0.02),
        'norm_g': 1.0 + nrm(ks[7], (L, N_NORMS, D), 0.02),
        'ffn1_w13': nrm(ks[8], (L, D, 2 * D_FF), D ** -0.5),
        'ffn1_w2': nrm(ks[9], (L, D_FF, D), D_FF ** -0.5),
        'ffn2_w13': nrm(ks[10], (L, D, 2 * D_FF), D ** -0.5),
        'ffn2_w2': nrm(ks[11], (L, D_FF, D), D_FF ** -0.5),
        'w_in': nrm(ks[12], (L, D, D_IN), D ** -0.5),
        'mu_shift': jax.random.uniform(ks[13], (L, N_DIR, 2, D), jnp.float32),
        'decay_w0': 1.0 + nrm(ks[14], (L, N_DIR, D_RWKV), 0.5),
        'decay_w1': nrm(ks[15], (L, N_DIR, D, LORA_DECAY), 0.3 * D ** -0.5),
        'decay_w2': nrm(ks[16], (L, N_DIR, LORA_DECAY, D_RWKV), 0.3 * LORA_DECAY ** -0.5),
        'iclr_a0': nrm(ks[17], (L, N_DIR, D_RWKV), 0.3),
        'iclr_a1': nrm(ks[18], (L, N_DIR, D, LORA_ICLR), 0.3 * D ** -0.5),
        'iclr_a2': nrm(ks[19], (L, N_DIR, LORA_ICLR, D_RWKV), 0.3 * LORA_ICLR ** -0.5),
        'k_k': 0.85 + nrm(ks[20], (L, D_RWKV), 0.05),
        'k_a': 1.0 + nrm(ks[21], (L, D_RWKV), 0.05),
        'r_k': nrm(ks[22], (L, N_HEADS_RWKV, HEAD_SIZE), 0.1),
        'gn_gain': 1.0 + nrm(ks[23], (L, D_RWKV), 0.02),
        'gn_bias': nrm(ks[24], (L, D_RWKV), 0.02),
        'conv_w': nrm(ks[25], (L, CONV_WIDTH, D_CONV), CONV_WIDTH ** -0.5),
        'conv_b': nrm(ks[26], (L, D_CONV), 0.02),
        'w_branch_a': nrm(ks[27], (L, D_RWKV, D), D_RWKV ** -0.5),
        'w_branch_b': nrm(ks[28], (L, D_CONV, D), D_CONV ** -0.5),
        'w_out': nrm(ks[29], (L, D, D), D ** -0.5),
    }


def reference(x_prompt, x_sample, c, state_rwkv, c_ctx, w_mod, b_mod, norm_g,
              ffn1_w13, ffn1_w2, ffn2_w13, ffn2_w2, w_in, mu_shift,
              decay_w0, decay_w1, decay_w2, iclr_a0, iclr_a1, iclr_a2,
              k_k, k_a, r_k, gn_gain, gn_bias, conv_w, conv_b,
              w_branch_a, w_branch_b, w_out):
    y_prompt, y_sample = x_prompt, x_sample
    ctx_states = []
    for l in range(DEPTH):
        p = {
            'norm_g': norm_g[l], 'ffn1_w13': ffn1_w13[l], 'ffn1_w2': ffn1_w2[l],
            'ffn2_w13': ffn2_w13[l], 'ffn2_w2': ffn2_w2[l], 'w_in': w_in[l],
            'mu_shift': mu_shift[l], 'decay_w0': decay_w0[l], 'decay_w1': decay_w1[l],
            'decay_w2': decay_w2[l], 'iclr_a0': iclr_a0[l], 'iclr_a1': iclr_a1[l],
            'iclr_a2': iclr_a2[l], 'k_k': k_k[l], 'k_a': k_a[l], 'r_k': r_k[l],
            'gn_gain': gn_gain[l], 'gn_bias': gn_bias[l], 'conv_w': conv_w[l],
            'conv_b': conv_b[l], 'w_branch_a': w_branch_a[l], 'w_branch_b': w_branch_b[l],
            'w_out': w_out[l],
        }
        mod_ctx = (jax.nn.silu(c_ctx)[None] @ w_mod[l] + b_mod[l])[:, None, :]
        mod_lat = (jax.nn.silu(c) @ w_mod[l] + b_mod[l])[:, None, :]
        s0_ctx = jnp.zeros((y_prompt.shape[0], N_DIR, N_HEADS_RWKV, HEAD_SIZE, HEAD_SIZE), jnp.float32)
        y_prompt, s_ctx = trunk_layer(y_prompt, mod_ctx, s0_ctx, p, latent=False)
        ctx_states.append(s_ctx)
        y_sample, _ = trunk_layer(y_sample, mod_lat, state_rwkv[:, l], p, latent=True)
    new_state_rwkv = jnp.stack(ctx_states, 1)
    return (y_prompt, y_sample, new_state_rwkv)
```

```cpp
#include <hip/hip_runtime.h>
#include <hip/hip_cooperative_groups.h>
#include <cstdio>
namespace cg = cooperative_groups;

typedef unsigned short bf16_t;
typedef short bf16x8 __attribute__((ext_vector_type(8)));
typedef float f32x4 __attribute__((ext_vector_type(4)));
typedef unsigned u32x4 __attribute__((ext_vector_type(4)));
typedef unsigned u32x2 __attribute__((ext_vector_type(2)));

constexpr int DM = 1024, NTOK = 8192, NCTX = 4096, DFF = 2816, NIN = 6144, ZLD = 6144, DR = 512;
constexpr int NTHREADS = 512;
#define REPEAT_MASK 0
constexpr int LDS_STAGE = 131072;
constexpr int LDS_BYTES = LDS_STAGE + 16;

constexpr size_t SZ_W13 = (size_t)5632 * 1024 * 2, SZ_W2 = (size_t)1024 * 2816 * 2;
constexpr size_t OFF_W13A = 0;
constexpr size_t OFF_W2A = OFF_W13A + SZ_W13;
constexpr size_t OFF_W13B = OFF_W2A + SZ_W2;
constexpr size_t OFF_W2B = OFF_W13B + SZ_W13;
constexpr size_t OFF_WIN = OFF_W2B + SZ_W2;
constexpr size_t OFF_WA = OFF_WIN + (size_t)6144 * 1024 * 2;
constexpr size_t OFF_WB = OFF_WA + (size_t)1024 * 512 * 2;
constexpr size_t OFF_WO = OFF_WB + (size_t)1024 * 512 * 2;
constexpr size_t OFF_L2 = OFF_WO + (size_t)1024 * 1024 * 2;
constexpr size_t OFF_MOD = OFF_L2 + (size_t)4 * 512 * 64 * 2;
constexpr size_t OFF_BONUS = OFF_MOD + (size_t)2 * 3 * 9216 * 4;
constexpr size_t OFF_H = OFF_BONUS + (size_t)2 * 8192 * 8 * 4;
constexpr size_t OFF_R1 = OFF_H + (size_t)8192 * 1024 * 2;
constexpr size_t OFF_R2 = OFF_R1 + (size_t)8192 * 6144 * 2;
constexpr size_t OFF_BAR = OFF_R2 + (size_t)72 * 1024 * 1024;
constexpr size_t WS_END = OFF_BAR + 16384;
constexpr size_t R2_KK = 0;
constexpr size_t R2_WD = R2_KK + (size_t)8192 * 512 * 2;
constexpr size_t R2_KD = R2_WD + (size_t)2 * 8192 * 512 * 4;
constexpr size_t R2_BB = R2_KD + (size_t)2 * 8192 * 512 * 2;
constexpr size_t R2_YA = 0;
constexpr size_t R2_YB = R2_YA + (size_t)8192 * 512 * 2;
constexpr size_t R2_GA = R2_YB + (size_t)8192 * 512 * 2;
constexpr size_t R2_GB = R2_GA + (size_t)8192 * 1024 * 2;

struct Params {
    const float* in[30];
    float* out;
    char* ws;
    int phase_lo, phase_hi;
};


typedef const __attribute__((address_space(4))) Params KParams;
__device__ __forceinline__ KParams* kargs() {
    KParams* k = (KParams*)__builtin_amdgcn_kernarg_segment_ptr();
    asm volatile("" : "+s"(k));
    return k;
}

__device__ __forceinline__ int tid_l() { int t = threadIdx.x; asm volatile("" : "+v"(t)); return t; }
__device__ __forceinline__ float bf2f(unsigned short u) { return __uint_as_float(((unsigned)u) << 16); }
__device__ __forceinline__ float bflo(unsigned u) { return __uint_as_float(u << 16); }
__device__ __forceinline__ float bfhi(unsigned u) { return __uint_as_float(u & 0xffff0000u); }
__device__ __forceinline__ unsigned pk_bf16(float lo, float hi) { unsigned r; asm("v_cvt_pk_bf16_f32 %0, %1, %2" : "=v"(r) : "v"(lo), "v"(hi)); return r; }
__device__ __forceinline__ void st_wt16(void* p, u32x4 v) { asm volatile("global_store_dwordx4 %0, %1, off sc1\n\ts_nop 1" :: "v"(p), "v"(v) : "memory"); }
__device__ __forceinline__ void st_wt16f_nc(void* p, f32x4 v) { asm volatile("global_store_dwordx4 %0, %1, off sc1\n\ts_nop 1" :: "v"(p), "v"(v)); }
__device__ __forceinline__ void st_wt8_nc(void* p, u32x2 v) { asm volatile("global_store_dwordx2 %0, %1, off sc1\n\ts_nop 1" :: "v"(p), "v"(v)); }
__device__ __forceinline__ __amdgpu_buffer_rsrc_t mk_rsrc(const void* p, unsigned bytes) {
    const unsigned long long a = (unsigned long long)p;
    const unsigned lo = __builtin_amdgcn_readfirstlane((unsigned)a), hi = __builtin_amdgcn_readfirstlane((unsigned)(a >> 32));
    return __builtin_amdgcn_make_buffer_rsrc((void*)(((unsigned long long)hi << 32) | lo), (short)0, (int)bytes, 0x00020000);
}
__device__ __forceinline__ void bst16(__amdgpu_buffer_rsrc_t r, unsigned byteoff, u32x4 v) { __builtin_amdgcn_raw_buffer_store_b128(v, r, byteoff, 0, 16); }
__device__ __forceinline__ void bst8(__amdgpu_buffer_rsrc_t r, unsigned byteoff, u32x2 v) { __builtin_amdgcn_raw_buffer_store_b64(v, r, byteoff, 0, 16); }
__device__ __forceinline__ float sigm(float x) { return __builtin_amdgcn_rcpf(1.0f + __expf(-x)); }
__device__ __forceinline__ float wave_sum(float v) {
#pragma unroll
    for (int o = 32; o > 0; o >>= 1) v += __shfl_xor(v, o);
    return v;
}
template <int CTRL> __device__ __forceinline__ float dppf(float x) {
    return __int_as_float(__builtin_amdgcn_update_dpp(0, __float_as_int(x), CTRL, 0xf, 0xf, true));
}
__device__ __forceinline__ float red16(float x) {
    x += dppf<0xB1>(x);
    x += dppf<0x4E>(x);
    x += dppf<0x141>(x);
    x += dppf<0x140>(x);
    return x;
}

__device__ __forceinline__ void conv_tile_w(char* wl, const float* __restrict__ src, int src_ld, int k0, int c0,
                                            bf16_t* __restrict__ dst, int dst_ld, int n0, const float* __restrict__ mu, int mode, const int lane) {
    float v[64];
    const float* s = src + (size_t)k0 * src_ld + c0 + lane;
#pragma unroll
    for (int i = 0; i < 64; ++i) v[i] = __builtin_nontemporal_load(s + (size_t)i * src_ld);
    if (mode) {
#pragma unroll
        for (int i = 0; i < 64; ++i) { const float m = mu[k0 + i]; v[i] *= (mode == 1) ? m : (1.0f - m); }
    }
#pragma unroll
    for (int q = 0; q < 8; ++q) {
        u32x4 o;
#pragma unroll
        for (int i = 0; i < 4; ++i) o[i] = pk_bf16(v[8 * q + 2 * i], v[8 * q + 2 * i + 1]);
        *(u32x4*)(wl + lane * 144 + q * 16) = o;
    }
    asm volatile("s_waitcnt lgkmcnt(0)" ::: "memory");
    const __amdgpu_buffer_rsrc_t drsrc = mk_rsrc(dst, 0x7fffffffu);
#pragma unroll
    for (int i = 0; i < 8; ++i) {
        const int id = i * 64 + lane, r = id >> 3, ch = id & 7;
        const u32x4 o = *(const u32x4*)(wl + r * 144 + ch * 16);
        bst16(drsrc, (unsigned)(((n0 + r) * dst_ld + k0 + ch * 8) * 2), o);
    }
    asm volatile("s_waitcnt lgkmcnt(0)" ::: "memory");
}

__device__ void phase_convert(char* shm) {
    KParams* kp = kargs();
    float* lds = (float*)shm;
    const int tid = tid_l(), lane = tid & 63, wave = __builtin_amdgcn_readfirstlane(tid >> 6);
    float* sc = lds;
    float* red = lds + 3072;
    char* wl = shm + 20480 + wave * (64 * 144);
    for (int i = tid; i < 3072; i += NTHREADS) {
        const int mi = i >> 10, k = i & 1023;
        const float cv = (mi == 0) ? kp->in[4][k] : kp->in[2][(mi - 1) * 1024 + k];
        sc[i] = cv * sigm(cv);
    }
    __syncthreads();
    float* modp = (float*)(kp->ws + OFF_MOD);
    for (int task = blockIdx.x; task < 288; task += gridDim.x) {
        const int kh = task / 144, cgp = task % 144, col = cgp * 64 + lane;
        const int kb = kh * 512 + wave * 64;
        const float* wm = kp->in[5] + (size_t)kb * 9216 + col;
        float a0 = 0.f, a1 = 0.f, a2 = 0.f;
#pragma unroll 16
        for (int i = 0; i < 64; ++i) {
            const float w = __builtin_nontemporal_load(wm + (size_t)i * 9216);
            a0 += sc[kb + i] * w; a1 += sc[1024 + kb + i] * w; a2 += sc[2048 + kb + i] * w;
        }
        red[(wave * 3 + 0) * 64 + lane] = a0; red[(wave * 3 + 1) * 64 + lane] = a1; red[(wave * 3 + 2) * 64 + lane] = a2;
        __syncthreads();
        if (tid < 192) {
            const int m = tid >> 6, cc = tid & 63;
            float s = kh == 0 ? kp->in[6][cgp * 64 + cc] : 0.f;
#pragma unroll
            for (int g = 0; g < 8; ++g) s += red[(g * 3 + m) * 64 + cc];
            modp[(kh * 3 + m) * 9216 + cgp * 64 + cc] = s;
        }
        __syncthreads();
    }
    constexpr int T_W13 = 88 * 16, T_W2 = 16 * 44, T_WIN = 88 * 16, T_LORA = 8 * 16, T_WAB = 16 * 8, T_WO = 16 * 16, T_L2 = 32;
    constexpr int TOTAL = 2 * T_W13 + 2 * T_W2 + T_WIN + T_LORA + 2 * T_WAB + T_WO + T_L2;
    for (int id0 = blockIdx.x * 8 + wave; id0 < TOTAL; id0 += gridDim.x * 8) {
        int id = id0;
        if (id < 2 * T_W13) {
            const int which = id / T_W13; id -= which * T_W13;
            const int nt = id >> 4, kt = id & 15, j = nt >> 2, w = nt & 3;
            const int c0 = (w < 2) ? (128 * j + 64 * w) : (2816 + 128 * j + 64 * (w - 2));
            conv_tile_w(wl, kp->in[which ? 10 : 8], 5632, kt * 64, c0, (bf16_t*)(kp->ws + (which ? OFF_W13B : OFF_W13A)), 1024, nt * 64, nullptr, 0, lane);
            continue;
        }
        id -= 2 * T_W13;
        if (id < 2 * T_W2) {
            const int which = id / T_W2; id -= which * T_W2;
            const int nt = id / 44, kt = id % 44;
            conv_tile_w(wl, kp->in[which ? 11 : 9], 1024, kt * 64, nt * 64, (bf16_t*)(kp->ws + (which ? OFF_W2B : OFF_W2A)), 2816, nt * 64, nullptr, 0, lane);
            continue;
        }
        id -= 2 * T_W2;
        if (id < T_WIN) {
            const int nt = id >> 4, kt = id & 15;
            conv_tile_w(wl, kp->in[12], 5632, kt * 64, nt * 64, (bf16_t*)(kp->ws + OFF_WIN), 1024, nt * 64, nullptr, 0, lane);
            continue;
        }
        id -= T_WIN;
        if (id < T_LORA) {
            const int nt = id >> 4, kt = id & 15;
            const int pq = nt & 1, l = (nt >> 1) & 1, d = nt >> 2;
            const float* src = kp->in[l ? 18 : 15] + (size_t)d * 1024 * 64;
            conv_tile_w(wl, src, 64, kt * 64, 0, (bf16_t*)(kp->ws + OFF_WIN), 1024, 5632 + nt * 64, kp->in[13] + (d * 2 + l) * 1024, pq ? 1 : 2, lane);
            continue;
        }
        id -= T_LORA;
        if (id < 2 * T_WAB) {
            const int which = id / T_WAB; id -= which * T_WAB;
            const int nt = id >> 3, kt = id & 7;
            conv_tile_w(wl, kp->in[which ? 28 : 27], 1024, kt * 64, nt * 64, (bf16_t*)(kp->ws + (which ? OFF_WB : OFF_WA)), 512, nt * 64, nullptr, 0, lane);
            continue;
        }
        id -= 2 * T_WAB;
        if (id < T_WO) {
            const int nt = id >> 4, kt = id & 15;
            conv_tile_w(wl, kp->in[29], 1024, kt * 64, nt * 64, (bf16_t*)(kp->ws + OFF_WO), 1024, nt * 64, nullptr, 0, lane);
            continue;
        }
        id -= T_WO;
        {
            const int dl = id >> 3, nt = id & 7, d = dl >> 1, l = dl & 1;
            const float* src = kp->in[l ? 19 : 16] + (size_t)d * 64 * 512;
            conv_tile_w(wl, src, 512, 0, nt * 64, (bf16_t*)(kp->ws + OFF_L2) + (size_t)dl * 512 * 64, 64, nt * 64, nullptr, 0, lane);
        }
    }
}

__device__ void phase_rowop(const float* __restrict__ xctx, const float* __restrict__ xlat, const bf16_t* __restrict__ P,
                            int gA, int mGate, float sA, float* __restrict__ xdst, int gB, int mShift, int mScale, bf16_t* __restrict__ hdst) {
    KParams* kp = kargs();
    const int tid = tid_l(), lane = tid & 63, wave = tid >> 6;
    const float* G = kp->in[7];
    const float* MOD = (const float*)(kp->ws + OFF_MOD);
    constexpr int RW = 4;
    for (int row0 = (blockIdx.x * 8 + wave) * RW; row0 < NTOK; row0 += gridDim.x * 8 * RW) {
        const int mi = row0 < NCTX ? 0 : 1 + ((row0 - NCTX) >> 11);
        const float* mod = MOD + mi * 9216;
        const float* xs = row0 < NCTX ? xctx + (size_t)row0 * DM : xlat + (size_t)(row0 - NCTX) * DM;
        f32x4 x[RW][4];
#pragma unroll
        for (int r = 0; r < RW; ++r)
#pragma unroll
            for (int i = 0; i < 4; ++i) x[r][i] = __builtin_nontemporal_load((const f32x4*)(xs + (size_t)r * DM + (i * 64 + lane) * 4));
        if (P) {
            u32x2 p0[RW][4], p1[RW][4];
#pragma unroll
            for (int r = 0; r < RW; ++r)
#pragma unroll
                for (int i = 0; i < 4; ++i) {
                    const size_t o = (size_t)(row0 + r) * DM + (i * 64 + lane) * 4;
                    p0[r][i] = __builtin_nontemporal_load((const u32x2*)(P + o)); p1[r][i] = __builtin_nontemporal_load((const u32x2*)(P + (size_t)NTOK * DM + o));
                }
            f32x4 gm[4];
#pragma unroll
            for (int i = 0; i < 4; ++i) {
                const int c = (i * 64 + lane) * 4;
                gm[i] = *(const f32x4*)(G + gA * DM + c) * (*(const f32x4*)(mod + mGate * DM + c) + *(const f32x4*)(mod + 27648 + mGate * DM + c));
            }
            float ss[RW];
#pragma unroll
            for (int r = 0; r < RW; ++r) {
                ss[r] = 0.f;
#pragma unroll
                for (int i = 0; i < 4; ++i) {
                    const f32x4 f = (f32x4){bflo(p0[r][i][0]) + bflo(p1[r][i][0]), bfhi(p0[r][i][0]) + bfhi(p1[r][i][0]), bflo(p0[r][i][1]) + bflo(p1[r][i][1]), bfhi(p0[r][i][1]) + bfhi(p1[r][i][1])};
                    ss[r] += f[0] * f[0] + f[1] * f[1] + f[2] * f[2] + f[3] * f[3];
                }
            }
#pragma unroll
            for (int o = 32; o > 0; o >>= 1) {
#pragma unroll
                for (int r = 0; r < RW; ++r) ss[r] += __shfl_xor(ss[r], o);
            }
#pragma unroll
            for (int r = 0; r < RW; ++r) {
                const float rstd = rsqrtf(ss[r] * (1.0f / DM) + 1e-6f) * sA;
#pragma unroll
                for (int i = 0; i < 4; ++i) {
                    const int c = (i * 64 + lane) * 4;
                    const f32x4 f = (f32x4){bflo(p0[r][i][0]) + bflo(p1[r][i][0]), bfhi(p0[r][i][0]) + bfhi(p1[r][i][0]), bflo(p0[r][i][1]) + bflo(p1[r][i][1]), bfhi(p0[r][i][1]) + bfhi(p1[r][i][1])};
                    x[r][i] += gm[i] * (f * rstd);
                    st_wt16f_nc(xdst + (size_t)(row0 + r) * DM + c, x[r][i]);
                }
            }
        }
        if (hdst) {
            f32x4 gs[4], sh[4];
#pragma unroll
            for (int i = 0; i < 4; ++i) {
                const int c = (i * 64 + lane) * 4;
                gs[i] = *(const f32x4*)(G + gB * DM + c) * (*(const f32x4*)(mod + mScale * DM + c) + *(const f32x4*)(mod + 27648 + mScale * DM + c) + 1.0f);
                sh[i] = *(const f32x4*)(mod + mShift * DM + c) + *(const f32x4*)(mod + 27648 + mShift * DM + c);
            }
            float ss[RW];
#pragma unroll
            for (int r = 0; r < RW; ++r) {
                ss[r] = 0.f;
#pragma unroll
                for (int i = 0; i < 4; ++i) ss[r] += x[r][i][0] * x[r][i][0] + x[r][i][1] * x[r][i][1] + x[r][i][2] * x[r][i][2] + x[r][i][3] * x[r][i][3];
            }
#pragma unroll
            for (int o = 32; o > 0; o >>= 1) {
#pragma unroll
                for (int r = 0; r < RW; ++r) ss[r] += __shfl_xor(ss[r], o);
            }
#pragma unroll
            for (int r = 0; r < RW; ++r) {
                const float rstd = rsqrtf(ss[r] * (1.0f / DM) + 1e-6f);
#pragma unroll
                for (int i = 0; i < 4; ++i) {
                    const int c = (i * 64 + lane) * 4;
                    const f32x4 h = (x[r][i] * rstd) * gs[i] + sh[i];
                    u32x2 o; o[0] = pk_bf16(h[0], h[1]); o[1] = pk_bf16(h[2], h[3]);
                    st_wt8_nc(hdst + (size_t)(row0 + r) * DM + c, o);
                }
            }
        }
    }
}

constexpr int BM = 256, BK = 64, HALF = 128, HT = HALF * BK;
__device__ __forceinline__ int lds_byte(int r, int c) {
    const int st = (r >> 4) * 2 + (c >> 5), rr = r & 15, cc = c & 31, ob = rr * 64 + cc * 2;
    return st * 1024 + (ob ^ (((ob >> 9) & 1) << 5));
}
__device__ __forceinline__ void stage_rc(int b, int& R, int& C) {
    const int st = b / 1024, sb = b % 1024, swz = sb ^ (((sb >> 9) & 1) << 5);
    R = (st >> 1) * 16 + swz / 64; C = (st & 1) * 32 + (swz % 64) / 2;
}
__device__ __forceinline__ void unit_map(int wgid, int nM, int nN, int& pm, int& pn) {
    const int NXCD = 8, WGM = 8, nwg = nM * nN;
    { const int q = nwg / NXCD, r = nwg % NXCD, xcd = wgid % NXCD, off = wgid / NXCD; wgid = (xcd < r ? xcd * (q + 1) : r * (q + 1) + (xcd - r) * q) + off; }
    const int nig = WGM * nN, gid = wgid / nig, fm = gid * WGM, gsz = min(nM - fm, WGM);
    pm = fm + ((wgid % nig) % gsz); pn = (wgid % nig) / gsz;
}

#define LAS __attribute__((address_space(3)))
constexpr int HTB = HALF * BK * 2;
__device__ __forceinline__ void gemm_tile(char* shmc, const bf16_t* __restrict__ A, int lda, const bf16_t* __restrict__ Bt, int ldb,
                                          int brow, int bcol, int nt, f32x4 (&acc)[2][2][4][2], const int tid) {
    LAS unsigned char* lds = (LAS unsigned char*)shmc;
    const int wid = __builtin_amdgcn_readfirstlane(tid >> 6), lane = tid & 63, wr = wid >> 2, wc = wid & 3, fr = lane & 15, fq = lane >> 4;
    unsigned voffA[2], voffB[2];
#pragma unroll
    for (int i = 0; i < 2; ++i) { int R, C; stage_rc(tid * 16 + i * 8192, R, C); voffA[i] = (unsigned)(R * lda + C) * 2u; voffB[i] = (unsigned)(R * ldb + C) * 2u; }
    const size_t kstep = (size_t)(BK * 2);
    const size_t hstepA = (size_t)HALF * lda * 2, hstepB = (size_t)HALF * ldb * 2;
    const unsigned ldsw = (unsigned)wid * 1024u;
    const int aoff = lds_byte(wr * 64 + fr, fq * 8), boff = lds_byte(wc * 32 + fr, fq * 8);
    const char* cA = (const char*)A + (size_t)brow * lda * 2;
    const char* cB = (const char*)Bt + (size_t)bcol * ldb * 2;
#define SA(b, h) (((b) * 2 + (h)) * HTB)
#define SB(b, h) ((4 + (b) * 2 + (h)) * HTB)
#define STAGE(bufoff, gbase, voff) do { _Pragma("unroll") for (int _i = 0; _i < 2; ++_i) \
    __builtin_amdgcn_global_load_lds((const unsigned*)((const char*)(gbase) + (voff)[_i]), (LAS unsigned*)(lds + (bufoff) + ldsw + _i * 8192), 16, 0, 0); } while (0)
#define LDA(dst, b, h) do { _Pragma("unroll") for (int m = 0; m < 4; ++m) _Pragma("unroll") for (int k = 0; k < 2; ++k) dst[m][k] = *(const LAS bf16x8*)(lds + SA(b, h) + aoff + m * 2048 + k * 1024); } while (0)
#define LDB(dst, b, h) do { _Pragma("unroll") for (int n = 0; n < 2; ++n) _Pragma("unroll") for (int k = 0; k < 2; ++k) dst[n][k] = *(const LAS bf16x8*)(lds + SB(b, h) + boff + n * 2048 + k * 1024); } while (0)
#define MMA(ai, bj, At_, Bt_) do { __builtin_amdgcn_s_setprio(1); _Pragma("unroll") for (int m = 0; m < 4; ++m) _Pragma("unroll") for (int n = 0; n < 2; ++n) _Pragma("unroll") for (int k = 0; k < 2; ++k) \
      acc[ai][bj][m][n] = __builtin_amdgcn_mfma_f32_16x16x32_bf16(Bt_[n][k], At_[m][k], acc[ai][bj][m][n], 0, 0, 0); \
    __builtin_amdgcn_s_setprio(0); } while (0)
#define WAIT_V(n) asm volatile("s_waitcnt vmcnt(" #n ")" ::: "memory")
#define WAIT_L(n) asm volatile("s_waitcnt lgkmcnt(" #n ")" ::: "memory")
#define BAR __builtin_amdgcn_s_barrier()
#define SCHED __builtin_amdgcn_sched_barrier(0)
#pragma unroll
    for (int a = 0; a < 2; ++a)
#pragma unroll
        for (int b = 0; b < 2; ++b)
#pragma unroll
            for (int m = 0; m < 4; ++m)
#pragma unroll
                for (int n = 0; n < 2; ++n) acc[a][b][m][n] = (f32x4){0.f, 0.f, 0.f, 0.f};
    bf16x8 At[4][2], B0[2][2], B1[2][2];
    STAGE(SB(0, 0), cB, voffB); STAGE(SA(0, 0), cA, voffA); STAGE(SB(0, 1), cB + hstepB, voffB); STAGE(SA(0, 1), cA + hstepA, voffA);
    if (wr == 1) BAR;
    WAIT_V(4); BAR;
    STAGE(SB(1, 0), cB + kstep, voffB); STAGE(SA(1, 0), cA + kstep, voffA); STAGE(SB(1, 1), cB + hstepB + kstep, voffB);
    WAIT_V(6); BAR;
    for (int t = 0; t < nt - 2; t += 2) {
        const char* a1 = cA + (size_t)(t + 1) * kstep;
        const char* a2 = cA + (size_t)(t + 2) * kstep; const char* b2 = cB + (size_t)(t + 2) * kstep;
        const char* a3 = a2 + kstep; const char* b3 = b2 + kstep;
        LDB(B0, 0, 0); SCHED; LDA(At, 0, 0); STAGE(SA(1, 1), a1 + hstepA, voffA);
        WAIT_L(8); BAR; WAIT_L(0); MMA(0, 0, At, B0); BAR; SCHED;
        LDB(B1, 0, 1); STAGE(SB(0, 0), b2, voffB);
        BAR; WAIT_L(0); MMA(0, 1, At, B1); BAR;
        LDA(At, 0, 1); STAGE(SA(0, 0), a2, voffA);
        BAR; WAIT_L(0); MMA(1, 0, At, B0); BAR; SCHED;
        STAGE(SB(0, 1), b2 + hstepB, voffB);
        WAIT_V(6); BAR; MMA(1, 1, At, B1); BAR;
        LDB(B0, 1, 0); SCHED; LDA(At, 1, 0); STAGE(SA(0, 1), a2 + hstepA, voffA);
        WAIT_L(8); BAR; WAIT_L(0); MMA(0, 0, At, B0); BAR; SCHED;
        LDB(B1, 1, 1); STAGE(SB(1, 0), b3, voffB);
        BAR; WAIT_L(0); MMA(0, 1, At, B1); BAR;
        LDA(At, 1, 1); STAGE(SA(1, 0), a3, voffA);
        BAR; WAIT_L(0); MMA(1, 0, At, B0); BAR; SCHED;
        STAGE(SB(1, 1), b3 + hstepB, voffB);
        WAIT_V(6); BAR; MMA(1, 1, At, B1); BAR;
    }
    { const char* a1 = cA + (size_t)(nt - 1) * kstep;
      LDB(B0, 0, 0); LDA(At, 0, 0); STAGE(SA(1, 1), a1 + hstepA, voffA);
      BAR; WAIT_L(0); MMA(0, 0, At, B0); BAR;
      LDB(B1, 0, 1); BAR; WAIT_L(0); MMA(0, 1, At, B1); BAR;
      LDA(At, 0, 1); WAIT_V(4); BAR; WAIT_L(0); MMA(1, 0, At, B0); MMA(1, 1, At, B1); BAR; }
    { LDB(B0, 1, 0); LDA(At, 1, 0); WAIT_V(2); BAR; WAIT_L(0); MMA(0, 0, At, B0); BAR;
      LDB(B1, 1, 1); WAIT_V(0); BAR; WAIT_L(0); MMA(0, 1, At, B1); BAR;
      LDA(At, 1, 1); BAR; WAIT_L(0); MMA(1, 0, At, B0); MMA(1, 1, At, B1); BAR; }
    if (wr == 0) BAR;
#undef SA
#undef SB
#undef STAGE
#undef LDA
#undef LDB
#undef MMA
}

struct GemmJob {
    const bf16_t* A0; const bf16_t* A1; const bf16_t* Bt0; const bf16_t* Bt1;
    int lda, ldb, nN, nsplit, nt, kstride, mode, pad;
    void* o1; void* o2; const bf16_t* Z;
};
__device__ void phase_gemm(char* shm, const GemmJob& J) {
    const int tid = tid_l();
    const int wid = __builtin_amdgcn_readfirstlane(tid >> 6), wr = wid >> 2, wc = wid & 3;
    const int nM = 32, nN = J.nN, nMN = nM * nN;
    const int mode = J.mode;
    for (int u = blockIdx.x; u < nMN * J.nsplit; u += gridDim.x) {
        const int ks = u / nMN;
        int pm, pn; unit_map(u - ks * nMN, nM, nN, pm, pn);
        {
            const int sub = ks;
            f32x4 acc[2][2][4][2];
            const size_t koff = (size_t)ks * J.kstride;
            gemm_tile(shm, (ks ? J.A1 : J.A0) + koff, J.lda, (ks ? J.Bt1 : J.Bt0) + koff, J.ldb, pm * BM, pn * BM, J.nt, acc, tid);
            int lane_e = tid & 63; asm volatile("" : "+v"(lane_e));
            const int fr = lane_e & 15, fq = lane_e >> 4;
            const int NBJ = (mode == 0) ? 1 : 2;
            const int W8 = NBJ * 16;
            const int pitch = NBJ * 256 + 32;
            bf16_t* obase; int old_, col0;
            if (mode == 0)      { obase = (bf16_t*)J.o1; old_ = DFF; col0 = pn * 128; }
            else if (mode == 1) { obase = (bf16_t*)J.o1 + (size_t)ks * NTOK * DM; old_ = DM; col0 = pn * BM; }
            else if (mode == 2) { obase = (bf16_t*)J.o1; old_ = ZLD; col0 = pn * BM; }
            else                { obase = (bf16_t*)(sub ? J.o2 : J.o1); old_ = DM; col0 = pn * BM; }
            const bf16_t* Zg = J.Z + (sub ? 4608 : 3584);
            const __amdgpu_buffer_rsrc_t orsrc = mk_rsrc(obase, (unsigned)NTOK * (unsigned)old_ * 2u);
#pragma unroll
            for (int ai = 0; ai < 2; ++ai) {
#pragma unroll
                for (int m = 0; m < 4; ++m) {
                    const int rloc = wr * 64 + m * 16 + fr;
                    const int row = pm * BM + ai * HALF + rloc;
#pragma unroll
                    for (int n = 0; n < 2; ++n) {
                        if (mode == 0) {
                            const f32x4 g = acc[ai][0][m][n], up = acc[ai][1][m][n];
                            float o[4];
#pragma unroll
                            for (int j = 0; j < 4; ++j) o[j] = g[j] * sigm(g[j]) * up[j];
                            u32x2 v; v[0] = pk_bf16(o[0], o[1]); v[1] = pk_bf16(o[2], o[3]);
                            *(u32x2*)(shm + rloc * pitch + (wc * 32 + n * 16 + fq * 4) * 2) = v;
                        } else {
#pragma unroll
                            for (int bj = 0; bj < 2; ++bj) {
                                const int cl = bj * HALF + wc * 32 + n * 16 + fq * 4;
                                f32x4 a = acc[ai][bj][m][n];
                                if (mode == 3) {
                                    const u32x2 gz = *(const u32x2*)(Zg + (size_t)row * ZLD + col0 + cl);
                                    a[0] *= sigm(bflo(gz[0])); a[1] *= sigm(bfhi(gz[0])); a[2] *= sigm(bflo(gz[1])); a[3] *= sigm(bfhi(gz[1]));
                                }
                                u32x2 v; v[0] = pk_bf16(a[0], a[1]); v[1] = pk_bf16(a[2], a[3]);
                                *(u32x2*)(shm + rloc * pitch + cl * 2) = v;
                            }
                        }
                    }
                }
                __syncthreads();
                const int w8sh = (mode == 0) ? 4 : 5;
                for (int c = tid; c < 128 * W8; c += NTHREADS) {
                    const int r = c >> w8sh, cc = c & (W8 - 1);
                    const u32x4 v = *(const u32x4*)(shm + r * pitch + cc * 16);
                    bst16(orsrc, (unsigned)(((pm * BM + ai * HALF + r) * old_ + col0 + cc * 8) * 2), v);
                }
                __syncthreads();
            }
        }
    }
}

__device__ void phase_prep(char* shm) {
    KParams* kp = kargs();
    const int tid = tid_l(), lane = tid & 63, wave = tid >> 6, fr = lane & 15, fq = lane >> 4;
    float* wt = (float*)shm + wave * (16 * 68);
    const bf16_t* Z = (const bf16_t*)(kp->ws + OFF_R1);
    const bf16_t* L2T = (const bf16_t*)(kp->ws + OFF_L2);
    bf16_t* KK = (bf16_t*)(kp->ws + OFF_R2 + R2_KK);
    float* WD = (float*)(kp->ws + OFF_R2 + R2_WD);
    bf16_t* KD = (bf16_t*)(kp->ws + OFF_R2 + R2_KD);
    bf16_t* BB = (bf16_t*)(kp->ws + OFF_R2 + R2_BB);
    float* BONUS = (float*)(kp->ws + OFF_BONUS);
    const __amdgpu_buffer_rsrc_t wd_rs = mk_rsrc(WD, 2u * NTOK * DR * 4), kd_rs = mk_rsrc(KD, 2u * NTOK * DR * 2), bb_rs = mk_rsrc(BB, 2u * NTOK * DR * 2), kk_rs = mk_rsrc(KK, NTOK * DR * 2);
    for (int unit = blockIdx.x * 8 + wave; unit < 2048; unit += gridDim.x * 8) {
        const int hq = unit & 1, d = (unit >> 1) & 1, tg = unit >> 2;
        const int row = tg * 16 + fr;
        const bool lat = row >= NCTX;
        const int pos = lat ? ((row - NCTX) & 2047) : (row & 255);
        const int T = lat ? 2048 : 256;
        const bool valid = d == 0 ? (pos > 0) : (pos < T - 1);
        const int srow = valid ? (d == 0 ? row - 1 : row + 1) : row;
        bf16x8 Bz[2][2];
#pragma unroll
        for (int l = 0; l < 2; ++l)
#pragma unroll
            for (int ks = 0; ks < 2; ++ks) {
                const int k = ks * 32 + fq * 8;
                const u32x4 Pv = *(const u32x4*)(Z + (size_t)row * ZLD + 5632 + ((d * 2 + l) * 2 + 0) * 64 + k);
                u32x4 Qv = *(const u32x4*)(Z + (size_t)srow * ZLD + 5632 + ((d * 2 + l) * 2 + 1) * 64 + k);
                if (!valid) Qv = (u32x4){0u, 0u, 0u, 0u};
                u32x4 o;
#pragma unroll
                for (int i = 0; i < 4; ++i) {
                    float z0 = bflo(Pv[i]) + bflo(Qv[i]), z1 = bfhi(Pv[i]) + bfhi(Qv[i]);
                    if (l == 0) {
                        z0 = 1.0f - 2.0f * __builtin_amdgcn_rcpf(__expf(2.0f * z0) + 1.0f);
                        z1 = 1.0f - 2.0f * __builtin_amdgcn_rcpf(__expf(2.0f * z1) + 1.0f);
                    }
                    o[i] = pk_bf16(z0, z1);
                }
                Bz[l][ks] = __builtin_bit_cast(bf16x8, o);
            }
        for (int hh = hq * 4; hh < hq * 4 + 4; ++hh) {
            f32x4 accw[4], acca[4];
#pragma unroll
            for (int mt = 0; mt < 4; ++mt) {
                accw[mt] = (f32x4){0.f, 0.f, 0.f, 0.f}; acca[mt] = (f32x4){0.f, 0.f, 0.f, 0.f};
#pragma unroll
                for (int ks = 0; ks < 2; ++ks) {
                    const bf16x8 Aw = *(const bf16x8*)(L2T + ((size_t)(d * 2 + 0) * 512 + hh * 64 + mt * 16 + fr) * 64 + ks * 32 + fq * 8);
                    const bf16x8 Aa = *(const bf16x8*)(L2T + ((size_t)(d * 2 + 1) * 512 + hh * 64 + mt * 16 + fr) * 64 + ks * 32 + fq * 8);
                    accw[mt] = __builtin_amdgcn_mfma_f32_16x16x32_bf16(Aw, Bz[0][ks], accw[mt], 0, 0, 0);
                    acca[mt] = __builtin_amdgcn_mfma_f32_16x16x32_bf16(Aa, Bz[1][ks], acca[mt], 0, 0, 0);
                }
            }
            float ss = 0.f, bon = 0.f;
            f32x4 kkr[4], kd[4];
#pragma unroll
            for (int mt = 0; mt < 4; ++mt) {
                const int c = hh * 64 + mt * 16 + fq * 4;
                const f32x4 w0 = *(const f32x4*)(kp->in[14] + d * 512 + c), a0 = *(const f32x4*)(kp->in[17] + d * 512 + c);
                const f32x4 kkp = *(const f32x4*)(kp->in[20] + c), kap = *(const f32x4*)(kp->in[21] + c), rkp = *(const f32x4*)(kp->in[22] + c);
                const u32x2 kz = *(const u32x2*)(Z + (size_t)row * ZLD + 512 + c), rz = *(const u32x2*)(Z + (size_t)row * ZLD + c);
                const float kv[4] = {bflo(kz[0]), bfhi(kz[0]), bflo(kz[1]), bfhi(kz[1])};
                const float rv[4] = {bflo(rz[0]), bfhi(rz[0]), bflo(rz[1]), bfhi(rz[1])};
#pragma unroll
                for (int j = 0; j < 4; ++j) {
                    const float xw = accw[mt][j] + w0[j];
                    accw[mt][j] = __expf(-0.60653065971f * sigm(xw));
                    const float a = sigm(acca[mt][j] + a0[j]);
                    acca[mt][j] = a;
                    const float kr = kv[j] * kkp[j];
                    kkr[mt][j] = kr; ss += kr * kr;
                    const float kdd = kv[j] * (1.0f + (a - 1.0f) * kap[j]);
                    kd[mt][j] = kdd;
                    bon += rv[j] * kdd * rkp[j];
                }
            }
            ss += __shfl_xor(ss, 16); ss += __shfl_xor(ss, 32);
            bon += __shfl_xor(bon, 16); bon += __shfl_xor(bon, 32);
            const float inv = rsqrtf(ss + 1e-12f);
            const int row0 = tg * 16;
#pragma unroll
            for (int pass = 0; pass < 4; ++pass) {
                if (pass == 3 && d != 0) break;
#pragma unroll
                for (int mt = 0; mt < 4; ++mt) {
                    f32x4 val;
                    if (pass == 0) val = accw[mt];
                    else if (pass == 1) val = kd[mt];
                    else if (pass == 2) val = kkr[mt] * inv * acca[mt];
                    else val = kkr[mt] * inv;
                    *(f32x4*)(wt + fr * 68 + mt * 16 + fq * 4) = val;
                }
                asm volatile("s_waitcnt lgkmcnt(0)" ::: "memory");
#pragma unroll
                for (int i = 0; i < 4; ++i) {
                    const int id = i * 64 + lane, tk = id >> 4, c4 = (id & 15) * 4;
                    const f32x4 val = *(const f32x4*)(wt + tk * 68 + c4);
                    const size_t o = ((size_t)d * NTOK + row0 + tk) * DR + hh * 64 + c4;
                    if (pass == 0) bst16(wd_rs, (unsigned)(o * 4), __builtin_bit_cast(u32x4, val));
                    else {
                        u32x2 v; v[0] = pk_bf16(val[0], val[1]); v[1] = pk_bf16(val[2], val[3]);
                        if (pass == 1) bst8(kd_rs, (unsigned)(o * 2), v);
                        else if (pass == 2) bst8(bb_rs, (unsigned)(o * 2), v);
                        else bst8(kk_rs, (unsigned)(((row0 + tk) * DR + hh * 64 + c4) * 2), v);
                    }
                }
                asm volatile("s_waitcnt lgkmcnt(0)" ::: "memory");
            }
            if (fq == 0) BONUS[((size_t)d * NTOK + row) * 8 + hh] = bon;
        }
    }
}

constexpr int TC = 32, STEP_F = 352;
typedef float f32x2 __attribute__((ext_vector_type(2)));
constexpr int SCAN_IN_F = TC * STEP_F;
constexpr int SCAN_Y_OFF = 2 * SCAN_IN_F;
struct ChunkDesc { int base, T, d, h, rq, c, b; bool first, last; };
template <bool LAT> __device__ __forceinline__ ChunkDesc chunk_desc(int slot, int g) {
    ChunkDesc q;
    if (LAT) {
        const int chain = slot >> 2; q.rq = slot & 3; q.b = chain >> 4; q.h = (chain >> 1) & 7; q.d = chain & 1;
        q.T = 2048; q.base = NCTX + q.b * 2048; q.c = g; q.first = g == 0; q.last = false;
    } else {
        const int u = slot * 4 + (g >> 3), chain = u >> 1; q.rq = u & 1; q.b = chain >> 4; q.h = (chain >> 1) & 7; q.d = chain & 1;
        q.T = 256; q.base = q.b * 256; q.c = g & 7; q.first = q.c == 0; q.last = q.c == 7;
    }
    return q;
}
__device__ __forceinline__ void st4(float* dst, unsigned a, unsigned b) {
    *(f32x4*)dst = (f32x4){bflo(a), bfhi(a), bflo(b), bfhi(b)};
}
struct LReg { u32x4 r8, k8, kk8, b8, v8; f32x4 w0, w1; };

template <bool LAT> __device__ __forceinline__ void scan_pass(char* shm, const int tid, const int slot) {
    constexpr int NSW = 4, RPL = LAT ? 1 : 2, RB = NSW * 4 * RPL, NCH = LAT ? 64 : 32;
    KParams* kp = kargs();
    float* lds = (float*)shm;
    const int wave = __builtin_amdgcn_readfirstlane(tid >> 6), lane = tid & 63;
    const bf16_t* Z = (const bf16_t*)(kp->ws + OFF_R1);
    const bf16_t* KK = (const bf16_t*)(kp->ws + OFF_R2 + R2_KK);
    const float* WD = (const float*)(kp->ws + OFF_R2 + R2_WD);
    const bf16_t* KD = (const bf16_t*)(kp->ws + OFF_R2 + R2_KD);
    const bf16_t* BB = (const bf16_t*)(kp->ws + OFF_R2 + R2_BB);
    bf16_t* Y = (bf16_t*)(kp->ws + OFF_H);
    float* OST = kp->out + (size_t)NTOK * DM;
    const float* ST0 = kp->in[3];
    {
        if (wave >= 4) {
            const int lt = tid - 256, s = lt >> 3, cg8 = (lt & 7) * 8;
            constexpr int NV = TC * RB / 8;
            LReg R;
            auto ld_chunk = [&](int g) {
                const ChunkDesc q = chunk_desc<LAT>(slot, g);
                const int tt = q.c * TC + s, t = q.d ? q.T - 1 - tt : tt, row = q.base + t;
                const int ch = q.h * 64 + cg8;
                const size_t od = ((size_t)q.d * NTOK + row) * DR + ch;
                R.r8 = *(const u32x4*)(Z + (size_t)row * ZLD + ch);
                R.w0 = *(const f32x4*)(WD + od); R.w1 = *(const f32x4*)(WD + od + 4);
                R.k8 = *(const u32x4*)(KD + od);
                R.kk8 = *(const u32x4*)(KK + (size_t)row * DR + ch);
                R.b8 = *(const u32x4*)(BB + od);
                if (lt < NV) {
                    const int s2 = lt / (RB / 8), hf = lt % (RB / 8);
                    const int tt2 = q.c * TC + s2, t2 = q.d ? q.T - 1 - tt2 : tt2, row2 = q.base + t2;
                    R.v8 = *(const u32x4*)(Z + (size_t)row2 * ZLD + 1024 + q.h * 64 + q.rq * RB + hf * 8);
                }
            };
            ld_chunk(0);
            for (int g = -1; g <= NCH; ++g) {
                if (g + 1 <= NCH - 1) {
                    float* buf = lds + ((g + 1) & 1) * SCAN_IN_F;
                    float* L = buf + s * STEP_F + cg8;
                    st4(L, R.r8[0], R.r8[1]); st4(L + 4, R.r8[2], R.r8[3]);
                    *(f32x4*)(L + 64) = R.w0; *(f32x4*)(L + 68) = R.w1;
                    st4(L + 128, R.k8[0], R.k8[1]); st4(L + 132, R.k8[2], R.k8[3]);
                    st4(L + 192, R.kk8[0], R.kk8[1]); st4(L + 196, R.kk8[2], R.kk8[3]);
                    st4(L + 256, R.b8[0], R.b8[1]); st4(L + 260, R.b8[2], R.b8[3]);
                    if (lt < NV) {
                        const int s2 = lt / (RB / 8), hf = lt % (RB / 8);
                        float* Lv = buf + s2 * STEP_F + 320 + hf * 8;
                        st4(Lv, R.v8[0], R.v8[1]); st4(Lv + 4, R.v8[2], R.v8[3]);
                    }
                }
                if (g + 2 <= NCH - 1) ld_chunk(g + 2);
                if (g >= 1) {
                    const ChunkDesc q = chunk_desc<LAT>(slot, g - 1);
                    const float* yb = lds + SCAN_Y_OFF + ((g - 1) & 1) * (TC * RB);
#pragma unroll
                    for (int i = lt; i < TC * RB / 2; i += 256) {
                        const int sy = i / (RB / 2), r2 = (i % (RB / 2)) * 2;
                        const int tt = q.c * TC + sy, t = q.d ? q.T - 1 - tt : tt, row = q.base + t;
                        const f32x2 yv = *(const f32x2*)(yb + sy * RB + r2);
                        *(unsigned*)(Y + ((size_t)q.d * NTOK + row) * DR + q.h * 64 + q.rq * RB + r2) = pk_bf16(yv[0], yv[1]);
                    }
                }
                __syncthreads();
            }
        } else if (wave < NSW) {
            const int rl = lane >> 4, qq = lane & 15;
            f32x2 Sa[RPL], Sb[RPL];
#pragma unroll
            for (int j = 0; j < RPL; ++j) { Sa[j] = (f32x2){0.f, 0.f}; Sb[j] = (f32x2){0.f, 0.f}; }
            __syncthreads();
            for (int g = 0; g <= NCH - 1; ++g) {
                const ChunkDesc q = chunk_desc<LAT>(slot, g);
                const float* buf = lds + (g & 1) * SCAN_IN_F;
                const int rloc = wave * RPL * 4 + rl;
                float* yb = lds + SCAN_Y_OFF + (g & 1) * (TC * RB) + rloc;
                if (q.first) {
#pragma unroll
                    for (int j = 0; j < RPL; ++j) {
                        if (LAT) {
                            const int irow = q.rq * RB + rloc + 4 * j;
                            const f32x4 s = *(const f32x4*)(ST0 + ((size_t)((q.b * 2 + q.d) * 8 + q.h) * 64 + irow) * 64 + qq * 4);
                            Sa[j] = (f32x2){s[0], s[1]}; Sb[j] = (f32x2){s[2], s[3]};
                        } else { Sa[j] = (f32x2){0.f, 0.f}; Sb[j] = (f32x2){0.f, 0.f}; }
                    }
                }
                const float* Lq = buf + qq * 4;
                const float* Lv = buf + 320 + rloc;
                f32x4 r4 = *(const f32x4*)(Lq), w4 = *(const f32x4*)(Lq + 64), k4 = *(const f32x4*)(Lq + 128), n4 = *(const f32x4*)(Lq + 192), b4 = *(const f32x4*)(Lq + 256);
                f32x4 r4n = *(const f32x4*)(Lq + STEP_F), w4n = *(const f32x4*)(Lq + STEP_F + 64), k4n = *(const f32x4*)(Lq + STEP_F + 128), n4n = *(const f32x4*)(Lq + STEP_F + 192), b4n = *(const f32x4*)(Lq + STEP_F + 256);
                float v[RPL], vn[RPL], yprev[RPL];
#pragma unroll
                for (int j = 0; j < RPL; ++j) { v[j] = Lv[4 * j]; vn[j] = Lv[STEP_F + 4 * j]; yprev[j] = 0.f; }
#pragma unroll
                for (int s = 0; s < TC; ++s) {
                    const int s2 = (s + 2 < TC) ? s + 2 : TC - 1;
                    const float* Ln = Lq + s2 * STEP_F;
                    const f32x4 r4m = *(const f32x4*)(Ln), w4m = *(const f32x4*)(Ln + 64), k4m = *(const f32x4*)(Ln + 128), n4m = *(const f32x4*)(Ln + 192), b4m = *(const f32x4*)(Ln + 256);
                    float vm[RPL];
#pragma unroll
                    for (int j = 0; j < RPL; ++j) vm[j] = Lv[s2 * STEP_F + 4 * j];
#pragma unroll
                    for (int j = 0; j < RPL; ++j) {
                        f32x2 pp = Sa[j] * (f32x2){n4[0], n4[1]};
                        pp = Sb[j] * (f32x2){n4[2], n4[3]} + pp;
                        float pd = pp[0] + pp[1];
                        const f32x2 vv = {v[j], v[j]};
                        f32x2 Ta = (f32x2){k4[0], k4[1]} * vv, Tb = (f32x2){k4[2], k4[3]} * vv;
                        Ta = Sa[j] * (f32x2){w4[0], w4[1]} + Ta; Tb = Sb[j] * (f32x2){w4[2], w4[3]} + Tb;
                        pd = red16(pd);
                        const float yr = red16(yprev[j]);
                        if (s > 0) yb[(s - 1) * RB + 4 * j] = yr;
                        const f32x2 np = {-pd, -pd};
                        Sa[j] = (f32x2){b4[0], b4[1]} * np + Ta; Sb[j] = (f32x2){b4[2], b4[3]} * np + Tb;
                        f32x2 yy = Sa[j] * (f32x2){r4[0], r4[1]};
                        yy = Sb[j] * (f32x2){r4[2], r4[3]} + yy;
                        yprev[j] = yy[0] + yy[1];
                    }
                    r4 = r4n; w4 = w4n; k4 = k4n; n4 = n4n; b4 = b4n;
                    r4n = r4m; w4n = w4m; k4n = k4m; n4n = n4m; b4n = b4m;
#pragma unroll
                    for (int j = 0; j < RPL; ++j) { v[j] = vn[j]; vn[j] = vm[j]; }
                }
#pragma unroll
                for (int j = 0; j < RPL; ++j) yb[(TC - 1) * RB + 4 * j] = red16(yprev[j]);
                if (!LAT && q.last) {
#pragma unroll
                    for (int j = 0; j < RPL; ++j) {
                        const int irow = q.rq * RB + rloc + 4 * j;
                        *(f32x4*)(OST + ((size_t)((q.b * 2 + q.d) * 8 + q.h) * 64 + irow) * 64 + qq * 4) = (f32x4){Sa[j][0], Sa[j][1], Sb[j][0], Sb[j][1]};
                    }
                }
                __syncthreads();
            }
            __syncthreads();
        } else {
            for (int g = -1; g <= NCH; ++g) __syncthreads();
        }
    }
}
__device__ void phase_scan(char* shm) {
    const int tid = tid_l();
    for (int slot = blockIdx.x; slot < 256; slot += gridDim.x) {
        if (slot < 128) scan_pass<true>(shm, tid, slot);
        else scan_pass<false>(shm, tid, slot - 128);
        __syncthreads();
    }
}

__device__ void phase_post() {
    KParams* kp = kargs();
    const int tid = tid_l(), lane = tid & 63, wave = tid >> 6;
    const bf16_t* Z = (const bf16_t*)(kp->ws + OFF_R1);
    const bf16_t* Y = (const bf16_t*)(kp->ws + OFF_H);
    const float* BONUS = (const float*)(kp->ws + OFF_BONUS);
    bf16_t* YA = (bf16_t*)(kp->ws + OFF_R2 + R2_YA);
    bf16_t* YB = (bf16_t*)(kp->ws + OFF_R2 + R2_YB);
    const int c = lane * 8, head = lane >> 3;
    const __amdgpu_buffer_rsrc_t ya_rs = mk_rsrc(YA, NTOK * DR * 2), yb_rs = mk_rsrc(YB, NTOK * DR * 2);
    for (int row = blockIdx.x * 8 + wave; row < NTOK; row += gridDim.x * 8) {
        const u32x4 y0 = *(const u32x4*)(Y + (size_t)row * DR + c), y1 = *(const u32x4*)(Y + ((size_t)NTOK + row) * DR + c);
        float y[8];
#pragma unroll
        for (int i = 0; i < 4; ++i) { y[2 * i] = bflo(y0[i]) + bflo(y1[i]); y[2 * i + 1] = bfhi(y0[i]) + bfhi(y1[i]); }
        float s = 0.f;
#pragma unroll
        for (int i = 0; i < 8; ++i) s += y[i];
        s += __shfl_xor(s, 1); s += __shfl_xor(s, 2); s += __shfl_xor(s, 4);
        const float mean = s * (1.0f / 64.0f);
        float vs = 0.f;
#pragma unroll
        for (int i = 0; i < 8; ++i) { y[i] -= mean; vs += y[i] * y[i]; }
        vs += __shfl_xor(vs, 1); vs += __shfl_xor(vs, 2); vs += __shfl_xor(vs, 4);
        const float rs = rsqrtf(vs * (1.0f / 64.0f) + 64e-5f);
        const float bon = BONUS[(size_t)row * 8 + head] + BONUS[((size_t)NTOK + row) * 8 + head];
        const u32x4 vz = *(const u32x4*)(Z + (size_t)row * ZLD + 1024 + c), gz = *(const u32x4*)(Z + (size_t)row * ZLD + 1536 + c);
        const f32x4 gn0 = *(const f32x4*)(kp->in[23] + c), gn1 = *(const f32x4*)(kp->in[23] + c + 4);
        const f32x4 gb0 = *(const f32x4*)(kp->in[24] + c), gb1 = *(const f32x4*)(kp->in[24] + c + 4);
        float o[8];
#pragma unroll
        for (int i = 0; i < 8; ++i) {
            const float vv = (i & 1) ? bfhi(vz[i >> 1]) : bflo(vz[i >> 1]);
            const float gg = (i & 1) ? bfhi(gz[i >> 1]) : bflo(gz[i >> 1]);
            const float gain = i < 4 ? gn0[i & 3] : gn1[i & 3], bias = i < 4 ? gb0[i & 3] : gb1[i & 3];
            o[i] = (y[i] * rs * gain + bias + bon * vv) * sigm(gg);
        }
        u32x4 ov;
#pragma unroll
        for (int i = 0; i < 4; ++i) ov[i] = pk_bf16(o[2 * i], o[2 * i + 1]);
        bst16(ya_rs, (unsigned)((row * DR + c) * 2), ov);
        const bool lat = row >= NCTX;
        const int pos = lat ? ((row - NCTX) & 63) : (row & 255);
        const int last = lat ? 63 : 255;
        const bool vl = pos > 0, vr = pos < last;
        const int rl = vl ? row - 1 : row, rr = vr ? row + 1 : row;
        const u32x4 ccm = *(const u32x4*)(Z + (size_t)row * ZLD + 2560 + c), xcm = *(const u32x4*)(Z + (size_t)row * ZLD + 3072 + c);
        const u32x4 ccl = *(const u32x4*)(Z + (size_t)rl * ZLD + 2560 + c), xcl = *(const u32x4*)(Z + (size_t)rl * ZLD + 3072 + c);
        const u32x4 ccr = *(const u32x4*)(Z + (size_t)rr * ZLD + 2560 + c), xcr = *(const u32x4*)(Z + (size_t)rr * ZLD + 3072 + c);
        const u32x4 cbz = *(const u32x4*)(Z + (size_t)row * ZLD + 2048 + c);
        const float fl = vl ? 1.f : 0.f, frr = vr ? 1.f : 0.f;
#pragma unroll
        for (int i = 0; i < 8; ++i) {
            const int w = i >> 1; const bool hi = i & 1;
            const float um = (hi ? bfhi(ccm[w]) : bflo(ccm[w])) * (hi ? bfhi(xcm[w]) : bflo(xcm[w]));
            const float ul = (hi ? bfhi(ccl[w]) : bflo(ccl[w])) * (hi ? bfhi(xcl[w]) : bflo(xcl[w])) * fl;
            const float ur = (hi ? bfhi(ccr[w]) : bflo(ccr[w])) * (hi ? bfhi(xcr[w]) : bflo(xcr[w])) * frr;
            const float cb = hi ? bfhi(cbz[w]) : bflo(cbz[w]);
            const float cv = ul * kp->in[25][c + i] + um * kp->in[25][512 + c + i] + ur * kp->in[25][1024 + c + i] + kp->in[26][c + i];
            o[i] = cb * cv;
        }
#pragma unroll
        for (int i = 0; i < 4; ++i) ov[i] = pk_bf16(o[2 * i], o[2 * i + 1]);
        bst16(yb_rs, (unsigned)((row * DR + c) * 2), ov);
    }
}

#define XB_TMO      128
#define XB_XCNT(j)  (256  + 64 * (j))
#define XB_XSUB(j)  (1280 + 64 * (j))
#define XB_XGEN(j)  (2304 + 64 * (j))
#define XB_TOP      3328
#define XB_TOPGEN   3392
#define XCD_BAR_WORDS 3456
#define XB_SPIN_CAP (1u << 18)
#define XLAS __attribute__((address_space(3)))
__device__ __forceinline__ unsigned xb_ld(unsigned* p)              { return __hip_atomic_load(p, __ATOMIC_RELAXED, __HIP_MEMORY_SCOPE_AGENT); }
__device__ __forceinline__ unsigned xb_add(unsigned* p, unsigned v) { return __hip_atomic_fetch_add(p, v, __ATOMIC_RELAXED, __HIP_MEMORY_SCOPE_AGENT); }
__device__ __forceinline__ unsigned xb_xcc_id() { return (unsigned)__builtin_amdgcn_s_getreg((3 << 11) | 20) & 0xFu; }
#define XB_SPIN(cond, bar) do { unsigned _sp = 0; while (cond) { __builtin_amdgcn_s_sleep(1); \
    if ((++_sp & 255u) == 0u) { if (xb_ld(&(bar)[XB_TMO])) break; if (_sp > XB_SPIN_CAP) { atomicAdd(&(bar)[XB_TMO], 1u); break; } } } } while (0)
struct XcdBarrier { unsigned* bar; unsigned x; volatile XLAS unsigned* st; };
__device__ __forceinline__ XcdBarrier xcd_barrier_post(unsigned* bar, volatile XLAS unsigned* st) {
    XcdBarrier b; b.bar = bar; b.x = xb_xcc_id(); b.st = st;
    if (threadIdx.x == 0) (void)xb_add(&bar[XB_XCNT(b.x)], 1u);
    return b;
}
__device__ __forceinline__ void xcd_barrier_complete(unsigned* bar, unsigned x, unsigned& nloc, unsigned& nx) {
    const unsigned G = gridDim.x * gridDim.y * gridDim.z;
    unsigned sum, cnt, mine, sp = 0u;
    for (;;) {
        sum = 0u; cnt = 0u; mine = 0u;
#pragma unroll
        for (unsigned j = 0; j < 16; ++j) { const unsigned c = xb_ld(&bar[XB_XCNT(j)]); sum += c; cnt += (c > 0u) ? 1u : 0u; mine = (j == x) ? c : mine; }
        if (sum == G) break;
        __builtin_amdgcn_s_sleep(1);
        if ((++sp & 255u) == 0u) { if (xb_ld(&bar[XB_TMO])) break; if (sp > XB_SPIN_CAP) { atomicAdd(&bar[XB_TMO], 1u); break; } }
    }
    nloc = mine > 0u ? mine : 1u; nx = cnt > 0u ? cnt : 1u;
}
__device__ __forceinline__ void xcd_barrier(const XcdBarrier& b) {
    asm volatile("s_waitcnt vmcnt(0)" ::: "memory");
    __syncthreads();
    if (threadIdx.x == 0) {
        unsigned* bar = b.bar;
        __builtin_amdgcn_s_waitcnt(0);
        unsigned nloc = b.st[0], nx = b.st[1];
        if (nloc == 0u) { xcd_barrier_complete(bar, b.x, nloc, nx); b.st[0] = nloc; b.st[1] = nx; }
        const unsigned old = xb_add(&bar[XB_XSUB(b.x)], 1u);
        const unsigned gen = old / nloc;
        if (old + 1u == (gen + 1u) * nloc) {
            __builtin_amdgcn_fence(__ATOMIC_RELEASE, "agent");
            asm volatile("s_waitcnt vmcnt(0)" ::: "memory");
            const unsigned og = xb_add(&bar[XB_TOP], 1u);
            const unsigned tg = og / nx;
            if (og + 1u == (tg + 1u) * nx) xb_add(&bar[XB_TOPGEN], 1u);
            else XB_SPIN(xb_ld(&bar[XB_TOPGEN]) == tg, bar);
            __builtin_amdgcn_fence(__ATOMIC_ACQUIRE, "agent");
            xb_add(&bar[XB_XGEN(b.x)], 1u);
            asm volatile("s_waitcnt vmcnt(0)" ::: "memory");
        } else {
            XB_SPIN(xb_ld(&bar[XB_XGEN(b.x)]) == gen, bar);
            __builtin_amdgcn_fence(__ATOMIC_ACQUIRE, "agent");
            asm volatile("s_waitcnt vmcnt(0)" ::: "memory");
        }
    }
    __syncthreads();
}

struct RowJob { const float* xc; const float* xl; const bf16_t* P; float* xdst; bf16_t* hdst; int gA, mGate, gB, mShift, mScale; float sA; };

__global__ void __launch_bounds__(NTHREADS) fwd_megakernel(Params p) {
    extern __shared__ __attribute__((aligned(16))) char shm[];
    volatile XLAS unsigned* st = (volatile XLAS unsigned*)((XLAS unsigned char*)shm + LDS_STAGE);
    if (threadIdx.x < 4) st[threadIdx.x] = 0u;
    __syncthreads();
    const XcdBarrier xb = xcd_barrier_post((unsigned*)(kargs()->ws + OFF_BAR), st);
    const int ph_lo = kargs()->phase_lo, ph_hi = kargs()->phase_hi;
    for (int ph = ph_lo; ph < ph_hi; ++ph) {
        KParams* kp0 = kargs();
        char* ws = kp0->ws;
        bf16_t* H = (bf16_t*)(ws + OFF_H);
        bf16_t* R1 = (bf16_t*)(ws + OFF_R1);
        float* R2f = (float*)(ws + OFF_R2);
        float* out = kp0->out;
        const float* xlat_out = out + (size_t)NCTX * DM;
        int kind = 0;
        RowJob R{}; GemmJob J{};
        switch (ph) {
        case 1: kind = 1; R = RowJob{kargs()->in[0], kargs()->in[1], nullptr, nullptr, H, 0, 0, 0, 0, 1, 0.f}; break;
        case 4: kind = 1; R = RowJob{kargs()->in[0], kargs()->in[1], (const bf16_t*)R2f, out, H, 1, 2, 2, 3, 4, 0.5f}; break;
        case 11: kind = 1; R = RowJob{out, xlat_out, (const bf16_t*)R1, out, H, 3, 5, 4, 6, 7, 1.0f}; break;
        case 14: kind = 1; R = RowJob{out, xlat_out, (const bf16_t*)R2f, out, nullptr, 5, 8, 0, 0, 0, 0.5f}; break;
        case 2: case 12: kind = 2;
            J.A0 = J.A1 = H; J.Bt0 = J.Bt1 = (const bf16_t*)(ws + (ph == 2 ? OFF_W13A : OFF_W13B)); J.lda = DM; J.ldb = DM; J.nN = 22; J.nsplit = 1; J.nt = DM / BK; J.kstride = 0; J.mode = 0; J.o1 = R1; break;
        case 3: case 13: kind = 2;
            J.A0 = J.A1 = R1; J.Bt0 = J.Bt1 = (const bf16_t*)(ws + (ph == 3 ? OFF_W2A : OFF_W2B)); J.lda = DFF; J.ldb = DFF; J.nN = 4; J.nsplit = 2; J.nt = 22; J.kstride = 22 * BK; J.mode = 1; J.o1 = R2f; break;
        case 5: kind = 2;
            J.A0 = J.A1 = H; J.Bt0 = J.Bt1 = (const bf16_t*)(ws + OFF_WIN); J.lda = DM; J.ldb = DM; J.nN = 24; J.nsplit = 1; J.nt = DM / BK; J.kstride = 0; J.mode = 2; J.o1 = R1; break;
        case 9: kind = 2;
            J.A0 = (const bf16_t*)(ws + OFF_R2 + R2_YA); J.A1 = (const bf16_t*)(ws + OFF_R2 + R2_YB); J.Bt0 = (const bf16_t*)(ws + OFF_WA); J.Bt1 = (const bf16_t*)(ws + OFF_WB);
            J.lda = DR; J.ldb = DR; J.nN = 4; J.nsplit = 2; J.nt = DR / BK; J.kstride = 0; J.mode = 3; J.o1 = ws + OFF_R2 + R2_GA; J.o2 = ws + OFF_R2 + R2_GB; J.Z = R1; break;
        case 10: kind = 2;
            J.A0 = (const bf16_t*)(ws + OFF_R2 + R2_GA); J.A1 = (const bf16_t*)(ws + OFF_R2 + R2_GB); J.Bt0 = J.Bt1 = (const bf16_t*)(ws + OFF_WO); J.lda = DM; J.ldb = DM; J.nN = 4; J.nsplit = 2; J.nt = DM / BK; J.kstride = 0; J.mode = 1; J.o1 = R1; break;
        default: break;
        }
        for (int rep = 0; rep <= ((REPEAT_MASK >> ph) & 1); ++rep) {
        if (rep) xcd_barrier(xb);
        if (kind == 1) phase_rowop(R.xc, R.xl, R.P, R.gA, R.mGate, R.sA, R.xdst, R.gB, R.mShift, R.mScale, R.hdst);
        else if (kind == 2) phase_gemm(shm, J);
        else if (ph == 0) phase_convert(shm);
        else if (ph == 6) phase_prep(shm);
        else if (ph == 7) phase_scan(shm);
        else if (ph == 8) phase_post();
        }
        if (ph + 1 < ph_hi) xcd_barrier(xb);
    }
}

extern "C" void kernel_launch(void* const* d_in, const int* in_sizes, int n_in, void* d_out, int out_size, void* d_ws, size_t ws_size, hipStream_t stream) {
    static int grid_blocks = 0;
    if (grid_blocks == 0) {
        if (ws_size < WS_END) { fprintf(stderr, "kernel_launch: workspace too small: %zu < %zu\n", ws_size, (size_t)WS_END); grid_blocks = -1; return; }
        int dev = 0, cus = 0, per_cu = 0;
        hipGetDevice(&dev);
        hipDeviceGetAttribute(&cus, hipDeviceAttributeMultiprocessorCount, dev);
        if (hipFuncSetAttribute((const void*)fwd_megakernel, hipFuncAttributeMaxDynamicSharedMemorySize, LDS_BYTES) != hipSuccess) { fprintf(stderr, "hipFuncSetAttribute failed\n"); grid_blocks = -1; return; }
        hipOccupancyMaxActiveBlocksPerMultiprocessor(&per_cu, (const void*)fwd_megakernel, NTHREADS, LDS_BYTES);
        if (per_cu < 1) { fprintf(stderr, "occupancy query says %d\n", per_cu); per_cu = 1; }
        if (per_cu > 1) per_cu = 1;
        grid_blocks = cus * per_cu;
    }
    if (grid_blocks < 0) return;
    Params p{};
    for (int i = 0; i < 30; ++i) p.in[i] = (const float*)d_in[i];
    p.out = (float*)d_out; p.ws = (char*)d_ws; p.phase_lo = 0; p.phase_hi = 15;
    if (hipMemsetAsync((char*)d_ws + OFF_BAR, 0, 16384, stream) != hipSuccess) { fprintf(stderr, "memset of barrier words failed\n"); return; }
    void* args[] = {&p};
    hipError_t e = hipLaunchCooperativeKernel((const void*)fwd_megakernel, dim3(grid_blocks), dim3(NTHREADS), args, LDS_BYTES, stream);
    if (e != hipSuccess) fprintf(stderr, "cooperative launch failed: %s (grid %d)\n", hipGetErrorString(e), grid_blocks);
}
```

```cpp
#include <hip/hip_runtime.h>
#include <hip/hip_cooperative_groups.h>
#include <cstdio>
namespace cg = cooperative_groups;

typedef unsigned short bf16_t;
typedef short bf16x8 __attribute__((ext_vector_type(8)));
typedef float f32x4 __attribute__((ext_vector_type(4)));
typedef unsigned u32x4 __attribute__((ext_vector_type(4)));
typedef unsigned u32x2 __attribute__((ext_vector_type(2)));

constexpr int DM = 1024, NTOK = 8192, NCTX = 4096, DFF = 2816, NIN = 6144, ZLD = 6144, DR = 512;
constexpr int NTHREADS = 512;
#define REPEAT_MASK 0
constexpr int LDS_STAGE = 131072;
constexpr int LDS_BYTES = LDS_STAGE + 16;

constexpr size_t SZ_W13 = (size_t)5632 * 1024 * 2, SZ_W2 = (size_t)1024 * 2816 * 2;
constexpr size_t OFF_W13A = 0;
constexpr size_t OFF_W2A = OFF_W13A + SZ_W13;
constexpr size_t OFF_W13B = OFF_W2A + SZ_W2;
constexpr size_t OFF_W2B = OFF_W13B + SZ_W13;
constexpr size_t OFF_WIN = OFF_W2B + SZ_W2;
constexpr size_t OFF_WA = OFF_WIN + (size_t)6144 * 1024 * 2;
constexpr size_t OFF_WB = OFF_WA + (size_t)1024 * 512 * 2;
constexpr size_t OFF_WO = OFF_WB + (size_t)1024 * 512 * 2;
constexpr size_t OFF_L2 = OFF_WO + (size_t)1024 * 1024 * 2;
constexpr size_t OFF_MOD = OFF_L2 + (size_t)4 * 512 * 64 * 2;
constexpr size_t OFF_BONUS = OFF_MOD + (size_t)2 * 3 * 9216 * 4;
constexpr size_t OFF_H = OFF_BONUS + (size_t)2 * 8192 * 8 * 4;
constexpr size_t OFF_R1 = OFF_H + (size_t)8192 * 1024 * 2;
constexpr size_t OFF_R2 = OFF_R1 + (size_t)8192 * 6144 * 2;
constexpr size_t OFF_BAR = OFF_R2 + (size_t)72 * 1024 * 1024;
constexpr size_t WS_END = OFF_BAR + 16384;
constexpr size_t R2_KK = 0;
constexpr size_t R2_WD = R2_KK + (size_t)8192 * 512 * 2;
constexpr size_t R2_KD = R2_WD + (size_t)2 * 8192 * 512 * 4;
constexpr size_t R2_BB = R2_KD + (size_t)2 * 8192 * 512 * 2;
constexpr size_t R2_YA = 0;
constexpr size_t R2_YB = R2_YA + (size_t)8192 * 512 * 2;
constexpr size_t R2_GA = R2_YB + (size_t)8192 * 512 * 2;
constexpr size_t R2_GB = R2_GA + (size_t)8192 * 1024 * 2;

struct Params {
    const float* in[30];
    float* out;
    char* ws;
    int phase_lo, phase_hi;
};


typedef const __attribute__((address_space(4))) Params KParams;
__device__ __forceinline__ KParams* kargs() {
    KParams* k = (KParams*)__builtin_amdgcn_kernarg_segment_ptr();
    asm volatile("" : "+s"(k));
    return k;
}

__device__ __forceinline__ int tid_l() { int t = threadIdx.x; asm volatile("" : "+v"(t)); return t; }
__device__ __forceinline__ float bf2f(unsigned short u) { return __uint_as_float(((unsigned)u) << 16); }
__device__ __forceinline__ float bflo(unsigned u) { return __uint_as_float(u << 16); }
__device__ __forceinline__ float bfhi(unsigned u) { return __uint_as_float(u & 0xffff0000u); }
__device__ __forceinline__ unsigned pk_bf16(float lo, float hi) { unsigned r; asm("v_cvt_pk_bf16_f32 %0, %1, %2" : "=v"(r) : "v"(lo), "v"(hi)); return r; }
__device__ __forceinline__ void st_wt16(void* p, u32x4 v) { asm volatile("global_store_dwordx4 %0, %1, off sc1\n\ts_nop 1" :: "v"(p), "v"(v) : "memory"); }
__device__ __forceinline__ void st_wt16f_nc(void* p, f32x4 v) { asm volatile("global_store_dwordx4 %0, %1, off sc1\n\ts_nop 1" :: "v"(p), "v"(v)); }
__device__ __forceinline__ void st_wt8_nc(void* p, u32x2 v) { asm volatile("global_store_dwordx2 %0, %1, off sc1\n\ts_nop 1" :: "v"(p), "v"(v)); }
__device__ __forceinline__ float sigm(float x) { return __builtin_amdgcn_rcpf(1.0f + __expf(-x)); }
__device__ __forceinline__ float wave_sum(float v) {
#pragma unroll
    for (int o = 32; o > 0; o >>= 1) v += __shfl_xor(v, o);
    return v;
}
template <int CTRL> __device__ __forceinline__ float dppf(float x) {
    return __int_as_float(__builtin_amdgcn_update_dpp(0, __float_as_int(x), CTRL, 0xf, 0xf, true));
}
__device__ __forceinline__ float red16(float x) {
    x += dppf<0xB1>(x);
    x += dppf<0x4E>(x);
    x += dppf<0x141>(x);
    x += dppf<0x140>(x);
    return x;
}

__device__ __forceinline__ void conv_tile_w(char* wl, const float* __restrict__ src, int src_ld, int k0, int c0,
                                            bf16_t* __restrict__ dst, int dst_ld, int n0, const float* __restrict__ mu, int mode, const int lane) {
    float v[64];
    const float* s = src + (size_t)k0 * src_ld + c0 + lane;
#pragma unroll
    for (int i = 0; i < 64; ++i) v[i] = __builtin_nontemporal_load(s + (size_t)i * src_ld);
    if (mode) {
#pragma unroll
        for (int i = 0; i < 64; ++i) { const float m = mu[k0 + i]; v[i] *= (mode == 1) ? m : (1.0f - m); }
    }
#pragma unroll
    for (int q = 0; q < 8; ++q) {
        u32x4 o;
#pragma unroll
        for (int i = 0; i < 4; ++i) o[i] = pk_bf16(v[8 * q + 2 * i], v[8 * q + 2 * i + 1]);
        *(u32x4*)(wl + lane * 144 + q * 16) = o;
    }
    asm volatile("s_waitcnt lgkmcnt(0)" ::: "memory");
#pragma unroll
    for (int i = 0; i < 8; ++i) {
        const int id = i * 64 + lane, r = id >> 3, ch = id & 7;
        const u32x4 o = *(const u32x4*)(wl + r * 144 + ch * 16);
        st_wt16(dst + (size_t)(n0 + r) * dst_ld + k0 + ch * 8, o);
    }
    asm volatile("s_waitcnt lgkmcnt(0)" ::: "memory");
}

__device__ void phase_convert(char* shm) {
    KParams* kp = kargs();
    float* lds = (float*)shm;
    const int tid = tid_l(), lane = tid & 63, wave = __builtin_amdgcn_readfirstlane(tid >> 6);
    float* sc = lds;
    float* red = lds + 3072;
    char* wl = shm + 20480 + wave * (64 * 144);
    for (int i = tid; i < 3072; i += NTHREADS) {
        const int mi = i >> 10, k = i & 1023;
        const float cv = (mi == 0) ? kp->in[4][k] : kp->in[2][(mi - 1) * 1024 + k];
        sc[i] = cv * sigm(cv);
    }
    __syncthreads();
    float* modp = (float*)(kp->ws + OFF_MOD);
    for (int task = blockIdx.x; task < 288; task += gridDim.x) {
        const int kh = task / 144, cgp = task % 144, col = cgp * 64 + lane;
        const int kb = kh * 512 + wave * 64;
        const float* wm = kp->in[5] + (size_t)kb * 9216 + col;
        float a0 = 0.f, a1 = 0.f, a2 = 0.f;
#pragma unroll 16
        for (int i = 0; i < 64; ++i) {
            const float w = __builtin_nontemporal_load(wm + (size_t)i * 9216);
            a0 += sc[kb + i] * w; a1 += sc[1024 + kb + i] * w; a2 += sc[2048 + kb + i] * w;
        }
        red[(wave * 3 + 0) * 64 + lane] = a0; red[(wave * 3 + 1) * 64 + lane] = a1; red[(wave * 3 + 2) * 64 + lane] = a2;
        __syncthreads();
        if (tid < 192) {
            const int m = tid >> 6, cc = tid & 63;
            float s = kh == 0 ? kp->in[6][cgp * 64 + cc] : 0.f;
#pragma unroll
            for (int g = 0; g < 8; ++g) s += red[(g * 3 + m) * 64 + cc];
            modp[(kh * 3 + m) * 9216 + cgp * 64 + cc] = s;
        }
        __syncthreads();
    }
    constexpr int T_W13 = 88 * 16, T_W2 = 16 * 44, T_WIN = 88 * 16, T_LORA = 8 * 16, T_WAB = 16 * 8, T_WO = 16 * 16, T_L2 = 32;
    constexpr int TOTAL = 2 * T_W13 + 2 * T_W2 + T_WIN + T_LORA + 2 * T_WAB + T_WO + T_L2;
    for (int id0 = blockIdx.x * 8 + wave; id0 < TOTAL; id0 += gridDim.x * 8) {
        int id = id0;
        if (id < 2 * T_W13) {
            const int which = id / T_W13; id -= which * T_W13;
            const int nt = id >> 4, kt = id & 15, j = nt >> 2, w = nt & 3;
            const int c0 = (w < 2) ? (128 * j + 64 * w) : (2816 + 128 * j + 64 * (w - 2));
            conv_tile_w(wl, kp->in[which ? 10 : 8], 5632, kt * 64, c0, (bf16_t*)(kp->ws + (which ? OFF_W13B : OFF_W13A)), 1024, nt * 64, nullptr, 0, lane);
            continue;
        }
        id -= 2 * T_W13;
        if (id < 2 * T_W2) {
            const int which = id / T_W2; id -= which * T_W2;
            const int nt = id / 44, kt = id % 44;
            conv_tile_w(wl, kp->in[which ? 11 : 9], 1024, kt * 64, nt * 64, (bf16_t*)(kp->ws + (which ? OFF_W2B : OFF_W2A)), 2816, nt * 64, nullptr, 0, lane);
            continue;
        }
        id -= 2 * T_W2;
        if (id < T_WIN) {
            const int nt = id >> 4, kt = id & 15;
            conv_tile_w(wl, kp->in[12], 5632, kt * 64, nt * 64, (bf16_t*)(kp->ws + OFF_WIN), 1024, nt * 64, nullptr, 0, lane);
            continue;
        }
        id -= T_WIN;
        if (id < T_LORA) {
            const int nt = id >> 4, kt = id & 15;
            const int pq = nt & 1, l = (nt >> 1) & 1, d = nt >> 2;
            const float* src = kp->in[l ? 18 : 15] + (size_t)d * 1024 * 64;
            conv_tile_w(wl, src, 64, kt * 64, 0, (bf16_t*)(kp->ws + OFF_WIN), 1024, 5632 + nt * 64, kp->in[13] + (d * 2 + l) * 1024, pq ? 1 : 2, lane);
            continue;
        }
        id -= T_LORA;
        if (id < 2 * T_WAB) {
            const int which = id / T_WAB; id -= which * T_WAB;
            const int nt = id >> 3, kt = id & 7;
            conv_tile_w(wl, kp->in[which ? 28 : 27], 1024, kt * 64, nt * 64, (bf16_t*)(kp->ws + (which ? OFF_WB : OFF_WA)), 512, nt * 64, nullptr, 0, lane);
            continue;
        }
        id -= 2 * T_WAB;
        if (id < T_WO) {
            const int nt = id >> 4, kt = id & 15;
            conv_tile_w(wl, kp->in[29], 1024, kt * 64, nt * 64, (bf16_t*)(kp->ws + OFF_WO), 1024, nt * 64, nullptr, 0, lane);
            continue;
        }
        id -= T_WO;
        {
            const int dl = id >> 3, nt = id & 7, d = dl >> 1, l = dl & 1;
            const float* src = kp->in[l ? 19 : 16] + (size_t)d * 64 * 512;
            conv_tile_w(wl, src, 512, 0, nt * 64, (bf16_t*)(kp->ws + OFF_L2) + (size_t)dl * 512 * 64, 64, nt * 64, nullptr, 0, lane);
        }
    }
}

__device__ void phase_rowop(const float* __restrict__ xctx, const float* __restrict__ xlat, const bf16_t* __restrict__ P,
                            int gA, int mGate, float sA, float* __restrict__ xdst, int gB, int mShift, int mScale, bf16_t* __restrict__ hdst) {
    KParams* kp = kargs();
    const int tid = tid_l(), lane = tid & 63, wave = tid >> 6;
    const float* G = kp->in[7];
    const float* MOD = (const float*)(kp->ws + OFF_MOD);
    constexpr int RW = 4;
    for (int row0 = (blockIdx.x * 8 + wave) * RW; row0 < NTOK; row0 += gridDim.x * 8 * RW) {
        const int mi = row0 < NCTX ? 0 : 1 + ((row0 - NCTX) >> 11);
        const float* mod = MOD + mi * 9216;
        const float* xs = row0 < NCTX ? xctx + (size_t)row0 * DM : xlat + (size_t)(row0 - NCTX) * DM;
        f32x4 x[RW][4];
#pragma unroll
        for (int r = 0; r < RW; ++r)
#pragma unroll
            for (int i = 0; i < 4; ++i) x[r][i] = __builtin_nontemporal_load((const f32x4*)(xs + (size_t)r * DM + (i * 64 + lane) * 4));
        if (P) {
            u32x2 p0[RW][4], p1[RW][4];
#pragma unroll
            for (int r = 0; r < RW; ++r)
#pragma unroll
                for (int i = 0; i < 4; ++i) {
                    const size_t o = (size_t)(row0 + r) * DM + (i * 64 + lane) * 4;
                    p0[r][i] = __builtin_nontemporal_load((const u32x2*)(P + o)); p1[r][i] = __builtin_nontemporal_load((const u32x2*)(P + (size_t)NTOK * DM + o));
                }
            f32x4 gm[4];
#pragma unroll
            for (int i = 0; i < 4; ++i) {
                const int c = (i * 64 + lane) * 4;
                gm[i] = *(const f32x4*)(G + gA * DM + c) * (*(const f32x4*)(mod + mGate * DM + c) + *(const f32x4*)(mod + 27648 + mGate * DM + c));
            }
            float ss[RW];
#pragma unroll
            for (int r = 0; r < RW; ++r) {
                ss[r] = 0.f;
#pragma unroll
                for (int i = 0; i < 4; ++i) {
                    const f32x4 f = (f32x4){bflo(p0[r][i][0]) + bflo(p1[r][i][0]), bfhi(p0[r][i][0]) + bfhi(p1[r][i][0]), bflo(p0[r][i][1]) + bflo(p1[r][i][1]), bfhi(p0[r][i][1]) + bfhi(p1[r][i][1])};
                    ss[r] += f[0] * f[0] + f[1] * f[1] + f[2] * f[2] + f[3] * f[3];
                }
            }
#pragma unroll
            for (int o = 32; o > 0; o >>= 1) {
#pragma unroll
                for (int r = 0; r < RW; ++r) ss[r] += __shfl_xor(ss[r], o);
            }
#pragma unroll
            for (int r = 0; r < RW; ++r) {
                const float rstd = rsqrtf(ss[r] * (1.0f / DM) + 1e-6f) * sA;
#pragma unroll
                for (int i = 0; i < 4; ++i) {
                    const int c = (i * 64 + lane) * 4;
                    const f32x4 f = (f32x4){bflo(p0[r][i][0]) + bflo(p1[r][i][0]), bfhi(p0[r][i][0]) + bfhi(p1[r][i][0]), bflo(p0[r][i][1]) + bflo(p1[r][i][1]), bfhi(p0[r][i][1]) + bfhi(p1[r][i][1])};
                    x[r][i] += gm[i] * (f * rstd);
                    st_wt16f_nc(xdst + (size_t)(row0 + r) * DM + c, x[r][i]);
                }
            }
        }
        if (hdst) {
            f32x4 gs[4], sh[4];
#pragma unroll
            for (int i = 0; i < 4; ++i) {
                const int c = (i * 64 + lane) * 4;
                gs[i] = *(const f32x4*)(G + gB * DM + c) * (*(const f32x4*)(mod + mScale * DM + c) + *(const f32x4*)(mod + 27648 + mScale * DM + c) + 1.0f);
                sh[i] = *(const f32x4*)(mod + mShift * DM + c) + *(const f32x4*)(mod + 27648 + mShift * DM + c);
            }
            float ss[RW];
#pragma unroll
            for (int r = 0; r < RW; ++r) {
                ss[r] = 0.f;
#pragma unroll
                for (int i = 0; i < 4; ++i) ss[r] += x[r][i][0] * x[r][i][0] + x[r][i][1] * x[r][i][1] + x[r][i][2] * x[r][i][2] + x[r][i][3] * x[r][i][3];
            }
#pragma unroll
            for (int o = 32; o > 0; o >>= 1) {
#pragma unroll
                for (int r = 0; r < RW; ++r) ss[r] += __shfl_xor(ss[r], o);
            }
#pragma unroll
            for (int r = 0; r < RW; ++r) {
                const float rstd = rsqrtf(ss[r] * (1.0f / DM) + 1e-6f);
#pragma unroll
                for (int i = 0; i < 4; ++i) {
                    const int c = (i * 64 + lane) * 4;
                    const f32x4 h = (x[r][i] * rstd) * gs[i] + sh[i];
                    u32x2 o; o[0] = pk_bf16(h[0], h[1]); o[1] = pk_bf16(h[2], h[3]);
                    st_wt8_nc(hdst + (size_t)(row0 + r) * DM + c, o);
                }
            }
        }
    }
}

constexpr int BM = 256, BK = 64, HALF = 128, HT = HALF * BK;
__device__ __forceinline__ int lds_byte(int r, int c) {
    const int st = (r >> 4) * 2 + (c >> 5), rr = r & 15, cc = c & 31, ob = rr * 64 + cc * 2;
    return st * 1024 + (ob ^ (((ob >> 9) & 1) << 5));
}
__device__ __forceinline__ void stage_rc(int b, int& R, int& C) {
    const int st = b / 1024, sb = b % 1024, swz = sb ^ (((sb >> 9) & 1) << 5);
    R = (st >> 1) * 16 + swz / 64; C = (st & 1) * 32 + (swz % 64) / 2;
}
__device__ __forceinline__ void unit_map(int wgid, int nM, int nN, int& pm, int& pn) {
    const int NXCD = 8, WGM = 8, nwg = nM * nN;
    { const int q = nwg / NXCD, r = nwg % NXCD, xcd = wgid % NXCD, off = wgid / NXCD; wgid = (xcd < r ? xcd * (q + 1) : r * (q + 1) + (xcd - r) * q) + off; }
    const int nig = WGM * nN, gid = wgid / nig, fm = gid * WGM, gsz = min(nM - fm, WGM);
    pm = fm + ((wgid % nig) % gsz); pn = (wgid % nig) / gsz;
}

#define LAS __attribute__((address_space(3)))
constexpr int HTB = HALF * BK * 2;
__device__ __forceinline__ void gemm_tile(char* shmc, const bf16_t* __restrict__ A, int lda, const bf16_t* __restrict__ Bt, int ldb,
                                          int brow, int bcol, int nt, f32x4 (&acc)[2][2][4][2], const int tid) {
    LAS unsigned char* lds = (LAS unsigned char*)shmc;
    const int wid = __builtin_amdgcn_readfirstlane(tid >> 6), lane = tid & 63, wr = wid >> 2, wc = wid & 3, fr = lane & 15, fq = lane >> 4;
    unsigned voffA[2], voffB[2];
#pragma unroll
    for (int i = 0; i < 2; ++i) { int R, C; stage_rc(tid * 16 + i * 8192, R, C); voffA[i] = (unsigned)(R * lda + C) * 2u; voffB[i] = (unsigned)(R * ldb + C) * 2u; }
    const size_t kstep = (size_t)(BK * 2);
    const size_t hstepA = (size_t)HALF * lda * 2, hstepB = (size_t)HALF * ldb * 2;
    const unsigned ldsw = (unsigned)wid * 1024u;
    const int aoff = lds_byte(wr * 64 + fr, fq * 8), boff = lds_byte(wc * 32 + fr, fq * 8);
    const char* cA = (const char*)A + (size_t)brow * lda * 2;
    const char* cB = (const char*)Bt + (size_t)bcol * ldb * 2;
#define SA(b, h) (((b) * 2 + (h)) * HTB)
#define SB(b, h) ((4 + (b) * 2 + (h)) * HTB)
#define STAGE(bufoff, gbase, voff) do { _Pragma("unroll") for (int _i = 0; _i < 2; ++_i) \
    __builtin_amdgcn_global_load_lds((const unsigned*)((const char*)(gbase) + (voff)[_i]), (LAS unsigned*)(lds + (bufoff) + ldsw + _i * 8192), 16, 0, 0); } while (0)
#define LDA(dst, b, h) do { _Pragma("unroll") for (int m = 0; m < 4; ++m) _Pragma("unroll") for (int k = 0; k < 2; ++k) dst[m][k] = *(const LAS bf16x8*)(lds + SA(b, h) + aoff + m * 2048 + k * 1024); } while (0)
#define LDB(dst, b, h) do { _Pragma("unroll") for (int n = 0; n < 2; ++n) _Pragma("unroll") for (int k = 0; k < 2; ++k) dst[n][k] = *(const LAS bf16x8*)(lds + SB(b, h) + boff + n * 2048 + k * 1024); } while (0)
#define MMA(ai, bj, At_, Bt_) do { __builtin_amdgcn_s_setprio(1); _Pragma("unroll") for (int m = 0; m < 4; ++m) _Pragma("unroll") for (int n = 0; n < 2; ++n) _Pragma("unroll") for (int k = 0; k < 2; ++k) \
      acc[ai][bj][m][n] = __builtin_amdgcn_mfma_f32_16x16x32_bf16(Bt_[n][k], At_[m][k], acc[ai][bj][m][n], 0, 0, 0); \
    __builtin_amdgcn_s_setprio(0); } while (0)
#define WAIT_V(n) asm volatile("s_waitcnt vmcnt(" #n ")" ::: "memory")
#define WAIT_L(n) asm volatile("s_waitcnt lgkmcnt(" #n ")" ::: "memory")
#define BAR __builtin_amdgcn_s_barrier()
#define SCHED __builtin_amdgcn_sched_barrier(0)
#pragma unroll
    for (int a = 0; a < 2; ++a)
#pragma unroll
        for (int b = 0; b < 2; ++b)
#pragma unroll
            for (int m = 0; m < 4; ++m)
#pragma unroll
                for (int n = 0; n < 2; ++n) acc[a][b][m][n] = (f32x4){0.f, 0.f, 0.f, 0.f};
    bf16x8 At[4][2], B0[2][2], B1[2][2];
    STAGE(SB(0, 0), cB, voffB); STAGE(SA(0, 0), cA, voffA); STAGE(SB(0, 1), cB + hstepB, voffB); STAGE(SA(0, 1), cA + hstepA, voffA);
    if (wr == 1) BAR;
    WAIT_V(4); BAR;
    STAGE(SB(1, 0), cB + kstep, voffB); STAGE(SA(1, 0), cA + kstep, voffA); STAGE(SB(1, 1), cB + hstepB + kstep, voffB);
    WAIT_V(6); BAR;
    for (int t = 0; t < nt - 2; t += 2) {
        const char* a1 = cA + (size_t)(t + 1) * kstep;
        const char* a2 = cA + (size_t)(t + 2) * kstep; const char* b2 = cB + (size_t)(t + 2) * kstep;
        const char* a3 = a2 + kstep; const char* b3 = b2 + kstep;
        LDB(B0, 0, 0); SCHED; LDA(At, 0, 0); STAGE(SA(1, 1), a1 + hstepA, voffA);
        WAIT_L(8); BAR; WAIT_L(0); MMA(0, 0, At, B0); BAR; SCHED;
        LDB(B1, 0, 1); STAGE(SB(0, 0), b2, voffB);
        BAR; WAIT_L(0); MMA(0, 1, At, B1); BAR;
        LDA(At, 0, 1); STAGE(SA(0, 0), a2, voffA);
        BAR; WAIT_L(0); MMA(1, 0, At, B0); BAR; SCHED;
        STAGE(SB(0, 1), b2 + hstepB, voffB);
        WAIT_V(6); BAR; MMA(1, 1, At, B1); BAR;
        LDB(B0, 1, 0); SCHED; LDA(At, 1, 0); STAGE(SA(0, 1), a2 + hstepA, voffA);
        WAIT_L(8); BAR; WAIT_L(0); MMA(0, 0, At, B0); BAR; SCHED;
        LDB(B1, 1, 1); STAGE(SB(1, 0), b3, voffB);
        BAR; WAIT_L(0); MMA(0, 1, At, B1); BAR;
        LDA(At, 1, 1); STAGE(SA(1, 0), a3, voffA);
        BAR; WAIT_L(0); MMA(1, 0, At, B0); BAR; SCHED;
        STAGE(SB(1, 1), b3 + hstepB, voffB);
        WAIT_V(6); BAR; MMA(1, 1, At, B1); BAR;
    }
    { const char* a1 = cA + (size_t)(nt - 1) * kstep;
      LDB(B0, 0, 0); LDA(At, 0, 0); STAGE(SA(1, 1), a1 + hstepA, voffA);
      BAR; WAIT_L(0); MMA(0, 0, At, B0); BAR;
      LDB(B1, 0, 1); BAR; WAIT_L(0); MMA(0, 1, At, B1); BAR;
      LDA(At, 0, 1); WAIT_V(4); BAR; WAIT_L(0); MMA(1, 0, At, B0); MMA(1, 1, At, B1); BAR; }
    { LDB(B0, 1, 0); LDA(At, 1, 0); WAIT_V(2); BAR; WAIT_L(0); MMA(0, 0, At, B0); BAR;
      LDB(B1, 1, 1); WAIT_V(0); BAR; WAIT_L(0); MMA(0, 1, At, B1); BAR;
      LDA(At, 1, 1); BAR; WAIT_L(0); MMA(1, 0, At, B0); MMA(1, 1, At, B1); BAR; }
    if (wr == 0) BAR;
#undef SA
#undef SB
#undef STAGE
#undef LDA
#undef LDB
#undef MMA
}

struct GemmJob {
    const bf16_t* A0; const bf16_t* A1; const bf16_t* Bt0; const bf16_t* Bt1;
    int lda, ldb, nN, nsplit, nt, kstride, mode, pad;
    void* o1; void* o2; const bf16_t* Z;
};
__device__ void phase_gemm(char* shm, const GemmJob& J) {
    const int tid = tid_l();
    const int wid = __builtin_amdgcn_readfirstlane(tid >> 6), wr = wid >> 2, wc = wid & 3;
    const int nM = 32, nN = J.nN, nMN = nM * nN;
    const int mode = J.mode;
    for (int u = blockIdx.x; u < nMN * J.nsplit; u += gridDim.x) {
        const int ks = u / nMN;
        int pm, pn; unit_map(u - ks * nMN, nM, nN, pm, pn);
        {
            const int sub = ks;
            f32x4 acc[2][2][4][2];
            const size_t koff = (size_t)ks * J.kstride;
            gemm_tile(shm, (ks ? J.A1 : J.A0) + koff, J.lda, (ks ? J.Bt1 : J.Bt0) + koff, J.ldb, pm * BM, pn * BM, J.nt, acc, tid);
            int lane_e = tid & 63; asm volatile("" : "+v"(lane_e));
            const int fr = lane_e & 15, fq = lane_e >> 4;
            const int NBJ = (mode == 0) ? 1 : 2;
            const int W8 = NBJ * 16;
            const int pitch = NBJ * 256 + 32;
            bf16_t* obase; int old_, col0;
            if (mode == 0)      { obase = (bf16_t*)J.o1; old_ = DFF; col0 = pn * 128; }
            else if (mode == 1) { obase = (bf16_t*)J.o1 + (size_t)ks * NTOK * DM; old_ = DM; col0 = pn * BM; }
            else if (mode == 2) { obase = (bf16_t*)J.o1; old_ = ZLD; col0 = pn * BM; }
            else                { obase = (bf16_t*)(sub ? J.o2 : J.o1); old_ = DM; col0 = pn * BM; }
            const bf16_t* Zg = J.Z + (sub ? 4608 : 3584);
#pragma unroll
            for (int ai = 0; ai < 2; ++ai) {
#pragma unroll
                for (int m = 0; m < 4; ++m) {
                    const int rloc = wr * 64 + m * 16 + fr;
                    const int row = pm * BM + ai * HALF + rloc;
#pragma unroll
                    for (int n = 0; n < 2; ++n) {
                        if (mode == 0) {
                            const f32x4 g = acc[ai][0][m][n], up = acc[ai][1][m][n];
                            float o[4];
#pragma unroll
                            for (int j = 0; j < 4; ++j) o[j] = g[j] * sigm(g[j]) * up[j];
                            u32x2 v; v[0] = pk_bf16(o[0], o[1]); v[1] = pk_bf16(o[2], o[3]);
                            *(u32x2*)(shm + rloc * pitch + (wc * 32 + n * 16 + fq * 4) * 2) = v;
                        } else {
#pragma unroll
                            for (int bj = 0; bj < 2; ++bj) {
                                const int cl = bj * HALF + wc * 32 + n * 16 + fq * 4;
                                f32x4 a = acc[ai][bj][m][n];
                                if (mode == 3) {
                                    const u32x2 gz = *(const u32x2*)(Zg + (size_t)row * ZLD + col0 + cl);
                                    a[0] *= sigm(bflo(gz[0])); a[1] *= sigm(bfhi(gz[0])); a[2] *= sigm(bflo(gz[1])); a[3] *= sigm(bfhi(gz[1]));
                                }
                                u32x2 v; v[0] = pk_bf16(a[0], a[1]); v[1] = pk_bf16(a[2], a[3]);
                                *(u32x2*)(shm + rloc * pitch + cl * 2) = v;
                            }
                        }
                    }
                }
                __syncthreads();
                const int w8sh = (mode == 0) ? 4 : 5;
                for (int c = tid; c < 128 * W8; c += NTHREADS) {
                    const int r = c >> w8sh, cc = c & (W8 - 1);
                    const u32x4 v = *(const u32x4*)(shm + r * pitch + cc * 16);
                    st_wt16(obase + (size_t)(pm * BM + ai * HALF + r) * old_ + col0 + cc * 8, v);
                }
                __syncthreads();
            }
        }
    }
}

__device__ void phase_prep(char* shm) {
    KParams* kp = kargs();
    const int tid = tid_l(), lane = tid & 63, wave = tid >> 6, fr = lane & 15, fq = lane >> 4;
    float* wt = (float*)shm + wave * (16 * 68);
    const bf16_t* Z = (const bf16_t*)(kp->ws + OFF_R1);
    const bf16_t* L2T = (const bf16_t*)(kp->ws + OFF_L2);
    bf16_t* KK = (bf16_t*)(kp->ws + OFF_R2 + R2_KK);
    float* WD = (float*)(kp->ws + OFF_R2 + R2_WD);
    bf16_t* KD = (bf16_t*)(kp->ws + OFF_R2 + R2_KD);
    bf16_t* BB = (bf16_t*)(kp->ws + OFF_R2 + R2_BB);
    float* BONUS = (float*)(kp->ws + OFF_BONUS);
    for (int unit = blockIdx.x * 8 + wave; unit < 2048; unit += gridDim.x * 8) {
        const int hq = unit & 1, d = (unit >> 1) & 1, tg = unit >> 2;
        const int row = tg * 16 + fr;
        const bool lat = row >= NCTX;
        const int pos = lat ? ((row - NCTX) & 2047) : (row & 255);
        const int T = lat ? 2048 : 256;
        const bool valid = d == 0 ? (pos > 0) : (pos < T - 1);
        const int srow = valid ? (d == 0 ? row - 1 : row + 1) : row;
        bf16x8 Bz[2][2];
#pragma unroll
        for (int l = 0; l < 2; ++l)
#pragma unroll
            for (int ks = 0; ks < 2; ++ks) {
                const int k = ks * 32 + fq * 8;
                const u32x4 Pv = *(const u32x4*)(Z + (size_t)row * ZLD + 5632 + ((d * 2 + l) * 2 + 0) * 64 + k);
                u32x4 Qv = *(const u32x4*)(Z + (size_t)srow * ZLD + 5632 + ((d * 2 + l) * 2 + 1) * 64 + k);
                if (!valid) Qv = (u32x4){0u, 0u, 0u, 0u};
                u32x4 o;
#pragma unroll
                for (int i = 0; i < 4; ++i) {
                    float z0 = bflo(Pv[i]) + bflo(Qv[i]), z1 = bfhi(Pv[i]) + bfhi(Qv[i]);
                    if (l == 0) {
                        z0 = 1.0f - 2.0f * __builtin_amdgcn_rcpf(__expf(2.0f * z0) + 1.0f);
                        z1 = 1.0f - 2.0f * __builtin_amdgcn_rcpf(__expf(2.0f * z1) + 1.0f);
                    }
                    o[i] = pk_bf16(z0, z1);
                }
                Bz[l][ks] = __builtin_bit_cast(bf16x8, o);
            }
        for (int hh = hq * 4; hh < hq * 4 + 4; ++hh) {
            f32x4 accw[4], acca[4];
#pragma unroll
            for (int mt = 0; mt < 4; ++mt) {
                accw[mt] = (f32x4){0.f, 0.f, 0.f, 0.f}; acca[mt] = (f32x4){0.f, 0.f, 0.f, 0.f};
#pragma unroll
                for (int ks = 0; ks < 2; ++ks) {
                    const bf16x8 Aw = *(const bf16x8*)(L2T + ((size_t)(d * 2 + 0) * 512 + hh * 64 + mt * 16 + fr) * 64 + ks * 32 + fq * 8);
                    const bf16x8 Aa = *(const bf16x8*)(L2T + ((size_t)(d * 2 + 1) * 512 + hh * 64 + mt * 16 + fr) * 64 + ks * 32 + fq * 8);
                    accw[mt] = __builtin_amdgcn_mfma_f32_16x16x32_bf16(Aw, Bz[0][ks], accw[mt], 0, 0, 0);
                    acca[mt] = __builtin_amdgcn_mfma_f32_16x16x32_bf16(Aa, Bz[1][ks], acca[mt], 0, 0, 0);
                }
            }
            float ss = 0.f, bon = 0.f;
            f32x4 kkr[4], kd[4];
#pragma unroll
            for (int mt = 0; mt < 4; ++mt) {
                const int c = hh * 64 + mt * 16 + fq * 4;
                const f32x4 w0 = *(const f32x4*)(kp->in[14] + d * 512 + c), a0 = *(const f32x4*)(kp->in[17] + d * 512 + c);
                const f32x4 kkp = *(const f32x4*)(kp->in[20] + c), kap = *(const f32x4*)(kp->in[21] + c), rkp = *(const f32x4*)(kp->in[22] + c);
                const u32x2 kz = *(const u32x2*)(Z + (size_t)row * ZLD + 512 + c), rz = *(const u32x2*)(Z + (size_t)row * ZLD + c);
                const float kv[4] = {bflo(kz[0]), bfhi(kz[0]), bflo(kz[1]), bfhi(kz[1])};
                const float rv[4] = {bflo(rz[0]), bfhi(rz[0]), bflo(rz[1]), bfhi(rz[1])};
#pragma unroll
                for (int j = 0; j < 4; ++j) {
                    const float xw = accw[mt][j] + w0[j];
                    accw[mt][j] = __expf(-0.60653065971f * sigm(xw));
                    const float a = sigm(acca[mt][j] + a0[j]);
                    acca[mt][j] = a;
                    const float kr = kv[j] * kkp[j];
                    kkr[mt][j] = kr; ss += kr * kr;
                    const float kdd = kv[j] * (1.0f + (a - 1.0f) * kap[j]);
                    kd[mt][j] = kdd;
                    bon += rv[j] * kdd * rkp[j];
                }
            }
            ss += __shfl_xor(ss, 16); ss += __shfl_xor(ss, 32);
            bon += __shfl_xor(bon, 16); bon += __shfl_xor(bon, 32);
            const float inv = rsqrtf(ss + 1e-12f);
            const int row0 = tg * 16;
#pragma unroll
            for (int pass = 0; pass < 4; ++pass) {
                if (pass == 3 && d != 0) break;
#pragma unroll
                for (int mt = 0; mt < 4; ++mt) {
                    f32x4 val;
                    if (pass == 0) val = accw[mt];
                    else if (pass == 1) val = kd[mt];
                    else if (pass == 2) val = kkr[mt] * inv * acca[mt];
                    else val = kkr[mt] * inv;
                    *(f32x4*)(wt + fr * 68 + mt * 16 + fq * 4) = val;
                }
                asm volatile("s_waitcnt lgkmcnt(0)" ::: "memory");
#pragma unroll
                for (int i = 0; i < 4; ++i) {
                    const int id = i * 64 + lane, tk = id >> 4, c4 = (id & 15) * 4;
                    const f32x4 val = *(const f32x4*)(wt + tk * 68 + c4);
                    const size_t o = ((size_t)d * NTOK + row0 + tk) * DR + hh * 64 + c4;
                    if (pass == 0) *(f32x4*)(WD + o) = val;
                    else {
                        u32x2 v; v[0] = pk_bf16(val[0], val[1]); v[1] = pk_bf16(val[2], val[3]);
                        if (pass == 1) *(u32x2*)(KD + o) = v;
                        else if (pass == 2) *(u32x2*)(BB + o) = v;
                        else *(u32x2*)(KK + (size_t)(row0 + tk) * DR + hh * 64 + c4) = v;
                    }
                }
                asm volatile("s_waitcnt lgkmcnt(0)" ::: "memory");
            }
            if (fq == 0) BONUS[((size_t)d * NTOK + row) * 8 + hh] = bon;
        }
    }
}

__device__ __forceinline__ float red16x4(float p0, float p1, float p2, float p3, const bool b0, const bool b1) {
    const float own01 = b0 ? p1 : p0, snd01 = b0 ? p0 : p1;
    const float own23 = b0 ? p3 : p2, snd23 = b0 ? p2 : p3;
    const float r01 = own01 + dppf<0xB1>(snd01);
    const float r23 = own23 + dppf<0xB1>(snd23);
    const float own = b1 ? r23 : r01, snd = b1 ? r01 : r23;
    float r = own + dppf<0x4E>(snd);
    r += dppf<0x124>(r);
    r += dppf<0x128>(r);
    return r;
}
constexpr int TC = 32, STEP_F = 352;
typedef float f32x2 __attribute__((ext_vector_type(2)));
constexpr int SCAN_IN_F = TC * STEP_F;
constexpr int SCAN_Y_OFF = 2 * SCAN_IN_F;
struct ChunkDesc { int base, T, d, h, rq, c, b; bool first, last; };
template <bool LAT> __device__ __forceinline__ ChunkDesc chunk_desc(int slot, int g) {
    ChunkDesc q;
    if (LAT) {
        const int chain = slot >> 2; q.rq = slot & 3; q.b = chain >> 4; q.h = (chain >> 1) & 7; q.d = chain & 1;
        q.T = 2048; q.base = NCTX + q.b * 2048; q.c = g; q.first = g == 0; q.last = false;
    } else {
        const int u = slot * 4 + (g >> 3), chain = u >> 1; q.rq = u & 1; q.b = chain >> 4; q.h = (chain >> 1) & 7; q.d = chain & 1;
        q.T = 256; q.base = q.b * 256; q.c = g & 7; q.first = q.c == 0; q.last = q.c == 7;
    }
    return q;
}
__device__ __forceinline__ void st4(float* dst, unsigned a, unsigned b) {
    *(f32x4*)dst = (f32x4){bflo(a), bfhi(a), bflo(b), bfhi(b)};
}
struct LReg { u32x4 r8, k8, kk8, b8, v8; f32x4 w0, w1; };

template <bool LAT> __device__ __forceinline__ void scan_pass(char* shm, const int tid, const int slot) {
    constexpr int NSW = 4, RPL = LAT ? 1 : 2, RB = NSW * 4 * RPL, NCH = LAT ? 64 : 32;
    KParams* kp = kargs();
    float* lds = (float*)shm;
    const int wave = __builtin_amdgcn_readfirstlane(tid >> 6), lane = tid & 63;
    const bf16_t* Z = (const bf16_t*)(kp->ws + OFF_R1);
    const bf16_t* KK = (const bf16_t*)(kp->ws + OFF_R2 + R2_KK);
    const float* WD = (const float*)(kp->ws + OFF_R2 + R2_WD);
    const bf16_t* KD = (const bf16_t*)(kp->ws + OFF_R2 + R2_KD);
    const bf16_t* BB = (const bf16_t*)(kp->ws + OFF_R2 + R2_BB);
    bf16_t* Y = (bf16_t*)(kp->ws + OFF_H);
    float* OST = kp->out + (size_t)NTOK * DM;
    const float* ST0 = kp->in[3];
    {
        if (wave >= 4) {
            const int lt = tid - 256, s = lt >> 3, cg8 = (lt & 7) * 8;
            constexpr int NV = TC * RB / 8;
            LReg R;
            auto ld_chunk = [&](int g) {
                const ChunkDesc q = chunk_desc<LAT>(slot, g);
                const int tt = q.c * TC + s, t = q.d ? q.T - 1 - tt : tt, row = q.base + t;
                const int ch = q.h * 64 + cg8;
                const size_t od = ((size_t)q.d * NTOK + row) * DR + ch;
                R.r8 = *(const u32x4*)(Z + (size_t)row * ZLD + ch);
                R.w0 = *(const f32x4*)(WD + od); R.w1 = *(const f32x4*)(WD + od + 4);
                R.k8 = *(const u32x4*)(KD + od);
                R.kk8 = *(const u32x4*)(KK + (size_t)row * DR + ch);
                R.b8 = *(const u32x4*)(BB + od);
                if (lt < NV) {
                    const int s2 = lt / (RB / 8), hf = lt % (RB / 8);
                    const int tt2 = q.c * TC + s2, t2 = q.d ? q.T - 1 - tt2 : tt2, row2 = q.base + t2;
                    R.v8 = *(const u32x4*)(Z + (size_t)row2 * ZLD + 1024 + q.h * 64 + q.rq * RB + hf * 8);
                }
            };
            ld_chunk(0);
            for (int g = -1; g <= NCH; ++g) {
                if (g + 1 <= NCH - 1) {
                    float* buf = lds + ((g + 1) & 1) * SCAN_IN_F;
                    float* L = buf + s * STEP_F + cg8;
                    st4(L, R.r8[0], R.r8[1]); st4(L + 4, R.r8[2], R.r8[3]);
                    *(f32x4*)(L + 64) = R.w0; *(f32x4*)(L + 68) = R.w1;
                    st4(L + 128, R.k8[0], R.k8[1]); st4(L + 132, R.k8[2], R.k8[3]);
                    st4(L + 192, R.kk8[0], R.kk8[1]); st4(L + 196, R.kk8[2], R.kk8[3]);
                    st4(L + 256, R.b8[0], R.b8[1]); st4(L + 260, R.b8[2], R.b8[3]);
                    if (lt < NV) {
                        const int s2 = lt / (RB / 8), hf = lt % (RB / 8);
                        float* Lv = buf + s2 * STEP_F + 320 + hf * 8;
                        st4(Lv, R.v8[0], R.v8[1]); st4(Lv + 4, R.v8[2], R.v8[3]);
                    }
                }
                if (g + 2 <= NCH - 1) ld_chunk(g + 2);
                if (g >= 1) {
                    const ChunkDesc q = chunk_desc<LAT>(slot, g - 1);
                    const float* yb = lds + SCAN_Y_OFF + ((g - 1) & 1) * (TC * RB);
#pragma unroll
                    for (int i = lt; i < TC * RB / 2; i += 256) {
                        const int sy = i / (RB / 2), r2 = (i % (RB / 2)) * 2;
                        const int tt = q.c * TC + sy, t = q.d ? q.T - 1 - tt : tt, row = q.base + t;
                        const f32x2 yv = *(const f32x2*)(yb + sy * RB + r2);
                        *(unsigned*)(Y + ((size_t)q.d * NTOK + row) * DR + q.h * 64 + q.rq * RB + r2) = pk_bf16(yv[0], yv[1]);
                    }
                }
                __syncthreads();
            }
        } else if (wave < NSW) {
            const int rl = lane >> 4, qq = lane & 15;
            f32x2 Sa[RPL], Sb[RPL];
#pragma unroll
            for (int j = 0; j < RPL; ++j) { Sa[j] = (f32x2){0.f, 0.f}; Sb[j] = (f32x2){0.f, 0.f}; }
            __syncthreads();
            for (int g = 0; g <= NCH - 1; ++g) {
                const ChunkDesc q = chunk_desc<LAT>(slot, g);
                const float* buf = lds + (g & 1) * SCAN_IN_F;
                const int rloc = wave * RPL * 4 + rl;
                float* yb = lds + SCAN_Y_OFF + (g & 1) * (TC * RB) + rloc;
                if (q.first) {
#pragma unroll
                    for (int j = 0; j < RPL; ++j) {
                        if (LAT) {
                            const int irow = q.rq * RB + rloc + 4 * j;
                            const f32x4 s = *(const f32x4*)(ST0 + ((size_t)((q.b * 2 + q.d) * 8 + q.h) * 64 + irow) * 64 + qq * 4);
                            Sa[j] = (f32x2){s[0], s[1]}; Sb[j] = (f32x2){s[2], s[3]};
                        } else { Sa[j] = (f32x2){0.f, 0.f}; Sb[j] = (f32x2){0.f, 0.f}; }
                    }
                }
                const float* Lq = buf + qq * 4;
                const float* Lv = buf + 320 + rloc;
                f32x4 r4 = *(const f32x4*)(Lq), w4 = *(const f32x4*)(Lq + 64), k4 = *(const f32x4*)(Lq + 128), n4 = *(const f32x4*)(Lq + 192), b4 = *(const f32x4*)(Lq + 256);
                f32x4 r4n = *(const f32x4*)(Lq + STEP_F), w4n = *(const f32x4*)(Lq + STEP_F + 64), k4n = *(const f32x4*)(Lq + STEP_F + 128), n4n = *(const f32x4*)(Lq + STEP_F + 192), b4n = *(const f32x4*)(Lq + STEP_F + 256);
                float v[RPL], vn[RPL], yp[RPL][4];
                const bool qb0 = (qq & 1) != 0, qb1 = (qq & 2) != 0;
                float* ybq = yb + (qq & 3) * RB;
#pragma unroll
                for (int j = 0; j < RPL; ++j) { v[j] = Lv[4 * j]; vn[j] = Lv[STEP_F + 4 * j]; }
#pragma unroll
                for (int s = 0; s < TC; ++s) {
                    const int s2 = (s + 2 < TC) ? s + 2 : TC - 1;
                    const float* Ln = Lq + s2 * STEP_F;
                    const f32x4 r4m = *(const f32x4*)(Ln), w4m = *(const f32x4*)(Ln + 64), k4m = *(const f32x4*)(Ln + 128), n4m = *(const f32x4*)(Ln + 192), b4m = *(const f32x4*)(Ln + 256);
                    float vm[RPL];
#pragma unroll
                    for (int j = 0; j < RPL; ++j) vm[j] = Lv[s2 * STEP_F + 4 * j];
#pragma unroll
                    for (int j = 0; j < RPL; ++j) {
                        f32x2 pp = Sa[j] * (f32x2){n4[0], n4[1]};
                        pp = Sb[j] * (f32x2){n4[2], n4[3]} + pp;
                        float pd = pp[0] + pp[1];
                        const f32x2 vv = {v[j], v[j]};
                        f32x2 Ta = (f32x2){k4[0], k4[1]} * vv, Tb = (f32x2){k4[2], k4[3]} * vv;
                        Ta = Sa[j] * (f32x2){w4[0], w4[1]} + Ta; Tb = Sb[j] * (f32x2){w4[2], w4[3]} + Tb;
                        pd = red16(pd);
                        const f32x2 np = {-pd, -pd};
                        Sa[j] = (f32x2){b4[0], b4[1]} * np + Ta; Sb[j] = (f32x2){b4[2], b4[3]} * np + Tb;
                        f32x2 yy = Sa[j] * (f32x2){r4[0], r4[1]};
                        yy = Sb[j] * (f32x2){r4[2], r4[3]} + yy;
                        yp[j][s & 3] = yy[0] + yy[1];
                        if ((s & 3) == 3) ybq[(s - 3) * RB + 4 * j] = red16x4(yp[j][0], yp[j][1], yp[j][2], yp[j][3], qb0, qb1);
                    }
                    r4 = r4n; w4 = w4n; k4 = k4n; n4 = n4n; b4 = b4n;
                    r4n = r4m; w4n = w4m; k4n = k4m; n4n = n4m; b4n = b4m;
#pragma unroll
                    for (int j = 0; j < RPL; ++j) { v[j] = vn[j]; vn[j] = vm[j]; }
                }
                if (!LAT && q.last) {
#pragma unroll
                    for (int j = 0; j < RPL; ++j) {
                        const int irow = q.rq * RB + rloc + 4 * j;
                        *(f32x4*)(OST + ((size_t)((q.b * 2 + q.d) * 8 + q.h) * 64 + irow) * 64 + qq * 4) = (f32x4){Sa[j][0], Sa[j][1], Sb[j][0], Sb[j][1]};
                    }
                }
                __syncthreads();
            }
            __syncthreads();
        } else {
            for (int g = -1; g <= NCH; ++g) __syncthreads();
        }
    }
}
__device__ void phase_scan(char* shm) {
    const int tid = tid_l();
    for (int slot = blockIdx.x; slot < 256; slot += gridDim.x) {
        if (slot < 128) scan_pass<true>(shm, tid, slot);
        else scan_pass<false>(shm, tid, slot - 128);
        __syncthreads();
    }
}

__device__ void phase_post() {
    KParams* kp = kargs();
    const int tid = tid_l(), lane = tid & 63, wave = tid >> 6;
    const bf16_t* Z = (const bf16_t*)(kp->ws + OFF_R1);
    const bf16_t* Y = (const bf16_t*)(kp->ws + OFF_H);
    const float* BONUS = (const float*)(kp->ws + OFF_BONUS);
    bf16_t* YA = (bf16_t*)(kp->ws + OFF_R2 + R2_YA);
    bf16_t* YB = (bf16_t*)(kp->ws + OFF_R2 + R2_YB);
    const int c = lane * 8, head = lane >> 3;
    for (int row = blockIdx.x * 8 + wave; row < NTOK; row += gridDim.x * 8) {
        const u32x4 y0 = *(const u32x4*)(Y + (size_t)row * DR + c), y1 = *(const u32x4*)(Y + ((size_t)NTOK + row) * DR + c);
        float y[8];
#pragma unroll
        for (int i = 0; i < 4; ++i) { y[2 * i] = bflo(y0[i]) + bflo(y1[i]); y[2 * i + 1] = bfhi(y0[i]) + bfhi(y1[i]); }
        float s = 0.f;
#pragma unroll
        for (int i = 0; i < 8; ++i) s += y[i];
        s += __shfl_xor(s, 1); s += __shfl_xor(s, 2); s += __shfl_xor(s, 4);
        const float mean = s * (1.0f / 64.0f);
        float vs = 0.f;
#pragma unroll
        for (int i = 0; i < 8; ++i) { y[i] -= mean; vs += y[i] * y[i]; }
        vs += __shfl_xor(vs, 1); vs += __shfl_xor(vs, 2); vs += __shfl_xor(vs, 4);
        const float rs = rsqrtf(vs * (1.0f / 64.0f) + 64e-5f);
        const float bon = BONUS[(size_t)row * 8 + head] + BONUS[((size_t)NTOK + row) * 8 + head];
        const u32x4 vz = *(const u32x4*)(Z + (size_t)row * ZLD + 1024 + c), gz = *(const u32x4*)(Z + (size_t)row * ZLD + 1536 + c);
        const f32x4 gn0 = *(const f32x4*)(kp->in[23] + c), gn1 = *(const f32x4*)(kp->in[23] + c + 4);
        const f32x4 gb0 = *(const f32x4*)(kp->in[24] + c), gb1 = *(const f32x4*)(kp->in[24] + c + 4);
        float o[8];
#pragma unroll
        for (int i = 0; i < 8; ++i) {
            const float vv = (i & 1) ? bfhi(vz[i >> 1]) : bflo(vz[i >> 1]);
            const float gg = (i & 1) ? bfhi(gz[i >> 1]) : bflo(gz[i >> 1]);
            const float gain = i < 4 ? gn0[i & 3] : gn1[i & 3], bias = i < 4 ? gb0[i & 3] : gb1[i & 3];
            o[i] = (y[i] * rs * gain + bias + bon * vv) * sigm(gg);
        }
        u32x4 ov;
#pragma unroll
        for (int i = 0; i < 4; ++i) ov[i] = pk_bf16(o[2 * i], o[2 * i + 1]);
        *(u32x4*)(YA + (size_t)row * DR + c) = ov;
        const bool lat = row >= NCTX;
        const int pos = lat ? ((row - NCTX) & 63) : (row & 255);
        const int last = lat ? 63 : 255;
        const bool vl = pos > 0, vr = pos < last;
        const int rl = vl ? row - 1 : row, rr = vr ? row + 1 : row;
        const u32x4 ccm = *(const u32x4*)(Z + (size_t)row * ZLD + 2560 + c), xcm = *(const u32x4*)(Z + (size_t)row * ZLD + 3072 + c);
        const u32x4 ccl = *(const u32x4*)(Z + (size_t)rl * ZLD + 2560 + c), xcl = *(const u32x4*)(Z + (size_t)rl * ZLD + 3072 + c);
        const u32x4 ccr = *(const u32x4*)(Z + (size_t)rr * ZLD + 2560 + c), xcr = *(const u32x4*)(Z + (size_t)rr * ZLD + 3072 + c);
        const u32x4 cbz = *(const u32x4*)(Z + (size_t)row * ZLD + 2048 + c);
        const float fl = vl ? 1.f : 0.f, frr = vr ? 1.f : 0.f;
#pragma unroll
        for (int i = 0; i < 8; ++i) {
            const int w = i >> 1; const bool hi = i & 1;
            const float um = (hi ? bfhi(ccm[w]) : bflo(ccm[w])) * (hi ? bfhi(xcm[w]) : bflo(xcm[w]));
            const float ul = (hi ? bfhi(ccl[w]) : bflo(ccl[w])) * (hi ? bfhi(xcl[w]) : bflo(xcl[w])) * fl;
            const float ur = (hi ? bfhi(ccr[w]) : bflo(ccr[w])) * (hi ? bfhi(xcr[w]) : bflo(xcr[w])) * frr;
            const float cb = hi ? bfhi(cbz[w]) : bflo(cbz[w]);
            const float cv = ul * kp->in[25][c + i] + um * kp->in[25][512 + c + i] + ur * kp->in[25][1024 + c + i] + kp->in[26][c + i];
            o[i] = cb * cv;
        }
#pragma unroll
        for (int i = 0; i < 4; ++i) ov[i] = pk_bf16(o[2 * i], o[2 * i + 1]);
        *(u32x4*)(YB + (size_t)row * DR + c) = ov;
    }
}

#define XB_TMO      128
#define XB_XCNT(j)  (256  + 64 * (j))
#define XB_XSUB(j)  (1280 + 64 * (j))
#define XB_XGEN(j)  (2304 + 64 * (j))
#define XB_TOP      3328
#define XB_TOPGEN   3392
#define XCD_BAR_WORDS 3456
#define XB_SPIN_CAP (1u << 18)
#define XLAS __attribute__((address_space(3)))
__device__ __forceinline__ unsigned xb_ld(unsigned* p)              { return __hip_atomic_load(p, __ATOMIC_RELAXED, __HIP_MEMORY_SCOPE_AGENT); }
__device__ __forceinline__ unsigned xb_add(unsigned* p, unsigned v) { return __hip_atomic_fetch_add(p, v, __ATOMIC_RELAXED, __HIP_MEMORY_SCOPE_AGENT); }
__device__ __forceinline__ unsigned xb_xcc_id() { return (unsigned)__builtin_amdgcn_s_getreg((3 << 11) | 20) & 0xFu; }
#define XB_SPIN(cond, bar) do { unsigned _sp = 0; while (cond) { __builtin_amdgcn_s_sleep(1); \
    if ((++_sp & 255u) == 0u) { if (xb_ld(&(bar)[XB_TMO])) break; if (_sp > XB_SPIN_CAP) { atomicAdd(&(bar)[XB_TMO], 1u); break; } } } } while (0)
struct XcdBarrier { unsigned* bar; unsigned x; volatile XLAS unsigned* st; };
__device__ __forceinline__ XcdBarrier xcd_barrier_post(unsigned* bar, volatile XLAS unsigned* st) {
    XcdBarrier b; b.bar = bar; b.x = xb_xcc_id(); b.st = st;
    if (threadIdx.x == 0) (void)xb_add(&bar[XB_XCNT(b.x)], 1u);
    return b;
}
__device__ __forceinline__ void xcd_barrier_complete(unsigned* bar, unsigned x, unsigned& nloc, unsigned& nx) {
    const unsigned G = gridDim.x * gridDim.y * gridDim.z;
    unsigned sum, cnt, mine, sp = 0u;
    for (;;) {
        sum = 0u; cnt = 0u; mine = 0u;
#pragma unroll
        for (unsigned j = 0; j < 16; ++j) { const unsigned c = xb_ld(&bar[XB_XCNT(j)]); sum += c; cnt += (c > 0u) ? 1u : 0u; mine = (j == x) ? c : mine; }
        if (sum == G) break;
        __builtin_amdgcn_s_sleep(1);
        if ((++sp & 255u) == 0u) { if (xb_ld(&bar[XB_TMO])) break; if (sp > XB_SPIN_CAP) { atomicAdd(&bar[XB_TMO], 1u); break; } }
    }
    nloc = mine > 0u ? mine : 1u; nx = cnt > 0u ? cnt : 1u;
}
__device__ __forceinline__ void xcd_barrier(const XcdBarrier& b) {
    asm volatile("s_waitcnt vmcnt(0)" ::: "memory");
    __syncthreads();
    if (threadIdx.x == 0) {
        unsigned* bar = b.bar;
        __builtin_amdgcn_s_waitcnt(0);
        unsigned nloc = b.st[0], nx = b.st[1];
        if (nloc == 0u) { xcd_barrier_complete(bar, b.x, nloc, nx); b.st[0] = nloc; b.st[1] = nx; }
        const unsigned old = xb_add(&bar[XB_XSUB(b.x)], 1u);
        const unsigned gen = old / nloc;
        if (old + 1u == (gen + 1u) * nloc) {
            __builtin_amdgcn_fence(__ATOMIC_RELEASE, "agent");
            asm volatile("s_waitcnt vmcnt(0)" ::: "memory");
            const unsigned og = xb_add(&bar[XB_TOP], 1u);
            const unsigned tg = og / nx;
            if (og + 1u == (tg + 1u) * nx) xb_add(&bar[XB_TOPGEN], 1u);
            else XB_SPIN(xb_ld(&bar[XB_TOPGEN]) == tg, bar);
            __builtin_amdgcn_fence(__ATOMIC_ACQUIRE, "agent");
            xb_add(&bar[XB_XGEN(b.x)], 1u);
            asm volatile("s_waitcnt vmcnt(0)" ::: "memory");
        } else {
            XB_SPIN(xb_ld(&bar[XB_XGEN(b.x)]) == gen, bar);
            __builtin_amdgcn_fence(__ATOMIC_ACQUIRE, "agent");
            asm volatile("s_waitcnt vmcnt(0)" ::: "memory");
        }
    }
    __syncthreads();
}

struct RowJob { const float* xc; const float* xl; const bf16_t* P; float* xdst; bf16_t* hdst; int gA, mGate, gB, mShift, mScale; float sA; };

__global__ void __launch_bounds__(NTHREADS) fwd_megakernel(Params p) {
    extern __shared__ __attribute__((aligned(16))) char shm[];
    volatile XLAS unsigned* st = (volatile XLAS unsigned*)((XLAS unsigned char*)shm + LDS_STAGE);
    if (threadIdx.x < 4) st[threadIdx.x] = 0u;
    __syncthreads();
    const XcdBarrier xb = xcd_barrier_post((unsigned*)(kargs()->ws + OFF_BAR), st);
    const int ph_lo = kargs()->phase_lo, ph_hi = kargs()->phase_hi;
    for (int ph = ph_lo; ph < ph_hi; ++ph) {
        KParams* kp0 = kargs();
        char* ws = kp0->ws;
        bf16_t* H = (bf16_t*)(ws + OFF_H);
        bf16_t* R1 = (bf16_t*)(ws + OFF_R1);
        float* R2f = (float*)(ws + OFF_R2);
        float* out = kp0->out;
        const float* xlat_out = out + (size_t)NCTX * DM;
        int kind = 0;
        RowJob R{}; GemmJob J{};
        switch (ph) {
        case 1: kind = 1; R = RowJob{kargs()->in[0], kargs()->in[1], nullptr, nullptr, H, 0, 0, 0, 0, 1, 0.f}; break;
        case 4: kind = 1; R = RowJob{kargs()->in[0], kargs()->in[1], (const bf16_t*)R2f, out, H, 1, 2, 2, 3, 4, 0.5f}; break;
        case 11: kind = 1; R = RowJob{out, xlat_out, (const bf16_t*)R1, out, H, 3, 5, 4, 6, 7, 1.0f}; break;
        case 14: kind = 1; R = RowJob{out, xlat_out, (const bf16_t*)R2f, out, nullptr, 5, 8, 0, 0, 0, 0.5f}; break;
        case 2: case 12: kind = 2;
            J.A0 = J.A1 = H; J.Bt0 = J.Bt1 = (const bf16_t*)(ws + (ph == 2 ? OFF_W13A : OFF_W13B)); J.lda = DM; J.ldb = DM; J.nN = 22; J.nsplit = 1; J.nt = DM / BK; J.kstride = 0; J.mode = 0; J.o1 = R1; break;
        case 3: case 13: kind = 2;
            J.A0 = J.A1 = R1; J.Bt0 = J.Bt1 = (const bf16_t*)(ws + (ph == 3 ? OFF_W2A : OFF_W2B)); J.lda = DFF; J.ldb = DFF; J.nN = 4; J.nsplit = 2; J.nt = 22; J.kstride = 22 * BK; J.mode = 1; J.o1 = R2f; break;
        case 5: kind = 2;
            J.A0 = J.A1 = H; J.Bt0 = J.Bt1 = (const bf16_t*)(ws + OFF_WIN); J.lda = DM; J.ldb = DM; J.nN = 24; J.nsplit = 1; J.nt = DM / BK; J.kstride = 0; J.mode = 2; J.o1 = R1; break;
        case 9: kind = 2;
            J.A0 = (const bf16_t*)(ws + OFF_R2 + R2_YA); J.A1 = (const bf16_t*)(ws + OFF_R2 + R2_YB); J.Bt0 = (const bf16_t*)(ws + OFF_WA); J.Bt1 = (const bf16_t*)(ws + OFF_WB);
            J.lda = DR; J.ldb = DR; J.nN = 4; J.nsplit = 2; J.nt = DR / BK; J.kstride = 0; J.mode = 3; J.o1 = ws + OFF_R2 + R2_GA; J.o2 = ws + OFF_R2 + R2_GB; J.Z = R1; break;
        case 10: kind = 2;
            J.A0 = (const bf16_t*)(ws + OFF_R2 + R2_GA); J.A1 = (const bf16_t*)(ws + OFF_R2 + R2_GB); J.Bt0 = J.Bt1 = (const bf16_t*)(ws + OFF_WO); J.lda = DM; J.ldb = DM; J.nN = 4; J.nsplit = 2; J.nt = DM / BK; J.kstride = 0; J.mode = 1; J.o1 = R1; break;
        default: break;
        }
        for (int rep = 0; rep <= ((REPEAT_MASK >> ph) & 1); ++rep) {
        if (rep) xcd_barrier(xb);
        if (kind == 1) phase_rowop(R.xc, R.xl, R.P, R.gA, R.mGate, R.sA, R.xdst, R.gB, R.mShift, R.mScale, R.hdst);
        else if (kind == 2) phase_gemm(shm, J);
        else if (ph == 0) phase_convert(shm);
        else if (ph == 6) phase_prep(shm);
        else if (ph == 7) phase_scan(shm);
        else if (ph == 8) phase_post();
        }
        if (ph + 1 < ph_hi) xcd_barrier(xb);
    }
}

extern "C" void kernel_launch(void* const* d_in, const int* in_sizes, int n_in, void* d_out, int out_size, void* d_ws, size_t ws_size, hipStream_t stream) {
    static int grid_blocks = 0;
    if (grid_blocks == 0) {
        if (ws_size < WS_END) { fprintf(stderr, "kernel_launch: workspace too small: %zu < %zu\n", ws_size, (size_t)WS_END); grid_blocks = -1; return; }
        int dev = 0, cus = 0, per_cu = 0;
        hipGetDevice(&dev);
        hipDeviceGetAttribute(&cus, hipDeviceAttributeMultiprocessorCount, dev);
        if (hipFuncSetAttribute((const void*)fwd_megakernel, hipFuncAttributeMaxDynamicSharedMemorySize, LDS_BYTES) != hipSuccess) { fprintf(stderr, "hipFuncSetAttribute failed\n"); grid_blocks = -1; return; }
        hipOccupancyMaxActiveBlocksPerMultiprocessor(&per_cu, (const void*)fwd_megakernel, NTHREADS, LDS_BYTES);
        if (per_cu < 1) { fprintf(stderr, "occupancy query says %d\n", per_cu); per_cu = 1; }
        if (per_cu > 1) per_cu = 1;
        grid_blocks = cus * per_cu;
    }
    if (grid_blocks < 0) return;
    Params p{};
    for (int i = 0; i < 30; ++i) p.in[i] = (const float*)d_in[i];
    p.out = (float*)d_out; p.ws = (char*)d_ws; p.phase_lo = 0; p.phase_hi = 15;
    if (hipMemsetAsync((char*)d_ws + OFF_BAR, 0, 16384, stream) != hipSuccess) { fprintf(stderr, "memset of barrier words failed\n"); return; }
    void* args[] = {&p};
    hipError_t e = hipLaunchCooperativeKernel((const void*)fwd_megakernel, dim3(grid_blocks), dim3(NTHREADS), args, LDS_BYTES, stream);
    if (e != hipSuccess) fprintf(stderr, "cooperative launch failed: %s (grid %d)\n", hipGetErrorString(e), grid_blocks);
}
```

```cpp
#include <hip/hip_runtime.h>
#include <hip/hip_cooperative_groups.h>
#include <cstdio>
namespace cg = cooperative_groups;

typedef unsigned short bf16_t;
typedef short bf16x8 __attribute__((ext_vector_type(8)));
typedef float f32x4 __attribute__((ext_vector_type(4)));
typedef unsigned u32x4 __attribute__((ext_vector_type(4)));
typedef unsigned u32x2 __attribute__((ext_vector_type(2)));

constexpr int DM = 1024, NTOK = 8192, NCTX = 4096, DFF = 2816, NIN = 6144, ZLD = 6144, DR = 512;
constexpr int NTHREADS = 512;
#define REPEAT_MASK 0
constexpr int LDS_STAGE = 131072;
constexpr int LDS_BYTES = LDS_STAGE + 16;

constexpr size_t SZ_W13 = (size_t)5632 * 1024 * 2, SZ_W2 = (size_t)1024 * 2816 * 2;
constexpr size_t OFF_W13A = 0;
constexpr size_t OFF_W2A = OFF_W13A + SZ_W13;
constexpr size_t OFF_W13B = OFF_W2A + SZ_W2;
constexpr size_t OFF_W2B = OFF_W13B + SZ_W13;
constexpr size_t OFF_WIN = OFF_W2B + SZ_W2;
constexpr size_t OFF_WA = OFF_WIN + (size_t)6144 * 1024 * 2;
constexpr size_t OFF_WB = OFF_WA + (size_t)1024 * 512 * 2;
constexpr size_t OFF_WO = OFF_WB + (size_t)1024 * 512 * 2;
constexpr size_t OFF_L2 = OFF_WO + (size_t)1024 * 1024 * 2;
constexpr size_t OFF_MOD = OFF_L2 + (size_t)4 * 512 * 64 * 2;
constexpr size_t OFF_BONUS = OFF_MOD + (size_t)2 * 3 * 9216 * 4;
constexpr size_t OFF_H = OFF_BONUS + (size_t)2 * 8192 * 8 * 4;
constexpr size_t OFF_R1 = OFF_H + (size_t)8192 * 1024 * 2;
constexpr size_t OFF_R2 = OFF_R1 + (size_t)8192 * 6144 * 2;
constexpr size_t OFF_BAR = OFF_R2 + (size_t)72 * 1024 * 1024;
constexpr size_t WS_END = OFF_BAR + 16384;
constexpr size_t R2_KK = 0;
constexpr size_t R2_WD = R2_KK + (size_t)8192 * 512 * 2;
constexpr size_t R2_KD = R2_WD + (size_t)2 * 8192 * 512 * 4;
constexpr size_t R2_BB = R2_KD + (size_t)2 * 8192 * 512 * 2;
constexpr size_t R2_YA = 0;
constexpr size_t R2_YB = R2_YA + (size_t)8192 * 512 * 2;
constexpr size_t R2_GA = R2_YB + (size_t)8192 * 512 * 2;
constexpr size_t R2_GB = R2_GA + (size_t)8192 * 1024 * 2;

struct Params {
    const float* in[30];
    float* out;
    char* ws;
    int phase_lo, phase_hi;
};


typedef const __attribute__((address_space(4))) Params KParams;
__device__ __forceinline__ KParams* kargs() {
    KParams* k = (KParams*)__builtin_amdgcn_kernarg_segment_ptr();
    asm volatile("" : "+s"(k));
    return k;
}

__device__ __forceinline__ int tid_l() { int t = threadIdx.x; asm volatile("" : "+v"(t)); return t; }
__device__ __forceinline__ float bf2f(unsigned short u) { return __uint_as_float(((unsigned)u) << 16); }
__device__ __forceinline__ float bflo(unsigned u) { return __uint_as_float(u << 16); }
__device__ __forceinline__ float bfhi(unsigned u) { return __uint_as_float(u & 0xffff0000u); }
__device__ __forceinline__ unsigned pk_bf16(float lo, float hi) { unsigned r; asm("v_cvt_pk_bf16_f32 %0, %1, %2" : "=v"(r) : "v"(lo), "v"(hi)); return r; }
__device__ __forceinline__ void st_wt16(void* p, u32x4 v) { asm volatile("global_store_dwordx4 %0, %1, off sc1\n\ts_nop 1" :: "v"(p), "v"(v) : "memory"); }
__device__ __forceinline__ void st_wt16f_nc(void* p, f32x4 v) { asm volatile("global_store_dwordx4 %0, %1, off sc1\n\ts_nop 1" :: "v"(p), "v"(v)); }
__device__ __forceinline__ void st_wt8_nc(void* p, u32x2 v) { asm volatile("global_store_dwordx2 %0, %1, off sc1\n\ts_nop 1" :: "v"(p), "v"(v)); }
__device__ __forceinline__ float sigm(float x) { return __builtin_amdgcn_rcpf(1.0f + __expf(-x)); }
__device__ __forceinline__ float wave_sum(float v) {
#pragma unroll
    for (int o = 32; o > 0; o >>= 1) v += __shfl_xor(v, o);
    return v;
}
template <int CTRL> __device__ __forceinline__ float dppf(float x) {
    return __int_as_float(__builtin_amdgcn_update_dpp(0, __float_as_int(x), CTRL, 0xf, 0xf, true));
}
__device__ __forceinline__ float red16(float x) {
    x += dppf<0xB1>(x);
    x += dppf<0x4E>(x);
    x += dppf<0x141>(x);
    x += dppf<0x140>(x);
    return x;
}

__device__ __forceinline__ void conv_tile_w(char* wl, const float* __restrict__ src, int src_ld, int k0, int c0,
                                            bf16_t* __restrict__ dst, int dst_ld, int n0, const float* __restrict__ mu, int mode, const int lane) {
    float v[64];
    const float* s = src + (size_t)k0 * src_ld + c0 + lane;
#pragma unroll
    for (int i = 0; i < 64; ++i) v[i] = __builtin_nontemporal_load(s + (size_t)i * src_ld);
    if (mode) {
#pragma unroll
        for (int i = 0; i < 64; ++i) { const float m = mu[k0 + i]; v[i] *= (mode == 1) ? m : (1.0f - m); }
    }
#pragma unroll
    for (int q = 0; q < 8; ++q) {
        u32x4 o;
#pragma unroll
        for (int i = 0; i < 4; ++i) o[i] = pk_bf16(v[8 * q + 2 * i], v[8 * q + 2 * i + 1]);
        *(u32x4*)(wl + lane * 144 + q * 16) = o;
    }
    asm volatile("s_waitcnt lgkmcnt(0)" ::: "memory");
#pragma unroll
    for (int i = 0; i < 8; ++i) {
        const int id = i * 64 + lane, r = id >> 3, ch = id & 7;
        const u32x4 o = *(const u32x4*)(wl + r * 144 + ch * 16);
        st_wt16(dst + (size_t)(n0 + r) * dst_ld + k0 + ch * 8, o);
    }
    asm volatile("s_waitcnt lgkmcnt(0)" ::: "memory");
}

__device__ void phase_convert(char* shm) {
    KParams* kp = kargs();
    float* lds = (float*)shm;
    const int tid = tid_l(), lane = tid & 63, wave = __builtin_amdgcn_readfirstlane(tid >> 6);
    float* sc = lds;
    float* red = lds + 3072;
    for (int i = tid; i < 3072; i += NTHREADS) {
        const int mi = i >> 10, k = i & 1023;
        const float cv = (mi == 0) ? kp->in[4][k] : kp->in[2][(mi - 1) * 1024 + k];
        sc[i] = cv * sigm(cv);
    }
    __syncthreads();
    float* modp = (float*)(kp->ws + OFF_MOD);
    for (int task = blockIdx.x; task < 288; task += gridDim.x) {
        const int kh = task / 144, cgp = task % 144, col = cgp * 64 + lane;
        const int kb = kh * 512 + wave * 64;
        const float* wm = kp->in[5] + (size_t)kb * 9216 + col;
        float a0 = 0.f, a1 = 0.f, a2 = 0.f;
#pragma unroll 16
        for (int i = 0; i < 64; ++i) {
            const float w = __builtin_nontemporal_load(wm + (size_t)i * 9216);
            a0 += sc[kb + i] * w; a1 += sc[1024 + kb + i] * w; a2 += sc[2048 + kb + i] * w;
        }
        red[(wave * 3 + 0) * 64 + lane] = a0; red[(wave * 3 + 1) * 64 + lane] = a1; red[(wave * 3 + 2) * 64 + lane] = a2;
        __syncthreads();
        if (tid < 192) {
            const int m = tid >> 6, cc = tid & 63;
            float s = kh == 0 ? kp->in[6][cgp * 64 + cc] : 0.f;
#pragma unroll
            for (int g = 0; g < 8; ++g) s += red[(g * 3 + m) * 64 + cc];
            modp[(kh * 3 + m) * 9216 + cgp * 64 + cc] = s;
        }
        __syncthreads();
    }
}

constexpr int T_W13 = 88 * 16, T_W2 = 16 * 44, T_WIN = 88 * 16, T_LORA = 8 * 16, T_WAB = 16 * 8, T_WO = 16 * 16, T_L2 = 32;
constexpr int CV_TOTAL = 2 * T_W13 + 2 * T_W2 + T_WIN + T_LORA + 2 * T_WAB + T_WO + T_L2;
constexpr int CV_SET1 = T_W13 + T_W2, CV_SET0 = CV_TOTAL - CV_SET1;
__device__ void convert_tiles(char* shm, int set, int gw, int nw) {
    KParams* kp = kargs();
    const int tid = tid_l(), lane = tid & 63, wave = __builtin_amdgcn_readfirstlane(tid >> 6);
    char* wl = shm + 20480 + wave * (64 * 144);
    const int cnt = set ? CV_SET1 : CV_SET0;
    for (int n = gw; n < cnt; n += nw) {
        int id;
        if (set == 0) id = n < T_W13 ? n : (n < T_W13 + T_W2 ? n + T_W13 : n + T_W13 + T_W2);
        else id = n < T_W13 ? n + T_W13 : n + T_W13 + T_W2;
        if (id < 2 * T_W13) {
            const int which = id / T_W13; id -= which * T_W13;
            const int nt = id >> 4, kt = id & 15, j = nt >> 2, w = nt & 3;
            const int c0 = (w < 2) ? (128 * j + 64 * w) : (2816 + 128 * j + 64 * (w - 2));
            conv_tile_w(wl, kp->in[which ? 10 : 8], 5632, kt * 64, c0, (bf16_t*)(kp->ws + (which ? OFF_W13B : OFF_W13A)), 1024, nt * 64, nullptr, 0, lane);
            continue;
        }
        id -= 2 * T_W13;
        if (id < 2 * T_W2) {
            const int which = id / T_W2; id -= which * T_W2;
            const int nt = id / 44, kt = id % 44;
            conv_tile_w(wl, kp->in[which ? 11 : 9], 1024, kt * 64, nt * 64, (bf16_t*)(kp->ws + (which ? OFF_W2B : OFF_W2A)), 2816, nt * 64, nullptr, 0, lane);
            continue;
        }
        id -= 2 * T_W2;
        if (id < T_WIN) {
            const int nt = id >> 4, kt = id & 15;
            conv_tile_w(wl, kp->in[12], 5632, kt * 64, nt * 64, (bf16_t*)(kp->ws + OFF_WIN), 1024, nt * 64, nullptr, 0, lane);
            continue;
        }
        id -= T_WIN;
        if (id < T_LORA) {
            const int nt = id >> 4, kt = id & 15;
            const int pq = nt & 1, l = (nt >> 1) & 1, d = nt >> 2;
            const float* src = kp->in[l ? 18 : 15] + (size_t)d * 1024 * 64;
            conv_tile_w(wl, src, 64, kt * 64, 0, (bf16_t*)(kp->ws + OFF_WIN), 1024, 5632 + nt * 64, kp->in[13] + (d * 2 + l) * 1024, pq ? 1 : 2, lane);
            continue;
        }
        id -= T_LORA;
        if (id < 2 * T_WAB) {
            const int which = id / T_WAB; id -= which * T_WAB;
            const int nt = id >> 3, kt = id & 7;
            conv_tile_w(wl, kp->in[which ? 28 : 27], 1024, kt * 64, nt * 64, (bf16_t*)(kp->ws + (which ? OFF_WB : OFF_WA)), 512, nt * 64, nullptr, 0, lane);
            continue;
        }
        id -= 2 * T_WAB;
        if (id < T_WO) {
            const int nt = id >> 4, kt = id & 15;
            conv_tile_w(wl, kp->in[29], 1024, kt * 64, nt * 64, (bf16_t*)(kp->ws + OFF_WO), 1024, nt * 64, nullptr, 0, lane);
            continue;
        }
        id -= T_WO;
        {
            const int dl = id >> 3, nt = id & 7, d = dl >> 1, l = dl & 1;
            const float* src = kp->in[l ? 19 : 16] + (size_t)d * 64 * 512;
            conv_tile_w(wl, src, 512, 0, nt * 64, (bf16_t*)(kp->ws + OFF_L2) + (size_t)dl * 512 * 64, 64, nt * 64, nullptr, 0, lane);
        }
    }
}

__device__ void phase_rowop(const float* __restrict__ xctx, const float* __restrict__ xlat, const bf16_t* __restrict__ P,
                            int gA, int mGate, float sA, float* __restrict__ xdst, int gB, int mShift, int mScale, bf16_t* __restrict__ hdst) {
    KParams* kp = kargs();
    const int tid = tid_l(), lane = tid & 63, wave = tid >> 6;
    const float* G = kp->in[7];
    const float* MOD = (const float*)(kp->ws + OFF_MOD);
    constexpr int RW = 4;
    for (int row0 = (blockIdx.x * 8 + wave) * RW; row0 < NTOK; row0 += gridDim.x * 8 * RW) {
        const int mi = row0 < NCTX ? 0 : 1 + ((row0 - NCTX) >> 11);
        const float* mod = MOD + mi * 9216;
        const float* xs = row0 < NCTX ? xctx + (size_t)row0 * DM : xlat + (size_t)(row0 - NCTX) * DM;
        f32x4 x[RW][4];
#pragma unroll
        for (int r = 0; r < RW; ++r)
#pragma unroll
            for (int i = 0; i < 4; ++i) x[r][i] = __builtin_nontemporal_load((const f32x4*)(xs + (size_t)r * DM + (i * 64 + lane) * 4));
        if (P) {
            u32x2 p0[RW][4], p1[RW][4];
#pragma unroll
            for (int r = 0; r < RW; ++r)
#pragma unroll
                for (int i = 0; i < 4; ++i) {
                    const size_t o = (size_t)(row0 + r) * DM + (i * 64 + lane) * 4;
                    p0[r][i] = __builtin_nontemporal_load((const u32x2*)(P + o)); p1[r][i] = __builtin_nontemporal_load((const u32x2*)(P + (size_t)NTOK * DM + o));
                }
            f32x4 gm[4];
#pragma unroll
            for (int i = 0; i < 4; ++i) {
                const int c = (i * 64 + lane) * 4;
                gm[i] = *(const f32x4*)(G + gA * DM + c) * (*(const f32x4*)(mod + mGate * DM + c) + *(const f32x4*)(mod + 27648 + mGate * DM + c));
            }
            float ss[RW];
#pragma unroll
            for (int r = 0; r < RW; ++r) {
                ss[r] = 0.f;
#pragma unroll
                for (int i = 0; i < 4; ++i) {
                    const f32x4 f = (f32x4){bflo(p0[r][i][0]) + bflo(p1[r][i][0]), bfhi(p0[r][i][0]) + bfhi(p1[r][i][0]), bflo(p0[r][i][1]) + bflo(p1[r][i][1]), bfhi(p0[r][i][1]) + bfhi(p1[r][i][1])};
                    ss[r] += f[0] * f[0] + f[1] * f[1] + f[2] * f[2] + f[3] * f[3];
                }
            }
#pragma unroll
            for (int o = 32; o > 0; o >>= 1) {
#pragma unroll
                for (int r = 0; r < RW; ++r) ss[r] += __shfl_xor(ss[r], o);
            }
#pragma unroll
            for (int r = 0; r < RW; ++r) {
                const float rstd = rsqrtf(ss[r] * (1.0f / DM) + 1e-6f) * sA;
#pragma unroll
                for (int i = 0; i < 4; ++i) {
                    const int c = (i * 64 + lane) * 4;
                    const f32x4 f = (f32x4){bflo(p0[r][i][0]) + bflo(p1[r][i][0]), bfhi(p0[r][i][0]) + bfhi(p1[r][i][0]), bflo(p0[r][i][1]) + bflo(p1[r][i][1]), bfhi(p0[r][i][1]) + bfhi(p1[r][i][1])};
                    x[r][i] += gm[i] * (f * rstd);
                    st_wt16f_nc(xdst + (size_t)(row0 + r) * DM + c, x[r][i]);
                }
            }
        }
        if (hdst) {
            f32x4 gs[4], sh[4];
#pragma unroll
            for (int i = 0; i < 4; ++i) {
                const int c = (i * 64 + lane) * 4;
                gs[i] = *(const f32x4*)(G + gB * DM + c) * (*(const f32x4*)(mod + mScale * DM + c) + *(const f32x4*)(mod + 27648 + mScale * DM + c) + 1.0f);
                sh[i] = *(const f32x4*)(mod + mShift * DM + c) + *(const f32x4*)(mod + 27648 + mShift * DM + c);
            }
            float ss[RW];
#pragma unroll
            for (int r = 0; r < RW; ++r) {
                ss[r] = 0.f;
#pragma unroll
                for (int i = 0; i < 4; ++i) ss[r] += x[r][i][0] * x[r][i][0] + x[r][i][1] * x[r][i][1] + x[r][i][2] * x[r][i][2] + x[r][i][3] * x[r][i][3];
            }
#pragma unroll
            for (int o = 32; o > 0; o >>= 1) {
#pragma unroll
                for (int r = 0; r < RW; ++r) ss[r] += __shfl_xor(ss[r], o);
            }
#pragma unroll
            for (int r = 0; r < RW; ++r) {
                const float rstd = rsqrtf(ss[r] * (1.0f / DM) + 1e-6f);
#pragma unroll
                for (int i = 0; i < 4; ++i) {
                    const int c = (i * 64 + lane) * 4;
                    const f32x4 h = (x[r][i] * rstd) * gs[i] + sh[i];
                    u32x2 o; o[0] = pk_bf16(h[0], h[1]); o[1] = pk_bf16(h[2], h[3]);
                    st_wt8_nc(hdst + (size_t)(row0 + r) * DM + c, o);
                }
            }
        }
    }
}

constexpr int BM = 256, BK = 64, HALF = 128, HT = HALF * BK;
__device__ __forceinline__ int lds_byte(int r, int c) {
    const int st = (r >> 4) * 2 + (c >> 5), rr = r & 15, cc = c & 31, ob = rr * 64 + cc * 2;
    return st * 1024 + (ob ^ (((ob >> 9) & 1) << 5));
}
__device__ __forceinline__ void stage_rc(int b, int& R, int& C) {
    const int st = b / 1024, sb = b % 1024, swz = sb ^ (((sb >> 9) & 1) << 5);
    R = (st >> 1) * 16 + swz / 64; C = (st & 1) * 32 + (swz % 64) / 2;
}
__device__ __forceinline__ void unit_map(int wgid, int nM, int nN, int& pm, int& pn) {
    const int NXCD = 8, WGM = 8, nwg = nM * nN;
    { const int q = nwg / NXCD, r = nwg % NXCD, xcd = wgid % NXCD, off = wgid / NXCD; wgid = (xcd < r ? xcd * (q + 1) : r * (q + 1) + (xcd - r) * q) + off; }
    const int nig = WGM * nN, gid = wgid / nig, fm = gid * WGM, gsz = min(nM - fm, WGM);
    pm = fm + ((wgid % nig) % gsz); pn = (wgid % nig) / gsz;
}

#define LAS __attribute__((address_space(3)))
constexpr int HTB = HALF * BK * 2;
__device__ __forceinline__ void gemm_tile(char* shmc, const bf16_t* __restrict__ A, int lda, const bf16_t* __restrict__ Bt, int ldb,
                                          int brow, int bcol, int nt, f32x4 (&acc)[2][2][4][2], const int tid) {
    LAS unsigned char* lds = (LAS unsigned char*)shmc;
    const int wid = __builtin_amdgcn_readfirstlane(tid >> 6), lane = tid & 63, wr = wid >> 2, wc = wid & 3, fr = lane & 15, fq = lane >> 4;
    unsigned voffA[2], voffB[2];
#pragma unroll
    for (int i = 0; i < 2; ++i) { int R, C; stage_rc(tid * 16 + i * 8192, R, C); voffA[i] = (unsigned)(R * lda + C) * 2u; voffB[i] = (unsigned)(R * ldb + C) * 2u; }
    const size_t kstep = (size_t)(BK * 2);
    const size_t hstepA = (size_t)HALF * lda * 2, hstepB = (size_t)HALF * ldb * 2;
    const unsigned ldsw = (unsigned)wid * 1024u;
    const int aoff = lds_byte(wr * 64 + fr, fq * 8), boff = lds_byte(wc * 32 + fr, fq * 8);
    const char* cA = (const char*)A + (size_t)brow * lda * 2;
    const char* cB = (const char*)Bt + (size_t)bcol * ldb * 2;
#define SA(b, h) (((b) * 2 + (h)) * HTB)
#define SB(b, h) ((4 + (b) * 2 + (h)) * HTB)
#define STAGE(bufoff, gbase, voff) do { _Pragma("unroll") for (int _i = 0; _i < 2; ++_i) \
    __builtin_amdgcn_global_load_lds((const unsigned*)((const char*)(gbase) + (voff)[_i]), (LAS unsigned*)(lds + (bufoff) + ldsw + _i * 8192), 16, 0, 0); } while (0)
#define LDA(dst, b, h) do { _Pragma("unroll") for (int m = 0; m < 4; ++m) _Pragma("unroll") for (int k = 0; k < 2; ++k) dst[m][k] = *(const LAS bf16x8*)(lds + SA(b, h) + aoff + m * 2048 + k * 1024); } while (0)
#define LDB(dst, b, h) do { _Pragma("unroll") for (int n = 0; n < 2; ++n) _Pragma("unroll") for (int k = 0; k < 2; ++k) dst[n][k] = *(const LAS bf16x8*)(lds + SB(b, h) + boff + n * 2048 + k * 1024); } while (0)
#define MMA(ai, bj, At_, Bt_) do { __builtin_amdgcn_s_setprio(1); _Pragma("unroll") for (int m = 0; m < 4; ++m) _Pragma("unroll") for (int n = 0; n < 2; ++n) _Pragma("unroll") for (int k = 0; k < 2; ++k) \
      acc[ai][bj][m][n] = __builtin_amdgcn_mfma_f32_16x16x32_bf16(Bt_[n][k], At_[m][k], acc[ai][bj][m][n], 0, 0, 0); \
    __builtin_amdgcn_s_setprio(0); } while (0)
#define WAIT_V(n) asm volatile("s_waitcnt vmcnt(" #n ")" ::: "memory")
#define WAIT_L(n) asm volatile("s_waitcnt lgkmcnt(" #n ")" ::: "memory")
#define BAR __builtin_amdgcn_s_barrier()
#define SCHED __builtin_amdgcn_sched_barrier(0)
#pragma unroll
    for (int a = 0; a < 2; ++a)
#pragma unroll
        for (int b = 0; b < 2; ++b)
#pragma unroll
            for (int m = 0; m < 4; ++m)
#pragma unroll
                for (int n = 0; n < 2; ++n) acc[a][b][m][n] = (f32x4){0.f, 0.f, 0.f, 0.f};
    bf16x8 At[4][2], B0[2][2], B1[2][2];
    STAGE(SB(0, 0), cB, voffB); STAGE(SA(0, 0), cA, voffA); STAGE(SB(0, 1), cB + hstepB, voffB); STAGE(SA(0, 1), cA + hstepA, voffA);
    if (wr == 1) BAR;
    WAIT_V(4); BAR;
    STAGE(SB(1, 0), cB + kstep, voffB); STAGE(SA(1, 0), cA + kstep, voffA); STAGE(SB(1, 1), cB + hstepB + kstep, voffB);
    WAIT_V(6); BAR;
    for (int t = 0; t < nt - 2; t += 2) {
        const char* a1 = cA + (size_t)(t + 1) * kstep;
        const char* a2 = cA + (size_t)(t + 2) * kstep; const char* b2 = cB + (size_t)(t + 2) * kstep;
        const char* a3 = a2 + kstep; const char* b3 = b2 + kstep;
        LDB(B0, 0, 0); SCHED; LDA(At, 0, 0); STAGE(SA(1, 1), a1 + hstepA, voffA);
        WAIT_L(8); BAR; WAIT_L(0); MMA(0, 0, At, B0); BAR; SCHED;
        LDB(B1, 0, 1); STAGE(SB(0, 0), b2, voffB);
        BAR; WAIT_L(0); MMA(0, 1, At, B1); BAR;
        LDA(At, 0, 1); STAGE(SA(0, 0), a2, voffA);
        BAR; WAIT_L(0); MMA(1, 0, At, B0); BAR; SCHED;
        STAGE(SB(0, 1), b2 + hstepB, voffB);
        WAIT_V(6); BAR; MMA(1, 1, At, B1); BAR;
        LDB(B0, 1, 0); SCHED; LDA(At, 1, 0); STAGE(SA(0, 1), a2 + hstepA, voffA);
        WAIT_L(8); BAR; WAIT_L(0); MMA(0, 0, At, B0); BAR; SCHED;
        LDB(B1, 1, 1); STAGE(SB(1, 0), b3, voffB);
        BAR; WAIT_L(0); MMA(0, 1, At, B1); BAR;
        LDA(At, 1, 1); STAGE(SA(1, 0), a3, voffA);
        BAR; WAIT_L(0); MMA(1, 0, At, B0); BAR; SCHED;
        STAGE(SB(1, 1), b3 + hstepB, voffB);
        WAIT_V(6); BAR; MMA(1, 1, At, B1); BAR;
    }
    { const char* a1 = cA + (size_t)(nt - 1) * kstep;
      LDB(B0, 0, 0); LDA(At, 0, 0); STAGE(SA(1, 1), a1 + hstepA, voffA);
      BAR; WAIT_L(0); MMA(0, 0, At, B0); BAR;
      LDB(B1, 0, 1); BAR; WAIT_L(0); MMA(0, 1, At, B1); BAR;
      LDA(At, 0, 1); WAIT_V(4); BAR; WAIT_L(0); MMA(1, 0, At, B0); MMA(1, 1, At, B1); BAR; }
    { LDB(B0, 1, 0); LDA(At, 1, 0); WAIT_V(2); BAR; WAIT_L(0); MMA(0, 0, At, B0); BAR;
      LDB(B1, 1, 1); WAIT_V(0); BAR; WAIT_L(0); MMA(0, 1, At, B1); BAR;
      LDA(At, 1, 1); BAR; WAIT_L(0); MMA(1, 0, At, B0); MMA(1, 1, At, B1); BAR; }
    if (wr == 0) BAR;
#undef SA
#undef SB
#undef STAGE
#undef LDA
#undef LDB
#undef MMA
}

struct GemmJob {
    const bf16_t* A0; const bf16_t* A1; const bf16_t* Bt0; const bf16_t* Bt1;
    int lda, ldb, nN, nsplit, nt, kstride, mode, pad;
    void* o1; void* o2; const bf16_t* Z;
};
__device__ void phase_gemm(char* shm, const GemmJob& J) {
    const int tid = tid_l();
    const int wid = __builtin_amdgcn_readfirstlane(tid >> 6), wr = wid >> 2, wc = wid & 3;
    const int nM = 32, nN = J.nN, nMN = nM * nN;
    const int mode = J.mode;
    for (int u = blockIdx.x; u < nMN * J.nsplit; u += gridDim.x) {
        const int ks = u / nMN;
        int pm, pn; unit_map(u - ks * nMN, nM, nN, pm, pn);
        {
            const int sub = ks;
            f32x4 acc[2][2][4][2];
            const size_t koff = (size_t)ks * J.kstride;
            gemm_tile(shm, (ks ? J.A1 : J.A0) + koff, J.lda, (ks ? J.Bt1 : J.Bt0) + koff, J.ldb, pm * BM, pn * BM, J.nt, acc, tid);
            int lane_e = tid & 63; asm volatile("" : "+v"(lane_e));
            const int fr = lane_e & 15, fq = lane_e >> 4;
            const int NBJ = (mode == 0) ? 1 : 2;
            const int W8 = NBJ * 16;
            const int pitch = NBJ * 256 + 32;
            bf16_t* obase; int old_, col0;
            if (mode == 0)      { obase = (bf16_t*)J.o1; old_ = DFF; col0 = pn * 128; }
            else if (mode == 1) { obase = (bf16_t*)J.o1 + (size_t)ks * NTOK * DM; old_ = DM; col0 = pn * BM; }
            else if (mode == 2) { obase = (bf16_t*)J.o1; old_ = ZLD; col0 = pn * BM; }
            else                { obase = (bf16_t*)(sub ? J.o2 : J.o1); old_ = DM; col0 = pn * BM; }
            const bf16_t* Zg = J.Z + (sub ? 4608 : 3584);
#pragma unroll
            for (int ai = 0; ai < 2; ++ai) {
#pragma unroll
                for (int m = 0; m < 4; ++m) {
                    const int rloc = wr * 64 + m * 16 + fr;
                    const int row = pm * BM + ai * HALF + rloc;
#pragma unroll
                    for (int n = 0; n < 2; ++n) {
                        if (mode == 0) {
                            const f32x4 g = acc[ai][0][m][n], up = acc[ai][1][m][n];
                            float o[4];
#pragma unroll
                            for (int j = 0; j < 4; ++j) o[j] = g[j] * sigm(g[j]) * up[j];
                            u32x2 v; v[0] = pk_bf16(o[0], o[1]); v[1] = pk_bf16(o[2], o[3]);
                            *(u32x2*)(shm + rloc * pitch + (wc * 32 + n * 16 + fq * 4) * 2) = v;
                        } else {
#pragma unroll
                            for (int bj = 0; bj < 2; ++bj) {
                                const int cl = bj * HALF + wc * 32 + n * 16 + fq * 4;
                                f32x4 a = acc[ai][bj][m][n];
                                if (mode == 3) {
                                    const u32x2 gz = *(const u32x2*)(Zg + (size_t)row * ZLD + col0 + cl);
                                    a[0] *= sigm(bflo(gz[0])); a[1] *= sigm(bfhi(gz[0])); a[2] *= sigm(bflo(gz[1])); a[3] *= sigm(bfhi(gz[1]));
                                }
                                u32x2 v; v[0] = pk_bf16(a[0], a[1]); v[1] = pk_bf16(a[2], a[3]);
                                *(u32x2*)(shm + rloc * pitch + cl * 2) = v;
                            }
                        }
                    }
                }
                __syncthreads();
                const int w8sh = (mode == 0) ? 4 : 5;
                for (int c = tid; c < 128 * W8; c += NTHREADS) {
                    const int r = c >> w8sh, cc = c & (W8 - 1);
                    const u32x4 v = *(const u32x4*)(shm + r * pitch + cc * 16);
                    st_wt16(obase + (size_t)(pm * BM + ai * HALF + r) * old_ + col0 + cc * 8, v);
                }
                __syncthreads();
            }
        }
    }
}

__device__ void phase_prep(char* shm) {
    KParams* kp = kargs();
    const int tid = tid_l(), lane = tid & 63, wave = tid >> 6, fr = lane & 15, fq = lane >> 4;
    float* wt = (float*)shm + wave * (16 * 68);
    const bf16_t* Z = (const bf16_t*)(kp->ws + OFF_R1);
    const bf16_t* L2T = (const bf16_t*)(kp->ws + OFF_L2);
    bf16_t* KK = (bf16_t*)(kp->ws + OFF_R2 + R2_KK);
    float* WD = (float*)(kp->ws + OFF_R2 + R2_WD);
    bf16_t* KD = (bf16_t*)(kp->ws + OFF_R2 + R2_KD);
    bf16_t* BB = (bf16_t*)(kp->ws + OFF_R2 + R2_BB);
    float* BONUS = (float*)(kp->ws + OFF_BONUS);
    for (int unit = blockIdx.x * 8 + wave; unit < 2048; unit += gridDim.x * 8) {
        const int hq = unit & 1, d = (unit >> 1) & 1, tg = unit >> 2;
        const int row = tg * 16 + fr;
        const bool lat = row >= NCTX;
        const int pos = lat ? ((row - NCTX) & 2047) : (row & 255);
        const int T = lat ? 2048 : 256;
        const bool valid = d == 0 ? (pos > 0) : (pos < T - 1);
        const int srow = valid ? (d == 0 ? row - 1 : row + 1) : row;
        bf16x8 Bz[2][2];
#pragma unroll
        for (int l = 0; l < 2; ++l)
#pragma unroll
            for (int ks = 0; ks < 2; ++ks) {
                const int k = ks * 32 + fq * 8;
                const u32x4 Pv = *(const u32x4*)(Z + (size_t)row * ZLD + 5632 + ((d * 2 + l) * 2 + 0) * 64 + k);
                u32x4 Qv = *(const u32x4*)(Z + (size_t)srow * ZLD + 5632 + ((d * 2 + l) * 2 + 1) * 64 + k);
                if (!valid) Qv = (u32x4){0u, 0u, 0u, 0u};
                u32x4 o;
#pragma unroll
                for (int i = 0; i < 4; ++i) {
                    float z0 = bflo(Pv[i]) + bflo(Qv[i]), z1 = bfhi(Pv[i]) + bfhi(Qv[i]);
                    if (l == 0) {
                        z0 = 1.0f - 2.0f * __builtin_amdgcn_rcpf(__expf(2.0f * z0) + 1.0f);
                        z1 = 1.0f - 2.0f * __builtin_amdgcn_rcpf(__expf(2.0f * z1) + 1.0f);
                    }
                    o[i] = pk_bf16(z0, z1);
                }
                Bz[l][ks] = __builtin_bit_cast(bf16x8, o);
            }
        for (int hh = hq * 4; hh < hq * 4 + 4; ++hh) {
            f32x4 accw[4], acca[4];
#pragma unroll
            for (int mt = 0; mt < 4; ++mt) {
                accw[mt] = (f32x4){0.f, 0.f, 0.f, 0.f}; acca[mt] = (f32x4){0.f, 0.f, 0.f, 0.f};
#pragma unroll
                for (int ks = 0; ks < 2; ++ks) {
                    const bf16x8 Aw = *(const bf16x8*)(L2T + ((size_t)(d * 2 + 0) * 512 + hh * 64 + mt * 16 + fr) * 64 + ks * 32 + fq * 8);
                    const bf16x8 Aa = *(const bf16x8*)(L2T + ((size_t)(d * 2 + 1) * 512 + hh * 64 + mt * 16 + fr) * 64 + ks * 32 + fq * 8);
                    accw[mt] = __builtin_amdgcn_mfma_f32_16x16x32_bf16(Aw, Bz[0][ks], accw[mt], 0, 0, 0);
                    acca[mt] = __builtin_amdgcn_mfma_f32_16x16x32_bf16(Aa, Bz[1][ks], acca[mt], 0, 0, 0);
                }
            }
            float ss = 0.f, bon = 0.f;
            f32x4 kkr[4], kd[4];
#pragma unroll
            for (int mt = 0; mt < 4; ++mt) {
                const int c = hh * 64 + mt * 16 + fq * 4;
                const f32x4 w0 = *(const f32x4*)(kp->in[14] + d * 512 + c), a0 = *(const f32x4*)(kp->in[17] + d * 512 + c);
                const f32x4 kkp = *(const f32x4*)(kp->in[20] + c), kap = *(const f32x4*)(kp->in[21] + c), rkp = *(const f32x4*)(kp->in[22] + c);
                const u32x2 kz = *(const u32x2*)(Z + (size_t)row * ZLD + 512 + c), rz = *(const u32x2*)(Z + (size_t)row * ZLD + c);
                const float kv[4] = {bflo(kz[0]), bfhi(kz[0]), bflo(kz[1]), bfhi(kz[1])};
                const float rv[4] = {bflo(rz[0]), bfhi(rz[0]), bflo(rz[1]), bfhi(rz[1])};
#pragma unroll
                for (int j = 0; j < 4; ++j) {
                    const float xw = accw[mt][j] + w0[j];
                    accw[mt][j] = __expf(-0.60653065971f * sigm(xw));
                    const float a = sigm(acca[mt][j] + a0[j]);
                    acca[mt][j] = a;
                    const float kr = kv[j] * kkp[j];
                    kkr[mt][j] = kr; ss += kr * kr;
                    const float kdd = kv[j] * (1.0f + (a - 1.0f) * kap[j]);
                    kd[mt][j] = kdd;
                    bon += rv[j] * kdd * rkp[j];
                }
            }
            ss += __shfl_xor(ss, 16); ss += __shfl_xor(ss, 32);
            bon += __shfl_xor(bon, 16); bon += __shfl_xor(bon, 32);
            const float inv = rsqrtf(ss + 1e-12f);
            const int row0 = tg * 16;
#pragma unroll
            for (int pass = 0; pass < 4; ++pass) {
                if (pass == 3 && d != 0) break;
#pragma unroll
                for (int mt = 0; mt < 4; ++mt) {
                    f32x4 val;
                    if (pass == 0) val = accw[mt];
                    else if (pass == 1) val = kd[mt];
                    else if (pass == 2) val = kkr[mt] * inv * acca[mt];
                    else val = kkr[mt] * inv;
                    *(f32x4*)(wt + fr * 68 + mt * 16 + fq * 4) = val;
                }
                asm volatile("s_waitcnt lgkmcnt(0)" ::: "memory");
#pragma unroll
                for (int i = 0; i < 4; ++i) {
                    const int id = i * 64 + lane, tk = id >> 4, c4 = (id & 15) * 4;
                    const f32x4 val = *(const f32x4*)(wt + tk * 68 + c4);
                    const size_t o = ((size_t)d * NTOK + row0 + tk) * DR + hh * 64 + c4;
                    if (pass == 0) *(f32x4*)(WD + o) = val;
                    else {
                        u32x2 v; v[0] = pk_bf16(val[0], val[1]); v[1] = pk_bf16(val[2], val[3]);
                        if (pass == 1) *(u32x2*)(KD + o) = v;
                        else if (pass == 2) *(u32x2*)(BB + o) = v;
                        else *(u32x2*)(KK + (size_t)(row0 + tk) * DR + hh * 64 + c4) = v;
                    }
                }
                asm volatile("s_waitcnt lgkmcnt(0)" ::: "memory");
            }
            if (fq == 0) BONUS[((size_t)d * NTOK + row) * 8 + hh] = bon;
        }
    }
}

__device__ __forceinline__ float red16x4(float p0, float p1, float p2, float p3, const bool b0, const bool b1) {
    const float own01 = b0 ? p1 : p0, snd01 = b0 ? p0 : p1;
    const float own23 = b0 ? p3 : p2, snd23 = b0 ? p2 : p3;
    const float r01 = own01 + dppf<0xB1>(snd01);
    const float r23 = own23 + dppf<0xB1>(snd23);
    const float own = b1 ? r23 : r01, snd = b1 ? r01 : r23;
    float r = own + dppf<0x4E>(snd);
    r += dppf<0x124>(r);
    r += dppf<0x128>(r);
    return r;
}
constexpr int TC = 32, STEP_F = 352;
typedef float f32x2 __attribute__((ext_vector_type(2)));
constexpr int SCAN_IN_F = TC * STEP_F;
constexpr int SCAN_Y_OFF = 2 * SCAN_IN_F;
struct ChunkDesc { int base, T, d, h, rq, c, b; bool first, last; };
template <bool LAT> __device__ __forceinline__ ChunkDesc chunk_desc(int slot, int g) {
    ChunkDesc q;
    if (LAT) {
        const int chain = slot >> 2; q.rq = slot & 3; q.b = chain >> 4; q.h = (chain >> 1) & 7; q.d = chain & 1;
        q.T = 2048; q.base = NCTX + q.b * 2048; q.c = g; q.first = g == 0; q.last = false;
    } else {
        const int u = slot * 4 + (g >> 3), chain = u >> 1; q.rq = u & 1; q.b = chain >> 4; q.h = (chain >> 1) & 7; q.d = chain & 1;
        q.T = 256; q.base = q.b * 256; q.c = g & 7; q.first = q.c == 0; q.last = q.c == 7;
    }
    return q;
}
__device__ __forceinline__ void st4(float* dst, unsigned a, unsigned b) {
    *(f32x4*)dst = (f32x4){bflo(a), bfhi(a), bflo(b), bfhi(b)};
}
struct LReg { u32x4 r8, k8, kk8, b8, v8; f32x4 w0, w1; };

template <bool LAT> __device__ __forceinline__ void scan_pass(char* shm, const int tid, const int slot) {
    constexpr int NSW = 4, RPL = LAT ? 1 : 2, RB = NSW * 4 * RPL, NCH = LAT ? 64 : 32;
    KParams* kp = kargs();
    float* lds = (float*)shm;
    const int wave = __builtin_amdgcn_readfirstlane(tid >> 6), lane = tid & 63;
    const bf16_t* Z = (const bf16_t*)(kp->ws + OFF_R1);
    const bf16_t* KK = (const bf16_t*)(kp->ws + OFF_R2 + R2_KK);
    const float* WD = (const float*)(kp->ws + OFF_R2 + R2_WD);
    const bf16_t* KD = (const bf16_t*)(kp->ws + OFF_R2 + R2_KD);
    const bf16_t* BB = (const bf16_t*)(kp->ws + OFF_R2 + R2_BB);
    bf16_t* Y = (bf16_t*)(kp->ws + OFF_H);
    float* OST = kp->out + (size_t)NTOK * DM;
    const float* ST0 = kp->in[3];
    {
        if (wave >= 4) {
            const int lt = tid - 256, s = lt >> 3, cg8 = (lt & 7) * 8;
            constexpr int NV = TC * RB / 8;
            LReg R;
            auto ld_chunk = [&](int g) {
                const ChunkDesc q = chunk_desc<LAT>(slot, g);
                const int tt = q.c * TC + s, t = q.d ? q.T - 1 - tt : tt, row = q.base + t;
                const int ch = q.h * 64 + cg8;
                const size_t od = ((size_t)q.d * NTOK + row) * DR + ch;
                R.r8 = *(const u32x4*)(Z + (size_t)row * ZLD + ch);
                R.w0 = *(const f32x4*)(WD + od); R.w1 = *(const f32x4*)(WD + od + 4);
                R.k8 = *(const u32x4*)(KD + od);
                R.kk8 = *(const u32x4*)(KK + (size_t)row * DR + ch);
                R.b8 = *(const u32x4*)(BB + od);
                if (lt < NV) {
                    const int s2 = lt / (RB / 8), hf = lt % (RB / 8);
                    const int tt2 = q.c * TC + s2, t2 = q.d ? q.T - 1 - tt2 : tt2, row2 = q.base + t2;
                    R.v8 = *(const u32x4*)(Z + (size_t)row2 * ZLD + 1024 + q.h * 64 + q.rq * RB + hf * 8);
                }
            };
            ld_chunk(0);
            for (int g = -1; g <= NCH; ++g) {
                if (g + 1 <= NCH - 1) {
                    float* buf = lds + ((g + 1) & 1) * SCAN_IN_F;
                    float* L = buf + s * STEP_F + cg8;
                    st4(L, R.r8[0], R.r8[1]); st4(L + 4, R.r8[2], R.r8[3]);
                    *(f32x4*)(L + 64) = R.w0; *(f32x4*)(L + 68) = R.w1;
                    st4(L + 128, R.k8[0], R.k8[1]); st4(L + 132, R.k8[2], R.k8[3]);
                    st4(L + 192, R.kk8[0], R.kk8[1]); st4(L + 196, R.kk8[2], R.kk8[3]);
                    st4(L + 256, R.b8[0], R.b8[1]); st4(L + 260, R.b8[2], R.b8[3]);
                    if (lt < NV) {
                        const int s2 = lt / (RB / 8), hf = lt % (RB / 8);
                        float* Lv = buf + s2 * STEP_F + 320 + hf * 8;
                        st4(Lv, R.v8[0], R.v8[1]); st4(Lv + 4, R.v8[2], R.v8[3]);
                    }
                }
                if (g + 2 <= NCH - 1) ld_chunk(g + 2);
                if (g >= 1) {
                    const ChunkDesc q = chunk_desc<LAT>(slot, g - 1);
                    const float* yb = lds + SCAN_Y_OFF + ((g - 1) & 1) * (TC * RB);
#pragma unroll
                    for (int i = lt; i < TC * RB / 2; i += 256) {
                        const int sy = i / (RB / 2), r2 = (i % (RB / 2)) * 2;
                        const int tt = q.c * TC + sy, t = q.d ? q.T - 1 - tt : tt, row = q.base + t;
                        const f32x2 yv = *(const f32x2*)(yb + sy * RB + r2);
                        *(unsigned*)(Y + ((size_t)q.d * NTOK + row) * DR + q.h * 64 + q.rq * RB + r2) = pk_bf16(yv[0], yv[1]);
                    }
                }
                __syncthreads();
            }
        } else if (wave < NSW) {
            const int rl = lane >> 4, qq = lane & 15;
            f32x2 Sa[RPL], Sb[RPL];
#pragma unroll
            for (int j = 0; j < RPL; ++j) { Sa[j] = (f32x2){0.f, 0.f}; Sb[j] = (f32x2){0.f, 0.f}; }
            __syncthreads();
            for (int g = 0; g <= NCH - 1; ++g) {
                const ChunkDesc q = chunk_desc<LAT>(slot, g);
                const float* buf = lds + (g & 1) * SCAN_IN_F;
                const int rloc = wave * RPL * 4 + rl;
                float* yb = lds + SCAN_Y_OFF + (g & 1) * (TC * RB) + rloc;
                if (q.first) {
#pragma unroll
                    for (int j = 0; j < RPL; ++j) {
                        if (LAT) {
                            const int irow = q.rq * RB + rloc + 4 * j;
                            const f32x4 s = *(const f32x4*)(ST0 + ((size_t)((q.b * 2 + q.d) * 8 + q.h) * 64 + irow) * 64 + qq * 4);
                            Sa[j] = (f32x2){s[0], s[1]}; Sb[j] = (f32x2){s[2], s[3]};
                        } else { Sa[j] = (f32x2){0.f, 0.f}; Sb[j] = (f32x2){0.f, 0.f}; }
                    }
                }
                const float* Lq = buf + qq * 4;
                const float* Lv = buf + 320 + rloc;
                f32x4 r4 = *(const f32x4*)(Lq), w4 = *(const f32x4*)(Lq + 64), k4 = *(const f32x4*)(Lq + 128), n4 = *(const f32x4*)(Lq + 192), b4 = *(const f32x4*)(Lq + 256);
                f32x4 r4n = *(const f32x4*)(Lq + STEP_F), w4n = *(const f32x4*)(Lq + STEP_F + 64), k4n = *(const f32x4*)(Lq + STEP_F + 128), n4n = *(const f32x4*)(Lq + STEP_F + 192), b4n = *(const f32x4*)(Lq + STEP_F + 256);
                float v[RPL], vn[RPL], yp[RPL][4];
                const bool qb0 = (qq & 1) != 0, qb1 = (qq & 2) != 0;
                float* ybq = yb + (qq & 3) * RB;
#pragma unroll
                for (int j = 0; j < RPL; ++j) { v[j] = Lv[4 * j]; vn[j] = Lv[STEP_F + 4 * j]; }
#pragma unroll
                for (int s = 0; s < TC; ++s) {
                    const int s2 = (s + 2 < TC) ? s + 2 : TC - 1;
                    const float* Ln = Lq + s2 * STEP_F;
                    const f32x4 r4m = *(const f32x4*)(Ln), w4m = *(const f32x4*)(Ln + 64), k4m = *(const f32x4*)(Ln + 128), n4m = *(const f32x4*)(Ln + 192), b4m = *(const f32x4*)(Ln + 256);
                    float vm[RPL];
#pragma unroll
                    for (int j = 0; j < RPL; ++j) vm[j] = Lv[s2 * STEP_F + 4 * j];
#pragma unroll
                    for (int j = 0; j < RPL; ++j) {
                        f32x2 pp = Sa[j] * (f32x2){n4[0], n4[1]};
                        pp = Sb[j] * (f32x2){n4[2], n4[3]} + pp;
                        float pd = pp[0] + pp[1];
                        const f32x2 vv = {v[j], v[j]};
                        f32x2 Ta = (f32x2){k4[0], k4[1]} * vv, Tb = (f32x2){k4[2], k4[3]} * vv;
                        Ta = Sa[j] * (f32x2){w4[0], w4[1]} + Ta; Tb = Sb[j] * (f32x2){w4[2], w4[3]} + Tb;
                        pd = red16(pd);
                        const f32x2 np = {-pd, -pd};
                        Sa[j] = (f32x2){b4[0], b4[1]} * np + Ta; Sb[j] = (f32x2){b4[2], b4[3]} * np + Tb;
                        f32x2 yy = Sa[j] * (f32x2){r4[0], r4[1]};
                        yy = Sb[j] * (f32x2){r4[2], r4[3]} + yy;
                        yp[j][s & 3] = yy[0] + yy[1];
                        if ((s & 3) == 3) ybq[(s - 3) * RB + 4 * j] = red16x4(yp[j][0], yp[j][1], yp[j][2], yp[j][3], qb0, qb1);
                    }
                    r4 = r4n; w4 = w4n; k4 = k4n; n4 = n4n; b4 = b4n;
                    r4n = r4m; w4n = w4m; k4n = k4m; n4n = n4m; b4n = b4m;
#pragma unroll
                    for (int j = 0; j < RPL; ++j) { v[j] = vn[j]; vn[j] = vm[j]; }
                }
                if (!LAT && q.last) {
#pragma unroll
                    for (int j = 0; j < RPL; ++j) {
                        const int irow = q.rq * RB + rloc + 4 * j;
                        *(f32x4*)(OST + ((size_t)((q.b * 2 + q.d) * 8 + q.h) * 64 + irow) * 64 + qq * 4) = (f32x4){Sa[j][0], Sa[j][1], Sb[j][0], Sb[j][1]};
                    }
                }
                __syncthreads();
            }
            __syncthreads();
        } else {
            for (int g = -1; g <= NCH; ++g) __syncthreads();
        }
    }
}
__device__ void phase_scan(char* shm) {
    const int tid = tid_l();
    for (int slot = blockIdx.x; slot < 256; slot += gridDim.x) {
        if (slot < 128) scan_pass<true>(shm, tid, slot);
        else scan_pass<false>(shm, tid, slot - 128);
        __syncthreads();
    }
}

__device__ void phase_post() {
    KParams* kp = kargs();
    const int tid = tid_l(), lane = tid & 63, wave = tid >> 6;
    const bf16_t* Z = (const bf16_t*)(kp->ws + OFF_R1);
    const bf16_t* Y = (const bf16_t*)(kp->ws + OFF_H);
    const float* BONUS = (const float*)(kp->ws + OFF_BONUS);
    bf16_t* YA = (bf16_t*)(kp->ws + OFF_R2 + R2_YA);
    bf16_t* YB = (bf16_t*)(kp->ws + OFF_R2 + R2_YB);
    const int c = lane * 8, head = lane >> 3;
    for (int row = blockIdx.x * 8 + wave; row < NTOK; row += gridDim.x * 8) {
        const u32x4 y0 = *(const u32x4*)(Y + (size_t)row * DR + c), y1 = *(const u32x4*)(Y + ((size_t)NTOK + row) * DR + c);
        float y[8];
#pragma unroll
        for (int i = 0; i < 4; ++i) { y[2 * i] = bflo(y0[i]) + bflo(y1[i]); y[2 * i + 1] = bfhi(y0[i]) + bfhi(y1[i]); }
        float s = 0.f;
#pragma unroll
        for (int i = 0; i < 8; ++i) s += y[i];
        s += __shfl_xor(s, 1); s += __shfl_xor(s, 2); s += __shfl_xor(s, 4);
        const float mean = s * (1.0f / 64.0f);
        float vs = 0.f;
#pragma unroll
        for (int i = 0; i < 8; ++i) { y[i] -= mean; vs += y[i] * y[i]; }
        vs += __shfl_xor(vs, 1); vs += __shfl_xor(vs, 2); vs += __shfl_xor(vs, 4);
        const float rs = rsqrtf(vs * (1.0f / 64.0f) + 64e-5f);
        const float bon = BONUS[(size_t)row * 8 + head] + BONUS[((size_t)NTOK + row) * 8 + head];
        const u32x4 vz = *(const u32x4*)(Z + (size_t)row * ZLD + 1024 + c), gz = *(const u32x4*)(Z + (size_t)row * ZLD + 1536 + c);
        const f32x4 gn0 = *(const f32x4*)(kp->in[23] + c), gn1 = *(const f32x4*)(kp->in[23] + c + 4);
        const f32x4 gb0 = *(const f32x4*)(kp->in[24] + c), gb1 = *(const f32x4*)(kp->in[24] + c + 4);
        float o[8];
#pragma unroll
        for (int i = 0; i < 8; ++i) {
            const float vv = (i & 1) ? bfhi(vz[i >> 1]) : bflo(vz[i >> 1]);
            const float gg = (i & 1) ? bfhi(gz[i >> 1]) : bflo(gz[i >> 1]);
            const float gain = i < 4 ? gn0[i & 3] : gn1[i & 3], bias = i < 4 ? gb0[i & 3] : gb1[i & 3];
            o[i] = (y[i] * rs * gain + bias + bon * vv) * sigm(gg);
        }
        u32x4 ov;
#pragma unroll
        for (int i = 0; i < 4; ++i) ov[i] = pk_bf16(o[2 * i], o[2 * i + 1]);
        *(u32x4*)(YA + (size_t)row * DR + c) = ov;
        const bool lat = row >= NCTX;
        const int pos = lat ? ((row - NCTX) & 63) : (row & 255);
        const int last = lat ? 63 : 255;
        const bool vl = pos > 0, vr = pos < last;
        const int rl = vl ? row - 1 : row, rr = vr ? row + 1 : row;
        const u32x4 ccm = *(const u32x4*)(Z + (size_t)row * ZLD + 2560 + c), xcm = *(const u32x4*)(Z + (size_t)row * ZLD + 3072 + c);
        const u32x4 ccl = *(const u32x4*)(Z + (size_t)rl * ZLD + 2560 + c), xcl = *(const u32x4*)(Z + (size_t)rl * ZLD + 3072 + c);
        const u32x4 ccr = *(const u32x4*)(Z + (size_t)rr * ZLD + 2560 + c), xcr = *(const u32x4*)(Z + (size_t)rr * ZLD + 3072 + c);
        const u32x4 cbz = *(const u32x4*)(Z + (size_t)row * ZLD + 2048 + c);
        const float fl = vl ? 1.f : 0.f, frr = vr ? 1.f : 0.f;
#pragma unroll
        for (int i = 0; i < 8; ++i) {
            const int w = i >> 1; const bool hi = i & 1;
            const float um = (hi ? bfhi(ccm[w]) : bflo(ccm[w])) * (hi ? bfhi(xcm[w]) : bflo(xcm[w]));
            const float ul = (hi ? bfhi(ccl[w]) : bflo(ccl[w])) * (hi ? bfhi(xcl[w]) : bflo(xcl[w])) * fl;
            const float ur = (hi ? bfhi(ccr[w]) : bflo(ccr[w])) * (hi ? bfhi(xcr[w]) : bflo(xcr[w])) * frr;
            const float cb = hi ? bfhi(cbz[w]) : bflo(cbz[w]);
            const float cv = ul * kp->in[25][c + i] + um * kp->in[25][512 + c + i] + ur * kp->in[25][1024 + c + i] + kp->in[26][c + i];
            o[i] = cb * cv;
        }
#pragma unroll
        for (int i = 0; i < 4; ++i) ov[i] = pk_bf16(o[2 * i], o[2 * i + 1]);
        *(u32x4*)(YB + (size_t)row * DR + c) = ov;
    }
}

#define XB_TMO      128
#define XB_XCNT(j)  (256  + 64 * (j))
#define XB_XSUB(j)  (1280 + 64 * (j))
#define XB_XGEN(j)  (2304 + 64 * (j))
#define XB_TOP      3328
#define XB_TOPGEN   3392
#define XCD_BAR_WORDS 3456
#define XB_SPIN_CAP (1u << 18)
#define XLAS __attribute__((address_space(3)))
__device__ __forceinline__ unsigned xb_ld(unsigned* p)              { return __hip_atomic_load(p, __ATOMIC_RELAXED, __HIP_MEMORY_SCOPE_AGENT); }
__device__ __forceinline__ unsigned xb_add(unsigned* p, unsigned v) { return __hip_atomic_fetch_add(p, v, __ATOMIC_RELAXED, __HIP_MEMORY_SCOPE_AGENT); }
__device__ __forceinline__ unsigned xb_xcc_id() { return (unsigned)__builtin_amdgcn_s_getreg((3 << 11) | 20) & 0xFu; }
#define XB_SPIN(cond, bar) do { unsigned _sp = 0; while (cond) { __builtin_amdgcn_s_sleep(1); \
    if ((++_sp & 255u) == 0u) { if (xb_ld(&(bar)[XB_TMO])) break; if (_sp > XB_SPIN_CAP) { atomicAdd(&(bar)[XB_TMO], 1u); break; } } } } while (0)
struct XcdBarrier { unsigned* bar; unsigned x; volatile XLAS unsigned* st; };
__device__ __forceinline__ XcdBarrier xcd_barrier_post(unsigned* bar, volatile XLAS unsigned* st) {
    XcdBarrier b; b.bar = bar; b.x = xb_xcc_id(); b.st = st;
    if (threadIdx.x == 0) (void)xb_add(&bar[XB_XCNT(b.x)], 1u);
    return b;
}
__device__ __forceinline__ void xcd_barrier_complete(unsigned* bar, unsigned x, unsigned& nloc, unsigned& nx) {
    const unsigned G = gridDim.x * gridDim.y * gridDim.z;
    unsigned sum, cnt, mine, sp = 0u;
    for (;;) {
        sum = 0u; cnt = 0u; mine = 0u;
#pragma unroll
        for (unsigned j = 0; j < 16; ++j) { const unsigned c = xb_ld(&bar[XB_XCNT(j)]); sum += c; cnt += (c > 0u) ? 1u : 0u; mine = (j == x) ? c : mine; }
        if (sum == G) break;
        __builtin_amdgcn_s_sleep(1);
        if ((++sp & 255u) == 0u) { if (xb_ld(&bar[XB_TMO])) break; if (sp > XB_SPIN_CAP) { atomicAdd(&bar[XB_TMO], 1u); break; } }
    }
    nloc = mine > 0u ? mine : 1u; nx = cnt > 0u ? cnt : 1u;
}
__device__ __forceinline__ void xcd_barrier(const XcdBarrier& b) {
    asm volatile("s_waitcnt vmcnt(0)" ::: "memory");
    __syncthreads();
    if (threadIdx.x == 0) {
        unsigned* bar = b.bar;
        __builtin_amdgcn_s_waitcnt(0);
        unsigned nloc = b.st[0], nx = b.st[1];
        if (nloc == 0u) { xcd_barrier_complete(bar, b.x, nloc, nx); b.st[0] = nloc; b.st[1] = nx; }
        const unsigned old = xb_add(&bar[XB_XSUB(b.x)], 1u);
        const unsigned gen = old / nloc;
        if (old + 1u == (gen + 1u) * nloc) {
            __builtin_amdgcn_fence(__ATOMIC_RELEASE, "agent");
            asm volatile("s_waitcnt vmcnt(0)" ::: "memory");
            const unsigned og = xb_add(&bar[XB_TOP], 1u);
            const unsigned tg = og / nx;
            if (og + 1u == (tg + 1u) * nx) xb_add(&bar[XB_TOPGEN], 1u);
            else XB_SPIN(xb_ld(&bar[XB_TOPGEN]) == tg, bar);
            __builtin_amdgcn_fence(__ATOMIC_ACQUIRE, "agent");
            xb_add(&bar[XB_XGEN(b.x)], 1u);
            asm volatile("s_waitcnt vmcnt(0)" ::: "memory");
        } else {
            XB_SPIN(xb_ld(&bar[XB_XGEN(b.x)]) == gen, bar);
            __builtin_amdgcn_fence(__ATOMIC_ACQUIRE, "agent");
            asm volatile("s_waitcnt vmcnt(0)" ::: "memory");
        }
    }
    __syncthreads();
}

struct RowJob { const float* xc; const float* xl; const bf16_t* P; float* xdst; bf16_t* hdst; int gA, mGate, gB, mShift, mScale; float sA; };

__global__ void __launch_bounds__(NTHREADS) fwd_megakernel(Params p) {
    extern __shared__ __attribute__((aligned(16))) char shm[];
    volatile XLAS unsigned* st = (volatile XLAS unsigned*)((XLAS unsigned char*)shm + LDS_STAGE);
    if (threadIdx.x < 4) st[threadIdx.x] = 0u;
    __syncthreads();
    const XcdBarrier xb = xcd_barrier_post((unsigned*)(kargs()->ws + OFF_BAR), st);
    const int ph_lo = kargs()->phase_lo, ph_hi = kargs()->phase_hi;
    for (int ph = ph_lo; ph < ph_hi; ++ph) {
        KParams* kp0 = kargs();
        char* ws = kp0->ws;
        bf16_t* H = (bf16_t*)(ws + OFF_H);
        bf16_t* R1 = (bf16_t*)(ws + OFF_R1);
        float* R2f = (float*)(ws + OFF_R2);
        float* out = kp0->out;
        const float* xlat_out = out + (size_t)NCTX * DM;
        int kind = 0;
        int cv_set = -1, cv_first = 0;
        RowJob R{}; GemmJob J{};
        switch (ph) {
        case 1: kind = 1; R = RowJob{kargs()->in[0], kargs()->in[1], nullptr, nullptr, H, 0, 0, 0, 0, 1, 0.f}; break;
        case 4: kind = 1; R = RowJob{kargs()->in[0], kargs()->in[1], (const bf16_t*)R2f, out, H, 1, 2, 2, 3, 4, 0.5f}; break;
        case 11: kind = 1; R = RowJob{out, xlat_out, (const bf16_t*)R1, out, H, 3, 5, 4, 6, 7, 1.0f}; break;
        case 14: kind = 1; R = RowJob{out, xlat_out, (const bf16_t*)R2f, out, nullptr, 5, 8, 0, 0, 0, 0.5f}; break;
        case 2: case 12: kind = 2;
            J.A0 = J.A1 = H; J.Bt0 = J.Bt1 = (const bf16_t*)(ws + (ph == 2 ? OFF_W13A : OFF_W13B)); J.lda = DM; J.ldb = DM; J.nN = 22; J.nsplit = 1; J.nt = DM / BK; J.kstride = 0; J.mode = 0; J.o1 = R1; break;
        case 3: case 13: kind = 2;
            J.A0 = J.A1 = R1; J.Bt0 = J.Bt1 = (const bf16_t*)(ws + (ph == 3 ? OFF_W2A : OFF_W2B)); J.lda = DFF; J.ldb = DFF; J.nN = 4; J.nsplit = 2; J.nt = 22; J.kstride = 22 * BK; J.mode = 1; J.o1 = R2f; break;
        case 5: kind = 2;
            J.A0 = J.A1 = H; J.Bt0 = J.Bt1 = (const bf16_t*)(ws + OFF_WIN); J.lda = DM; J.ldb = DM; J.nN = 24; J.nsplit = 1; J.nt = DM / BK; J.kstride = 0; J.mode = 2; J.o1 = R1; break;
        case 9: kind = 2;
            J.A0 = (const bf16_t*)(ws + OFF_R2 + R2_YA); J.A1 = (const bf16_t*)(ws + OFF_R2 + R2_YB); J.Bt0 = (const bf16_t*)(ws + OFF_WA); J.Bt1 = (const bf16_t*)(ws + OFF_WB);
            J.lda = DR; J.ldb = DR; J.nN = 4; J.nsplit = 2; J.nt = DR / BK; J.kstride = 0; J.mode = 3; J.o1 = ws + OFF_R2 + R2_GA; J.o2 = ws + OFF_R2 + R2_GB; J.Z = R1; break;
        case 10: kind = 2;
            J.A0 = (const bf16_t*)(ws + OFF_R2 + R2_GA); J.A1 = (const bf16_t*)(ws + OFF_R2 + R2_GB); J.Bt0 = J.Bt1 = (const bf16_t*)(ws + OFF_WO); J.lda = DM; J.ldb = DM; J.nN = 4; J.nsplit = 2; J.nt = DM / BK; J.kstride = 0; J.mode = 1; J.o1 = R1; break;
        default: break;
        }
        for (int rep = 0; rep <= ((REPEAT_MASK >> ph) & 1); ++rep) {
        if (rep) xcd_barrier(xb);
        if (kind == 1) phase_rowop(R.xc, R.xl, R.P, R.gA, R.mGate, R.sA, R.xdst, R.gB, R.mShift, R.mScale, R.hdst);
        else if (kind == 2) phase_gemm(shm, J);
        else if (ph == 0) { phase_convert(shm); cv_set = 0; cv_first = 0; }
        else if (ph == 6) phase_prep(shm);
        else if (ph == 7) { phase_scan(shm); cv_set = 1; cv_first = ((int)gridDim.x == 256) ? 128 : 0; }
        else if (ph == 8) phase_post();
        }
        if (cv_set >= 0 && (int)blockIdx.x >= cv_first)
            convert_tiles(shm, cv_set, ((int)blockIdx.x - cv_first) * 8 + (int)(threadIdx.x >> 6), ((int)gridDim.x - cv_first) * 8);
        if (ph + 1 < ph_hi) xcd_barrier(xb);
    }
}

extern "C" void kernel_launch(void* const* d_in, const int* in_sizes, int n_in, void* d_out, int out_size, void* d_ws, size_t ws_size, hipStream_t stream) {
    static int grid_blocks = 0;
    if (grid_blocks == 0) {
        if (ws_size < WS_END) { fprintf(stderr, "kernel_launch: workspace too small: %zu < %zu\n", ws_size, (size_t)WS_END); grid_blocks = -1; return; }
        int dev = 0, cus = 0, per_cu = 0;
        hipGetDevice(&dev);
        hipDeviceGetAttribute(&cus, hipDeviceAttributeMultiprocessorCount, dev);
        if (hipFuncSetAttribute((const void*)fwd_megakernel, hipFuncAttributeMaxDynamicSharedMemorySize, LDS_BYTES) != hipSuccess) { fprintf(stderr, "hipFuncSetAttribute failed\n"); grid_blocks = -1; return; }
        hipOccupancyMaxActiveBlocksPerMultiprocessor(&per_cu, (const void*)fwd_megakernel, NTHREADS, LDS_BYTES);
        if (per_cu < 1) { fprintf(stderr, "occupancy query says %d\n", per_cu); per_cu = 1; }
        if (per_cu > 1) per_cu = 1;
        grid_blocks = cus * per_cu;
    }
    if (grid_blocks < 0) return;
    Params p{};
    for (int i = 0; i < 30; ++i) p.in[i] = (const float*)d_in[i];
    p.out = (float*)d_out; p.ws = (char*)d_ws; p.phase_lo = 0; p.phase_hi = 15;
    if (hipMemsetAsync((char*)d_ws + OFF_BAR, 0, 16384, stream) != hipSuccess) { fprintf(stderr, "memset of barrier words failed\n"); return; }
    void* args[] = {&p};
    hipError_t e = hipLaunchCooperativeKernel((const void*)fwd_megakernel, dim3(grid_blocks), dim3(NTHREADS), args, LDS_BYTES, stream);
    if (e != hipSuccess) fprintf(stderr, "cooperative launch failed: %s (grid %d)\n", hipGetErrorString(e), grid_blocks);
}
```

```cpp
#include <hip/hip_runtime.h>
#include <hip/hip_cooperative_groups.h>
#include <cstdio>
namespace cg = cooperative_groups;

typedef unsigned short bf16_t;
typedef short bf16x8 __attribute__((ext_vector_type(8)));
typedef float f32x4 __attribute__((ext_vector_type(4)));
typedef unsigned u32x4 __attribute__((ext_vector_type(4)));
typedef unsigned u32x2 __attribute__((ext_vector_type(2)));

constexpr int DM = 1024, NTOK = 8192, NCTX = 4096, DFF = 2816, NIN = 6144, ZLD = 6144, DR = 512;
constexpr int NTHREADS = 512;
#define REPEAT_MASK 0
constexpr int LDS_STAGE = 131072;
constexpr int LDS_BYTES = LDS_STAGE + 16;

constexpr size_t SZ_W13 = (size_t)5632 * 1024 * 2, SZ_W2 = (size_t)1024 * 2816 * 2;
constexpr size_t OFF_W13A = 0;
constexpr size_t OFF_W2A = OFF_W13A + SZ_W13;
constexpr size_t OFF_W13B = OFF_W2A + SZ_W2;
constexpr size_t OFF_W2B = OFF_W13B + SZ_W13;
constexpr size_t OFF_WIN = OFF_W2B + SZ_W2;
constexpr size_t OFF_WA = OFF_WIN + (size_t)6144 * 1024 * 2;
constexpr size_t OFF_WB = OFF_WA + (size_t)1024 * 512 * 2;
constexpr size_t OFF_WO = OFF_WB + (size_t)1024 * 512 * 2;
constexpr size_t OFF_L2 = OFF_WO + (size_t)1024 * 1024 * 2;
constexpr size_t OFF_MOD = OFF_L2 + (size_t)4 * 512 * 64 * 2;
constexpr size_t OFF_BONUS = OFF_MOD + (size_t)2 * 3 * 9216 * 4;
constexpr size_t OFF_H = OFF_BONUS + (size_t)2 * 8192 * 8 * 4;
constexpr size_t OFF_R1 = OFF_H + (size_t)8192 * 1024 * 2;
constexpr size_t OFF_R2 = OFF_R1 + (size_t)8192 * 6144 * 2;
constexpr size_t OFF_BAR = OFF_R2 + (size_t)72 * 1024 * 1024;
constexpr size_t WS_END = OFF_BAR + 16384;
constexpr size_t R2_KK = 0;
constexpr size_t R2_WD = R2_KK + (size_t)8192 * 512 * 2;
constexpr size_t R2_KD = R2_WD + (size_t)2 * 8192 * 512 * 4;
constexpr size_t R2_BB = R2_KD + (size_t)2 * 8192 * 512 * 2;
constexpr size_t R2_YA = 0;
constexpr size_t R2_YB = R2_YA + (size_t)8192 * 512 * 2;
constexpr size_t R2_GA = R2_YB + (size_t)8192 * 512 * 2;
constexpr size_t R2_GB = R2_GA + (size_t)8192 * 1024 * 2;

struct Params {
    const float* in[30];
    float* out;
    char* ws;
    int phase_lo, phase_hi;
};


typedef const __attribute__((address_space(4))) Params KParams;
__device__ __forceinline__ KParams* kargs() {
    KParams* k = (KParams*)__builtin_amdgcn_kernarg_segment_ptr();
    asm volatile("" : "+s"(k));
    return k;
}

__device__ __forceinline__ int tid_l() { int t = threadIdx.x; asm volatile("" : "+v"(t)); return t; }
__device__ __forceinline__ float bf2f(unsigned short u) { return __uint_as_float(((unsigned)u) << 16); }
__device__ __forceinline__ float bflo(unsigned u) { return __uint_as_float(u << 16); }
__device__ __forceinline__ float bfhi(unsigned u) { return __uint_as_float(u & 0xffff0000u); }
__device__ __forceinline__ unsigned pk_bf16(float lo, float hi) { unsigned r; asm("v_cvt_pk_bf16_f32 %0, %1, %2" : "=v"(r) : "v"(lo), "v"(hi)); return r; }
__device__ __forceinline__ void st_wt16(void* p, u32x4 v) { asm volatile("global_store_dwordx4 %0, %1, off sc1\n\ts_nop 1" :: "v"(p), "v"(v) : "memory"); }
__device__ __forceinline__ void st_wt16f_nc(void* p, f32x4 v) { asm volatile("global_store_dwordx4 %0, %1, off sc1\n\ts_nop 1" :: "v"(p), "v"(v)); }
__device__ __forceinline__ void st_wt8_nc(void* p, u32x2 v) { asm volatile("global_store_dwordx2 %0, %1, off sc1\n\ts_nop 1" :: "v"(p), "v"(v)); }
__device__ __forceinline__ float sigm(float x) { return __builtin_amdgcn_rcpf(1.0f + __expf(-x)); }
__device__ __forceinline__ float wave_sum(float v) {
#pragma unroll
    for (int o = 32; o > 0; o >>= 1) v += __shfl_xor(v, o);
    return v;
}
template <int CTRL> __device__ __forceinline__ float dppf(float x) {
    return __int_as_float(__builtin_amdgcn_update_dpp(0, __float_as_int(x), CTRL, 0xf, 0xf, true));
}
__device__ __forceinline__ float red16(float x) {
    x += dppf<0xB1>(x);
    x += dppf<0x4E>(x);
    x += dppf<0x141>(x);
    x += dppf<0x140>(x);
    return x;
}

__device__ __forceinline__ void conv_tile_w(char* wl, const float* __restrict__ src, int src_ld, int k0, int c0,
                                            bf16_t* __restrict__ dst, int dst_ld, int n0, const float* __restrict__ mu, int mode, const int lane) {
    float v[64];
    const float* s = src + (size_t)k0 * src_ld + c0 + lane;
#pragma unroll
    for (int i = 0; i < 64; ++i) v[i] = __builtin_nontemporal_load(s + (size_t)i * src_ld);
    if (mode) {
#pragma unroll
        for (int i = 0; i < 64; ++i) { const float m = mu[k0 + i]; v[i] *= (mode == 1) ? m : (1.0f - m); }
    }
#pragma unroll
    for (int q = 0; q < 8; ++q) {
        u32x4 o;
#pragma unroll
        for (int i = 0; i < 4; ++i) o[i] = pk_bf16(v[8 * q + 2 * i], v[8 * q + 2 * i + 1]);
        *(u32x4*)(wl + lane * 144 + q * 16) = o;
    }
    asm volatile("s_waitcnt lgkmcnt(0)" ::: "memory");
#pragma unroll
    for (int i = 0; i < 8; ++i) {
        const int id = i * 64 + lane, r = id >> 3, ch = id & 7;
        const u32x4 o = *(const u32x4*)(wl + r * 144 + ch * 16);
        st_wt16(dst + (size_t)(n0 + r) * dst_ld + k0 + ch * 8, o);
    }
    asm volatile("s_waitcnt lgkmcnt(0)" ::: "memory");
}

__device__ void phase_convert(char* shm) {
    KParams* kp = kargs();
    float* lds = (float*)shm;
    const int tid = tid_l(), lane = tid & 63, wave = __builtin_amdgcn_readfirstlane(tid >> 6);
    float* sc = lds;
    float* red = lds + 3072;
    for (int i = tid; i < 3072; i += NTHREADS) {
        const int mi = i >> 10, k = i & 1023;
        const float cv = (mi == 0) ? kp->in[4][k] : kp->in[2][(mi - 1) * 1024 + k];
        sc[i] = cv * sigm(cv);
    }
    __syncthreads();
    float* modp = (float*)(kp->ws + OFF_MOD);
    for (int task = blockIdx.x; task < 288; task += gridDim.x) {
        const int kh = task / 144, cgp = task % 144, col = cgp * 64 + lane;
        const int kb = kh * 512 + wave * 64;
        const float* wm = kp->in[5] + (size_t)kb * 9216 + col;
        float a0 = 0.f, a1 = 0.f, a2 = 0.f;
#pragma unroll 16
        for (int i = 0; i < 64; ++i) {
            const float w = __builtin_nontemporal_load(wm + (size_t)i * 9216);
            a0 += sc[kb + i] * w; a1 += sc[1024 + kb + i] * w; a2 += sc[2048 + kb + i] * w;
        }
        red[(wave * 3 + 0) * 64 + lane] = a0; red[(wave * 3 + 1) * 64 + lane] = a1; red[(wave * 3 + 2) * 64 + lane] = a2;
        __syncthreads();
        if (tid < 192) {
            const int m = tid >> 6, cc = tid & 63;
            float s = kh == 0 ? kp->in[6][cgp * 64 + cc] : 0.f;
#pragma unroll
            for (int g = 0; g < 8; ++g) s += red[(g * 3 + m) * 64 + cc];
            modp[(kh * 3 + m) * 9216 + cgp * 64 + cc] = s;
        }
        __syncthreads();
    }
}

constexpr int T_W13 = 88 * 16, T_W2 = 16 * 44, T_WIN = 88 * 16, T_LORA = 8 * 16, T_WAB = 16 * 8, T_WO = 16 * 16, T_L2 = 32;
constexpr int CV_TOTAL = 2 * T_W13 + 2 * T_W2 + T_WIN + T_LORA + 2 * T_WAB + T_WO + T_L2;
constexpr int CV_SET1 = T_W13 + T_W2 + 2 * T_WAB + T_WO, CV_SET0 = CV_TOTAL - CV_SET1;
__device__ void convert_tiles(char* shm, int set, int gw, int nw) {
    KParams* kp = kargs();
    const int tid = tid_l(), lane = tid & 63, wave = __builtin_amdgcn_readfirstlane(tid >> 6);
    char* wl = shm + 20480 + wave * (64 * 144);
    const int cnt = set ? CV_SET1 : CV_SET0;
    for (int n = gw; n < cnt; n += nw) {
        int id;
        if (set == 0) id = n < T_W13 ? n : (n < T_W13 + T_W2 ? n + T_W13 : (n < T_W13 + T_W2 + T_WIN + T_LORA ? n + T_W13 + T_W2 : n + T_W13 + T_W2 + 2 * T_WAB + T_WO));
        else id = n < T_W13 ? n + T_W13 : (n < T_W13 + T_W2 ? n + T_W13 + T_W2 : n + T_W13 + T_W2 + T_WIN + T_LORA);
        if (id < 2 * T_W13) {
            const int which = id / T_W13; id -= which * T_W13;
            const int nt = id >> 4, kt = id & 15, j = nt >> 2, w = nt & 3;
            const int c0 = (w < 2) ? (128 * j + 64 * w) : (2816 + 128 * j + 64 * (w - 2));
            conv_tile_w(wl, kp->in[which ? 10 : 8], 5632, kt * 64, c0, (bf16_t*)(kp->ws + (which ? OFF_W13B : OFF_W13A)), 1024, nt * 64, nullptr, 0, lane);
            continue;
        }
        id -= 2 * T_W13;
        if (id < 2 * T_W2) {
            const int which = id / T_W2; id -= which * T_W2;
            const int nt = id / 44, kt = id % 44;
            conv_tile_w(wl, kp->in[which ? 11 : 9], 1024, kt * 64, nt * 64, (bf16_t*)(kp->ws + (which ? OFF_W2B : OFF_W2A)), 2816, nt * 64, nullptr, 0, lane);
            continue;
        }
        id -= 2 * T_W2;
        if (id < T_WIN) {
            const int nt = id >> 4, kt = id & 15;
            conv_tile_w(wl, kp->in[12], 5632, kt * 64, nt * 64, (bf16_t*)(kp->ws + OFF_WIN), 1024, nt * 64, nullptr, 0, lane);
            continue;
        }
        id -= T_WIN;
        if (id < T_LORA) {
            const int nt = id >> 4, kt = id & 15;
            const int pq = nt & 1, l = (nt >> 1) & 1, d = nt >> 2;
            const float* src = kp->in[l ? 18 : 15] + (size_t)d * 1024 * 64;
            conv_tile_w(wl, src, 64, kt * 64, 0, (bf16_t*)(kp->ws + OFF_WIN), 1024, 5632 + nt * 64, kp->in[13] + (d * 2 + l) * 1024, pq ? 1 : 2, lane);
            continue;
        }
        id -= T_LORA;
        if (id < 2 * T_WAB) {
            const int which = id / T_WAB; id -= which * T_WAB;
            const int nt = id >> 3, kt = id & 7;
            conv_tile_w(wl, kp->in[which ? 28 : 27], 1024, kt * 64, nt * 64, (bf16_t*)(kp->ws + (which ? OFF_WB : OFF_WA)), 512, nt * 64, nullptr, 0, lane);
            continue;
        }
        id -= 2 * T_WAB;
        if (id < T_WO) {
            const int nt = id >> 4, kt = id & 15;
            conv_tile_w(wl, kp->in[29], 1024, kt * 64, nt * 64, (bf16_t*)(kp->ws + OFF_WO), 1024, nt * 64, nullptr, 0, lane);
            continue;
        }
        id -= T_WO;
        {
            const int dl = id >> 3, nt = id & 7, d = dl >> 1, l = dl & 1;
            const float* src = kp->in[l ? 19 : 16] + (size_t)d * 64 * 512;
            conv_tile_w(wl, src, 512, 0, nt * 64, (bf16_t*)(kp->ws + OFF_L2) + (size_t)dl * 512 * 64, 64, nt * 64, nullptr, 0, lane);
        }
    }
}

__device__ void phase_rowop(const float* __restrict__ xctx, const float* __restrict__ xlat, const bf16_t* __restrict__ P,
                            int gA, int mGate, float sA, float* __restrict__ xdst, int gB, int mShift, int mScale, bf16_t* __restrict__ hdst) {
    KParams* kp = kargs();
    const int tid = tid_l(), lane = tid & 63, wave = tid >> 6;
    const float* G = kp->in[7];
    const float* MOD = (const float*)(kp->ws + OFF_MOD);
    constexpr int RW = 4;
    for (int row0 = (blockIdx.x * 8 + wave) * RW; row0 < NTOK; row0 += gridDim.x * 8 * RW) {
        const int mi = row0 < NCTX ? 0 : 1 + ((row0 - NCTX) >> 11);
        const float* mod = MOD + mi * 9216;
        const float* xs = row0 < NCTX ? xctx + (size_t)row0 * DM : xlat + (size_t)(row0 - NCTX) * DM;
        f32x4 x[RW][4];
#pragma unroll
        for (int r = 0; r < RW; ++r)
#pragma unroll
            for (int i = 0; i < 4; ++i) x[r][i] = __builtin_nontemporal_load((const f32x4*)(xs + (size_t)r * DM + (i * 64 + lane) * 4));
        if (P) {
            u32x2 p0[RW][4], p1[RW][4];
#pragma unroll
            for (int r = 0; r < RW; ++r)
#pragma unroll
                for (int i = 0; i < 4; ++i) {
                    const size_t o = (size_t)(row0 + r) * DM + (i * 64 + lane) * 4;
                    p0[r][i] = __builtin_nontemporal_load((const u32x2*)(P + o)); p1[r][i] = __builtin_nontemporal_load((const u32x2*)(P + (size_t)NTOK * DM + o));
                }
            f32x4 gm[4];
#pragma unroll
            for (int i = 0; i < 4; ++i) {
                const int c = (i * 64 + lane) * 4;
                gm[i] = *(const f32x4*)(G + gA * DM + c) * (*(const f32x4*)(mod + mGate * DM + c) + *(const f32x4*)(mod + 27648 + mGate * DM + c));
            }
            float ss[RW];
#pragma unroll
            for (int r = 0; r < RW; ++r) {
                ss[r] = 0.f;
#pragma unroll
                for (int i = 0; i < 4; ++i) {
                    const f32x4 f = (f32x4){bflo(p0[r][i][0]) + bflo(p1[r][i][0]), bfhi(p0[r][i][0]) + bfhi(p1[r][i][0]), bflo(p0[r][i][1]) + bflo(p1[r][i][1]), bfhi(p0[r][i][1]) + bfhi(p1[r][i][1])};
                    ss[r] += f[0] * f[0] + f[1] * f[1] + f[2] * f[2] + f[3] * f[3];
                }
            }
#pragma unroll
            for (int o = 32; o > 0; o >>= 1) {
#pragma unroll
                for (int r = 0; r < RW; ++r) ss[r] += __shfl_xor(ss[r], o);
            }
#pragma unroll
            for (int r = 0; r < RW; ++r) {
                const float rstd = rsqrtf(ss[r] * (1.0f / DM) + 1e-6f) * sA;
#pragma unroll
                for (int i = 0; i < 4; ++i) {
                    const int c = (i * 64 + lane) * 4;
                    const f32x4 f = (f32x4){bflo(p0[r][i][0]) + bflo(p1[r][i][0]), bfhi(p0[r][i][0]) + bfhi(p1[r][i][0]), bflo(p0[r][i][1]) + bflo(p1[r][i][1]), bfhi(p0[r][i][1]) + bfhi(p1[r][i][1])};
                    x[r][i] += gm[i] * (f * rstd);
                    st_wt16f_nc(xdst + (size_t)(row0 + r) * DM + c, x[r][i]);
                }
            }
        }
        if (hdst) {
            f32x4 gs[4], sh[4];
#pragma unroll
            for (int i = 0; i < 4; ++i) {
                const int c = (i * 64 + lane) * 4;
                gs[i] = *(const f32x4*)(G + gB * DM + c) * (*(const f32x4*)(mod + mScale * DM + c) + *(const f32x4*)(mod + 27648 + mScale * DM + c) + 1.0f);
                sh[i] = *(const f32x4*)(mod + mShift * DM + c) + *(const f32x4*)(mod + 27648 + mShift * DM + c);
            }
            float ss[RW];
#pragma unroll
            for (int r = 0; r < RW; ++r) {
                ss[r] = 0.f;
#pragma unroll
                for (int i = 0; i < 4; ++i) ss[r] += x[r][i][0] * x[r][i][0] + x[r][i][1] * x[r][i][1] + x[r][i][2] * x[r][i][2] + x[r][i][3] * x[r][i][3];
            }
#pragma unroll
            for (int o = 32; o > 0; o >>= 1) {
#pragma unroll
                for (int r = 0; r < RW; ++r) ss[r] += __shfl_xor(ss[r], o);
            }
#pragma unroll
            for (int r = 0; r < RW; ++r) {
                const float rstd = rsqrtf(ss[r] * (1.0f / DM) + 1e-6f);
#pragma unroll
                for (int i = 0; i < 4; ++i) {
                    const int c = (i * 64 + lane) * 4;
                    const f32x4 h = (x[r][i] * rstd) * gs[i] + sh[i];
                    u32x2 o; o[0] = pk_bf16(h[0], h[1]); o[1] = pk_bf16(h[2], h[3]);
                    st_wt8_nc(hdst + (size_t)(row0 + r) * DM + c, o);
                }
            }
        }
    }
}

constexpr int BM = 256, BK = 64, HALF = 128, HT = HALF * BK;
__device__ __forceinline__ int lds_byte(int r, int c) {
    const int st = (r >> 4) * 2 + (c >> 5), rr = r & 15, cc = c & 31, ob = rr * 64 + cc * 2;
    return st * 1024 + (ob ^ (((ob >> 9) & 1) << 5));
}
__device__ __forceinline__ void stage_rc(int b, int& R, int& C) {
    const int st = b / 1024, sb = b % 1024, swz = sb ^ (((sb >> 9) & 1) << 5);
    R = (st >> 1) * 16 + swz / 64; C = (st & 1) * 32 + (swz % 64) / 2;
}
__device__ __forceinline__ void unit_map(int wgid, int nM, int nN, int& pm, int& pn) {
    const int NXCD = 8, WGM = 8, nwg = nM * nN;
    { const int q = nwg / NXCD, r = nwg % NXCD, xcd = wgid % NXCD, off = wgid / NXCD; wgid = (xcd < r ? xcd * (q + 1) : r * (q + 1) + (xcd - r) * q) + off; }
    const int nig = WGM * nN, gid = wgid / nig, fm = gid * WGM, gsz = min(nM - fm, WGM);
    pm = fm + ((wgid % nig) % gsz); pn = (wgid % nig) / gsz;
}

#define LAS __attribute__((address_space(3)))
constexpr int HTB = HALF * BK * 2;
__device__ __forceinline__ void gemm_tile(char* shmc, const bf16_t* __restrict__ A, int lda, const bf16_t* __restrict__ Bt, int ldb,
                                          int brow, int bcol, int nt, f32x4 (&acc)[2][2][4][2], const int tid) {
    LAS unsigned char* lds = (LAS unsigned char*)shmc;
    const int wid = __builtin_amdgcn_readfirstlane(tid >> 6), lane = tid & 63, wr = wid >> 2, wc = wid & 3, fr = lane & 15, fq = lane >> 4;
    unsigned voffA[2], voffB[2];
#pragma unroll
    for (int i = 0; i < 2; ++i) { int R, C; stage_rc(tid * 16 + i * 8192, R, C); voffA[i] = (unsigned)(R * lda + C) * 2u; voffB[i] = (unsigned)(R * ldb + C) * 2u; }
    const size_t kstep = (size_t)(BK * 2);
    const size_t hstepA = (size_t)HALF * lda * 2, hstepB = (size_t)HALF * ldb * 2;
    const unsigned ldsw = (unsigned)wid * 1024u;
    const int aoff = lds_byte(wr * 64 + fr, fq * 8), boff = lds_byte(wc * 32 + fr, fq * 8);
    const char* cA = (const char*)A + (size_t)brow * lda * 2;
    const char* cB = (const char*)Bt + (size_t)bcol * ldb * 2;
#define SA(b, h) (((b) * 2 + (h)) * HTB)
#define SB(b, h) ((4 + (b) * 2 + (h)) * HTB)
#define STAGE(bufoff, gbase, voff) do { _Pragma("unroll") for (int _i = 0; _i < 2; ++_i) \
    __builtin_amdgcn_global_load_lds((const unsigned*)((const char*)(gbase) + (voff)[_i]), (LAS unsigned*)(lds + (bufoff) + ldsw + _i * 8192), 16, 0, 0); } while (0)
#define LDA(dst, b, h) do { _Pragma("unroll") for (int m = 0; m < 4; ++m) _Pragma("unroll") for (int k = 0; k < 2; ++k) dst[m][k] = *(const LAS bf16x8*)(lds + SA(b, h) + aoff + m * 2048 + k * 1024); } while (0)
#define LDB(dst, b, h) do { _Pragma("unroll") for (int n = 0; n < 2; ++n) _Pragma("unroll") for (int k = 0; k < 2; ++k) dst[n][k] = *(const LAS bf16x8*)(lds + SB(b, h) + boff + n * 2048 + k * 1024); } while (0)
#define MMA(ai, bj, At_, Bt_) do { __builtin_amdgcn_s_setprio(1); _Pragma("unroll") for (int m = 0; m < 4; ++m) _Pragma("unroll") for (int n = 0; n < 2; ++n) _Pragma("unroll") for (int k = 0; k < 2; ++k) \
      acc[ai][bj][m][n] = __builtin_amdgcn_mfma_f32_16x16x32_bf16(Bt_[n][k], At_[m][k], acc[ai][bj][m][n], 0, 0, 0); \
    __builtin_amdgcn_s_setprio(0); } while (0)
#define WAIT_V(n) asm volatile("s_waitcnt vmcnt(" #n ")" ::: "memory")
#define WAIT_L(n) asm volatile("s_waitcnt lgkmcnt(" #n ")" ::: "memory")
#define BAR __builtin_amdgcn_s_barrier()
#define SCHED __builtin_amdgcn_sched_barrier(0)
#pragma unroll
    for (int a = 0; a < 2; ++a)
#pragma unroll
        for (int b = 0; b < 2; ++b)
#pragma unroll
            for (int m = 0; m < 4; ++m)
#pragma unroll
                for (int n = 0; n < 2; ++n) acc[a][b][m][n] = (f32x4){0.f, 0.f, 0.f, 0.f};
    bf16x8 At[4][2], B0[2][2], B1[2][2];
    STAGE(SB(0, 0), cB, voffB); STAGE(SA(0, 0), cA, voffA); STAGE(SB(0, 1), cB + hstepB, voffB); STAGE(SA(0, 1), cA + hstepA, voffA);
    if (wr == 1) BAR;
    WAIT_V(4); BAR;
    STAGE(SB(1, 0), cB + kstep, voffB); STAGE(SA(1, 0), cA + kstep, voffA); STAGE(SB(1, 1), cB + hstepB + kstep, voffB);
    WAIT_V(6); BAR;
    for (int t = 0; t < nt - 2; t += 2) {
        const char* a1 = cA + (size_t)(t + 1) * kstep;
        const char* a2 = cA + (size_t)(t + 2) * kstep; const char* b2 = cB + (size_t)(t + 2) * kstep;
        const char* a3 = a2 + kstep; const char* b3 = b2 + kstep;
        LDB(B0, 0, 0); SCHED; LDA(At, 0, 0); STAGE(SA(1, 1), a1 + hstepA, voffA);
        WAIT_L(8); BAR; WAIT_L(0); MMA(0, 0, At, B0); BAR; SCHED;
        LDB(B1, 0, 1); STAGE(SB(0, 0), b2, voffB);
        BAR; WAIT_L(0); MMA(0, 1, At, B1); BAR;
        LDA(At, 0, 1); STAGE(SA(0, 0), a2, voffA);
        BAR; WAIT_L(0); MMA(1, 0, At, B0); BAR; SCHED;
        STAGE(SB(0, 1), b2 + hstepB, voffB);
        WAIT_V(6); BAR; MMA(1, 1, At, B1); BAR;
        LDB(B0, 1, 0); SCHED; LDA(At, 1, 0); STAGE(SA(0, 1), a2 + hstepA, voffA);
        WAIT_L(8); BAR; WAIT_L(0); MMA(0, 0, At, B0); BAR; SCHED;
        LDB(B1, 1, 1); STAGE(SB(1, 0), b3, voffB);
        BAR; WAIT_L(0); MMA(0, 1, At, B1); BAR;
        LDA(At, 1, 1); STAGE(SA(1, 0), a3, voffA);
        BAR; WAIT_L(0); MMA(1, 0, At, B0); BAR; SCHED;
        STAGE(SB(1, 1), b3 + hstepB, voffB);
        WAIT_V(6); BAR; MMA(1, 1, At, B1); BAR;
    }
    { const char* a1 = cA + (size_t)(nt - 1) * kstep;
      LDB(B0, 0, 0); LDA(At, 0, 0); STAGE(SA(1, 1), a1 + hstepA, voffA);
      BAR; WAIT_L(0); MMA(0, 0, At, B0); BAR;
      LDB(B1, 0, 1); BAR; WAIT_L(0); MMA(0, 1, At, B1); BAR;
      LDA(At, 0, 1); WAIT_V(4); BAR; WAIT_L(0); MMA(1, 0, At, B0); MMA(1, 1, At, B1); BAR; }
    { LDB(B0, 1, 0); LDA(At, 1, 0); WAIT_V(2); BAR; WAIT_L(0); MMA(0, 0, At, B0); BAR;
      LDB(B1, 1, 1); WAIT_V(0); BAR; WAIT_L(0); MMA(0, 1, At, B1); BAR;
      LDA(At, 1, 1); BAR; WAIT_L(0); MMA(1, 0, At, B0); MMA(1, 1, At, B1); BAR; }
    if (wr == 0) BAR;
#undef SA
#undef SB
#undef STAGE
#undef LDA
#undef LDB
#undef MMA
}

struct GemmJob {
    const bf16_t* A0; const bf16_t* A1; const bf16_t* Bt0; const bf16_t* Bt1;
    int lda, ldb, nN, nsplit, nt, kstride, mode, pad;
    void* o1; void* o2; const bf16_t* Z;
};
__device__ void phase_gemm(char* shm, const GemmJob& J) {
    const int tid = tid_l();
    const int wid = __builtin_amdgcn_readfirstlane(tid >> 6), wr = wid >> 2, wc = wid & 3;
    const int nM = 32, nN = J.nN, nMN = nM * nN;
    const int mode = J.mode;
    for (int u = blockIdx.x; u < nMN * J.nsplit; u += gridDim.x) {
        const int ks = u / nMN;
        int pm, pn; unit_map(u - ks * nMN, nM, nN, pm, pn);
        {
            const int sub = ks;
            f32x4 acc[2][2][4][2];
            const size_t koff = (size_t)ks * J.kstride;
            gemm_tile(shm, (ks ? J.A1 : J.A0) + koff, J.lda, (ks ? J.Bt1 : J.Bt0) + koff, J.ldb, pm * BM, pn * BM, J.nt, acc, tid);
            int lane_e = tid & 63; asm volatile("" : "+v"(lane_e));
            const int fr = lane_e & 15, fq = lane_e >> 4;
            const int NBJ = (mode == 0) ? 1 : 2;
            const int W8 = NBJ * 16;
            const int pitch = NBJ * 256 + 32;
            bf16_t* obase; int old_, col0;
            if (mode == 0)      { obase = (bf16_t*)J.o1; old_ = DFF; col0 = pn * 128; }
            else if (mode == 1) { obase = (bf16_t*)J.o1 + (size_t)ks * NTOK * DM; old_ = DM; col0 = pn * BM; }
            else if (mode == 2) { obase = (bf16_t*)J.o1; old_ = ZLD; col0 = pn * BM; }
            else                { obase = (bf16_t*)(sub ? J.o2 : J.o1); old_ = DM; col0 = pn * BM; }
            const bf16_t* Zg = J.Z + (sub ? 4608 : 3584);
#pragma unroll
            for (int ai = 0; ai < 2; ++ai) {
#pragma unroll
                for (int m = 0; m < 4; ++m) {
                    const int rloc = wr * 64 + m * 16 + fr;
                    const int row = pm * BM + ai * HALF + rloc;
#pragma unroll
                    for (int n = 0; n < 2; ++n) {
                        if (mode == 0) {
                            const f32x4 g = acc[ai][0][m][n], up = acc[ai][1][m][n];
                            float o[4];
#pragma unroll
                            for (int j = 0; j < 4; ++j) o[j] = g[j] * sigm(g[j]) * up[j];
                            u32x2 v; v[0] = pk_bf16(o[0], o[1]); v[1] = pk_bf16(o[2], o[3]);
                            *(u32x2*)(shm + rloc * pitch + (wc * 32 + n * 16 + fq * 4) * 2) = v;
                        } else {
#pragma unroll
                            for (int bj = 0; bj < 2; ++bj) {
                                const int cl = bj * HALF + wc * 32 + n * 16 + fq * 4;
                                f32x4 a = acc[ai][bj][m][n];
                                if (mode == 3) {
                                    const u32x2 gz = *(const u32x2*)(Zg + (size_t)row * ZLD + col0 + cl);
                                    a[0] *= sigm(bflo(gz[0])); a[1] *= sigm(bfhi(gz[0])); a[2] *= sigm(bflo(gz[1])); a[3] *= sigm(bfhi(gz[1]));
                                }
                                u32x2 v; v[0] = pk_bf16(a[0], a[1]); v[1] = pk_bf16(a[2], a[3]);
                                *(u32x2*)(shm + rloc * pitch + cl * 2) = v;
                            }
                        }
                    }
                }
                __syncthreads();
                const int w8sh = (mode == 0) ? 4 : 5;
                for (int c = tid; c < 128 * W8; c += NTHREADS) {
                    const int r = c >> w8sh, cc = c & (W8 - 1);
                    const u32x4 v = *(const u32x4*)(shm + r * pitch + cc * 16);
                    st_wt16(obase + (size_t)(pm * BM + ai * HALF + r) * old_ + col0 + cc * 8, v);
                }
                __syncthreads();
            }
        }
    }
}

__device__ void phase_prep(char* shm) {
    KParams* kp = kargs();
    const int tid = tid_l(), lane = tid & 63, wave = tid >> 6, fr = lane & 15, fq = lane >> 4;
    float* wt = (float*)shm + wave * (16 * 68);
    const bf16_t* Z = (const bf16_t*)(kp->ws + OFF_R1);
    const bf16_t* L2T = (const bf16_t*)(kp->ws + OFF_L2);
    bf16_t* KK = (bf16_t*)(kp->ws + OFF_R2 + R2_KK);
    float* WD = (float*)(kp->ws + OFF_R2 + R2_WD);
    bf16_t* KD = (bf16_t*)(kp->ws + OFF_R2 + R2_KD);
    bf16_t* BB = (bf16_t*)(kp->ws + OFF_R2 + R2_BB);
    float* BONUS = (float*)(kp->ws + OFF_BONUS);
    for (int unit = blockIdx.x * 8 + wave; unit < 2048; unit += gridDim.x * 8) {
        const int hq = unit & 1, d = (unit >> 1) & 1, tg = unit >> 2;
        const int row = tg * 16 + fr;
        const bool lat = row >= NCTX;
        const int pos = lat ? ((row - NCTX) & 2047) : (row & 255);
        const int T = lat ? 2048 : 256;
        const bool valid = d == 0 ? (pos > 0) : (pos < T - 1);
        const int srow = valid ? (d == 0 ? row - 1 : row + 1) : row;
        bf16x8 Bz[2][2];
#pragma unroll
        for (int l = 0; l < 2; ++l)
#pragma unroll
            for (int ks = 0; ks < 2; ++ks) {
                const int k = ks * 32 + fq * 8;
                const u32x4 Pv = *(const u32x4*)(Z + (size_t)row * ZLD + 5632 + ((d * 2 + l) * 2 + 0) * 64 + k);
                u32x4 Qv = *(const u32x4*)(Z + (size_t)srow * ZLD + 5632 + ((d * 2 + l) * 2 + 1) * 64 + k);
                if (!valid) Qv = (u32x4){0u, 0u, 0u, 0u};
                u32x4 o;
#pragma unroll
                for (int i = 0; i < 4; ++i) {
                    float z0 = bflo(Pv[i]) + bflo(Qv[i]), z1 = bfhi(Pv[i]) + bfhi(Qv[i]);
                    if (l == 0) {
                        z0 = 1.0f - 2.0f * __builtin_amdgcn_rcpf(__expf(2.0f * z0) + 1.0f);
                        z1 = 1.0f - 2.0f * __builtin_amdgcn_rcpf(__expf(2.0f * z1) + 1.0f);
                    }
                    o[i] = pk_bf16(z0, z1);
                }
                Bz[l][ks] = __builtin_bit_cast(bf16x8, o);
            }
        for (int hh = hq * 4; hh < hq * 4 + 4; ++hh) {
            f32x4 accw[4], acca[4];
#pragma unroll
            for (int mt = 0; mt < 4; ++mt) {
                accw[mt] = (f32x4){0.f, 0.f, 0.f, 0.f}; acca[mt] = (f32x4){0.f, 0.f, 0.f, 0.f};
#pragma unroll
                for (int ks = 0; ks < 2; ++ks) {
                    const bf16x8 Aw = *(const bf16x8*)(L2T + ((size_t)(d * 2 + 0) * 512 + hh * 64 + mt * 16 + fr) * 64 + ks * 32 + fq * 8);
                    const bf16x8 Aa = *(const bf16x8*)(L2T + ((size_t)(d * 2 + 1) * 512 + hh * 64 + mt * 16 + fr) * 64 + ks * 32 + fq * 8);
                    accw[mt] = __builtin_amdgcn_mfma_f32_16x16x32_bf16(Aw, Bz[0][ks], accw[mt], 0, 0, 0);
                    acca[mt] = __builtin_amdgcn_mfma_f32_16x16x32_bf16(Aa, Bz[1][ks], acca[mt], 0, 0, 0);
                }
            }
            float ss = 0.f, bon = 0.f;
            f32x4 kkr[4], kd[4];
#pragma unroll
            for (int mt = 0; mt < 4; ++mt) {
                const int c = hh * 64 + mt * 16 + fq * 4;
                const f32x4 w0 = *(const f32x4*)(kp->in[14] + d * 512 + c), a0 = *(const f32x4*)(kp->in[17] + d * 512 + c);
                const f32x4 kkp = *(const f32x4*)(kp->in[20] + c), kap = *(const f32x4*)(kp->in[21] + c), rkp = *(const f32x4*)(kp->in[22] + c);
                const u32x2 kz = *(const u32x2*)(Z + (size_t)row * ZLD + 512 + c), rz = *(const u32x2*)(Z + (size_t)row * ZLD + c);
                const float kv[4] = {bflo(kz[0]), bfhi(kz[0]), bflo(kz[1]), bfhi(kz[1])};
                const float rv[4] = {bflo(rz[0]), bfhi(rz[0]), bflo(rz[1]), bfhi(rz[1])};
#pragma unroll
                for (int j = 0; j < 4; ++j) {
                    const float xw = accw[mt][j] + w0[j];
                    accw[mt][j] = __expf(-0.60653065971f * sigm(xw));
                    const float a = sigm(acca[mt][j] + a0[j]);
                    acca[mt][j] = a;
                    const float kr = kv[j] * kkp[j];
                    kkr[mt][j] = kr; ss += kr * kr;
                    const float kdd = kv[j] * (1.0f + (a - 1.0f) * kap[j]);
                    kd[mt][j] = kdd;
                    bon += rv[j] * kdd * rkp[j];
                }
            }
            ss += __shfl_xor(ss, 16); ss += __shfl_xor(ss, 32);
            bon += __shfl_xor(bon, 16); bon += __shfl_xor(bon, 32);
            const float inv = rsqrtf(ss + 1e-12f);
            const int row0 = tg * 16;
#pragma unroll
            for (int pass = 0; pass < 4; ++pass) {
                if (pass == 3 && d != 0) break;
#pragma unroll
                for (int mt = 0; mt < 4; ++mt) {
                    f32x4 val;
                    if (pass == 0) val = accw[mt];
                    else if (pass == 1) val = kd[mt];
                    else if (pass == 2) val = kkr[mt] * inv * acca[mt];
                    else val = kkr[mt] * inv;
                    *(f32x4*)(wt + fr * 68 + mt * 16 + fq * 4) = val;
                }
                asm volatile("s_waitcnt lgkmcnt(0)" ::: "memory");
#pragma unroll
                for (int i = 0; i < 4; ++i) {
                    const int id = i * 64 + lane, tk = id >> 4, c4 = (id & 15) * 4;
                    const f32x4 val = *(const f32x4*)(wt + tk * 68 + c4);
                    const size_t o = ((size_t)d * NTOK + row0 + tk) * DR + hh * 64 + c4;
                    if (pass == 0) *(f32x4*)(WD + o) = val;
                    else {
                        u32x2 v; v[0] = pk_bf16(val[0], val[1]); v[1] = pk_bf16(val[2], val[3]);
                        if (pass == 1) *(u32x2*)(KD + o) = v;
                        else if (pass == 2) *(u32x2*)(BB + o) = v;
                        else *(u32x2*)(KK + (size_t)(row0 + tk) * DR + hh * 64 + c4) = v;
                    }
                }
                asm volatile("s_waitcnt lgkmcnt(0)" ::: "memory");
            }
            if (fq == 0) BONUS[((size_t)d * NTOK + row) * 8 + hh] = bon;
        }
    }
}

__device__ __forceinline__ float red16x4(float p0, float p1, float p2, float p3, const bool b0, const bool b1) {
    const float own01 = b0 ? p1 : p0, snd01 = b0 ? p0 : p1;
    const float own23 = b0 ? p3 : p2, snd23 = b0 ? p2 : p3;
    const float r01 = own01 + dppf<0xB1>(snd01);
    const float r23 = own23 + dppf<0xB1>(snd23);
    const float own = b1 ? r23 : r01, snd = b1 ? r01 : r23;
    float r = own + dppf<0x4E>(snd);
    r += dppf<0x124>(r);
    r += dppf<0x128>(r);
    return r;
}
constexpr int TC = 32, STEP_F = 352;
typedef float f32x2 __attribute__((ext_vector_type(2)));
constexpr int SCAN_IN_F = TC * STEP_F;
constexpr int SCAN_Y_OFF = 2 * SCAN_IN_F;
struct ChunkDesc { int base, T, d, h, rq, c, b; bool first, last; };
template <bool LAT> __device__ __forceinline__ ChunkDesc chunk_desc(int slot, int g) {
    ChunkDesc q;
    if (LAT) {
        const int chain = slot >> 2; q.rq = slot & 3; q.b = chain >> 4; q.h = (chain >> 1) & 7; q.d = chain & 1;
        q.T = 2048; q.base = NCTX + q.b * 2048; q.c = g; q.first = g == 0; q.last = false;
    } else {
        const int u = slot * 4 + (g >> 3), chain = u >> 1; q.rq = u & 1; q.b = chain >> 4; q.h = (chain >> 1) & 7; q.d = chain & 1;
        q.T = 256; q.base = q.b * 256; q.c = g & 7; q.first = q.c == 0; q.last = q.c == 7;
    }
    return q;
}
__device__ __forceinline__ void st4(float* dst, unsigned a, unsigned b) {
    *(f32x4*)dst = (f32x4){bflo(a), bfhi(a), bflo(b), bfhi(b)};
}
struct LReg { u32x4 r8, k8, kk8, b8, v8; f32x4 w0, w1; };

template <bool LAT> __device__ __forceinline__ void scan_pass(char* shm, const int tid, const int slot) {
    constexpr int NSW = 4, RPL = LAT ? 1 : 2, RB = NSW * 4 * RPL, NCH = LAT ? 64 : 32;
    KParams* kp = kargs();
    float* lds = (float*)shm;
    const int wave = __builtin_amdgcn_readfirstlane(tid >> 6), lane = tid & 63;
    const bf16_t* Z = (const bf16_t*)(kp->ws + OFF_R1);
    const bf16_t* KK = (const bf16_t*)(kp->ws + OFF_R2 + R2_KK);
    const float* WD = (const float*)(kp->ws + OFF_R2 + R2_WD);
    const bf16_t* KD = (const bf16_t*)(kp->ws + OFF_R2 + R2_KD);
    const bf16_t* BB = (const bf16_t*)(kp->ws + OFF_R2 + R2_BB);
    bf16_t* Y = (bf16_t*)(kp->ws + OFF_H);
    float* OST = kp->out + (size_t)NTOK * DM;
    const float* ST0 = kp->in[3];
    {
        if (wave >= 4) {
            const int lt = tid - 256, s = lt >> 3, cg8 = (lt & 7) * 8;
            constexpr int NV = TC * RB / 8;
            LReg R;
            auto ld_chunk = [&](int g) {
                const ChunkDesc q = chunk_desc<LAT>(slot, g);
                const int tt = q.c * TC + s, t = q.d ? q.T - 1 - tt : tt, row = q.base + t;
                const int ch = q.h * 64 + cg8;
                const size_t od = ((size_t)q.d * NTOK + row) * DR + ch;
                R.r8 = *(const u32x4*)(Z + (size_t)row * ZLD + ch);
                R.w0 = *(const f32x4*)(WD + od); R.w1 = *(const f32x4*)(WD + od + 4);
                R.k8 = *(const u32x4*)(KD + od);
                R.kk8 = *(const u32x4*)(KK + (size_t)row * DR + ch);
                R.b8 = *(const u32x4*)(BB + od);
                if (lt < NV) {
                    const int s2 = lt / (RB / 8), hf = lt % (RB / 8);
                    const int tt2 = q.c * TC + s2, t2 = q.d ? q.T - 1 - tt2 : tt2, row2 = q.base + t2;
                    R.v8 = *(const u32x4*)(Z + (size_t)row2 * ZLD + 1024 + q.h * 64 + q.rq * RB + hf * 8);
                }
            };
            ld_chunk(0);
            for (int g = -1; g <= NCH; ++g) {
                if (g + 1 <= NCH - 1) {
                    float* buf = lds + ((g + 1) & 1) * SCAN_IN_F;
                    float* L = buf + s * STEP_F + cg8;
                    st4(L, R.r8[0], R.r8[1]); st4(L + 4, R.r8[2], R.r8[3]);
                    *(f32x4*)(L + 64) = R.w0; *(f32x4*)(L + 68) = R.w1;
                    st4(L + 128, R.k8[0], R.k8[1]); st4(L + 132, R.k8[2], R.k8[3]);
                    st4(L + 192, R.kk8[0], R.kk8[1]); st4(L + 196, R.kk8[2], R.kk8[3]);
                    st4(L + 256, R.b8[0], R.b8[1]); st4(L + 260, R.b8[2], R.b8[3]);
                    if (lt < NV) {
                        const int s2 = lt / (RB / 8), hf = lt % (RB / 8);
                        float* Lv = buf + s2 * STEP_F + 320 + hf * 8;
                        st4(Lv, R.v8[0], R.v8[1]); st4(Lv + 4, R.v8[2], R.v8[3]);
                    }
                }
                if (g + 2 <= NCH - 1) ld_chunk(g + 2);
                if (g >= 1) {
                    const ChunkDesc q = chunk_desc<LAT>(slot, g - 1);
                    const float* yb = lds + SCAN_Y_OFF + ((g - 1) & 1) * (TC * RB);
#pragma unroll
                    for (int i = lt; i < TC * RB / 2; i += 256) {
                        const int sy = i / (RB / 2), r2 = (i % (RB / 2)) * 2;
                        const int tt = q.c * TC + sy, t = q.d ? q.T - 1 - tt : tt, row = q.base + t;
                        const f32x2 yv = *(const f32x2*)(yb + sy * RB + r2);
                        *(unsigned*)(Y + ((size_t)q.d * NTOK + row) * DR + q.h * 64 + q.rq * RB + r2) = pk_bf16(yv[0], yv[1]);
                    }
                }
                __syncthreads();
            }
        } else if (wave < NSW) {
            const int rl = lane >> 4, qq = lane & 15;
            f32x2 Sa[RPL], Sb[RPL];
#pragma unroll
            for (int j = 0; j < RPL; ++j) { Sa[j] = (f32x2){0.f, 0.f}; Sb[j] = (f32x2){0.f, 0.f}; }
            __syncthreads();
            for (int g = 0; g <= NCH - 1; ++g) {
                const ChunkDesc q = chunk_desc<LAT>(slot, g);
                const float* buf = lds + (g & 1) * SCAN_IN_F;
                const int rloc = wave * RPL * 4 + rl;
                float* yb = lds + SCAN_Y_OFF + (g & 1) * (TC * RB) + rloc;
                if (q.first) {
#pragma unroll
                    for (int j = 0; j < RPL; ++j) {
                        if (LAT) {
                            const int irow = q.rq * RB + rloc + 4 * j;
                            const f32x4 s = *(const f32x4*)(ST0 + ((size_t)((q.b * 2 + q.d) * 8 + q.h) * 64 + irow) * 64 + qq * 4);
                            Sa[j] = (f32x2){s[0], s[1]}; Sb[j] = (f32x2){s[2], s[3]};
                        } else { Sa[j] = (f32x2){0.f, 0.f}; Sb[j] = (f32x2){0.f, 0.f}; }
                    }
                }
                const float* Lq = buf + qq * 4;
                const float* Lv = buf + 320 + rloc;
                f32x4 r4 = *(const f32x4*)(Lq), w4 = *(const f32x4*)(Lq + 64), k4 = *(const f32x4*)(Lq + 128), n4 = *(const f32x4*)(Lq + 192), b4 = *(const f32x4*)(Lq + 256);
                f32x4 r4n = *(const f32x4*)(Lq + STEP_F), w4n = *(const f32x4*)(Lq + STEP_F + 64), k4n = *(const f32x4*)(Lq + STEP_F + 128), n4n = *(const f32x4*)(Lq + STEP_F + 192), b4n = *(const f32x4*)(Lq + STEP_F + 256);
                float v[RPL], vn[RPL], yp[RPL][4];
                const bool qb0 = (qq & 1) != 0, qb1 = (qq & 2) != 0;
                float* ybq = yb + (qq & 3) * RB;
#pragma unroll
                for (int j = 0; j < RPL; ++j) { v[j] = Lv[4 * j]; vn[j] = Lv[STEP_F + 4 * j]; }
#pragma unroll
                for (int s = 0; s < TC; ++s) {
                    const int s2 = (s + 2 < TC) ? s + 2 : TC - 1;
                    const float* Ln = Lq + s2 * STEP_F;
                    const f32x4 r4m = *(const f32x4*)(Ln), w4m = *(const f32x4*)(Ln + 64), k4m = *(const f32x4*)(Ln + 128), n4m = *(const f32x4*)(Ln + 192), b4m = *(const f32x4*)(Ln + 256);
                    float vm[RPL];
#pragma unroll
                    for (int j = 0; j < RPL; ++j) vm[j] = Lv[s2 * STEP_F + 4 * j];
#pragma unroll
                    for (int j = 0; j < RPL; ++j) {
                        f32x2 pp = Sa[j] * (f32x2){n4[0], n4[1]};
                        pp = Sb[j] * (f32x2){n4[2], n4[3]} + pp;
                        float pd = pp[0] + pp[1];
                        const f32x2 vv = {v[j], v[j]};
                        f32x2 Ta = (f32x2){k4[0], k4[1]} * vv, Tb = (f32x2){k4[2], k4[3]} * vv;
                        Ta = Sa[j] * (f32x2){w4[0], w4[1]} + Ta; Tb = Sb[j] * (f32x2){w4[2], w4[3]} + Tb;
                        pd = red16(pd);
                        const f32x2 np = {-pd, -pd};
                        Sa[j] = (f32x2){b4[0], b4[1]} * np + Ta; Sb[j] = (f32x2){b4[2], b4[3]} * np + Tb;
                        f32x2 yy = Sa[j] * (f32x2){r4[0], r4[1]};
                        yy = Sb[j] * (f32x2){r4[2], r4[3]} + yy;
                        yp[j][s & 3] = yy[0] + yy[1];
                        if ((s & 3) == 3) ybq[(s - 3) * RB + 4 * j] = red16x4(yp[j][0], yp[j][1], yp[j][2], yp[j][3], qb0, qb1);
                    }
                    r4 = r4n; w4 = w4n; k4 = k4n; n4 = n4n; b4 = b4n;
                    r4n = r4m; w4n = w4m; k4n = k4m; n4n = n4m; b4n = b4m;
#pragma unroll
                    for (int j = 0; j < RPL; ++j) { v[j] = vn[j]; vn[j] = vm[j]; }
                }
                if (!LAT && q.last) {
#pragma unroll
                    for (int j = 0; j < RPL; ++j) {
                        const int irow = q.rq * RB + rloc + 4 * j;
                        *(f32x4*)(OST + ((size_t)((q.b * 2 + q.d) * 8 + q.h) * 64 + irow) * 64 + qq * 4) = (f32x4){Sa[j][0], Sa[j][1], Sb[j][0], Sb[j][1]};
                    }
                }
                __syncthreads();
            }
            __syncthreads();
        } else {
            for (int g = -1; g <= NCH; ++g) __syncthreads();
        }
    }
}
__device__ void phase_scan(char* shm) {
    const int tid = tid_l();
    for (int slot = blockIdx.x; slot < 256; slot += gridDim.x) {
        if (slot < 128) scan_pass<true>(shm, tid, slot);
        else scan_pass<false>(shm, tid, slot - 128);
        __syncthreads();
    }
}

__device__ void phase_post() {
    KParams* kp = kargs();
    const int tid = tid_l(), lane = tid & 63, wave = tid >> 6;
    const bf16_t* Z = (const bf16_t*)(kp->ws + OFF_R1);
    const bf16_t* Y = (const bf16_t*)(kp->ws + OFF_H);
    const float* BONUS = (const float*)(kp->ws + OFF_BONUS);
    bf16_t* YA = (bf16_t*)(kp->ws + OFF_R2 + R2_YA);
    bf16_t* YB = (bf16_t*)(kp->ws + OFF_R2 + R2_YB);
    const int c = lane * 8, head = lane >> 3;
    for (int row = blockIdx.x * 8 + wave; row < NTOK; row += gridDim.x * 8) {
        const u32x4 y0 = *(const u32x4*)(Y + (size_t)row * DR + c), y1 = *(const u32x4*)(Y + ((size_t)NTOK + row) * DR + c);
        float y[8];
#pragma unroll
        for (int i = 0; i < 4; ++i) { y[2 * i] = bflo(y0[i]) + bflo(y1[i]); y[2 * i + 1] = bfhi(y0[i]) + bfhi(y1[i]); }
        float s = 0.f;
#pragma unroll
        for (int i = 0; i < 8; ++i) s += y[i];
        s += __shfl_xor(s, 1); s += __shfl_xor(s, 2); s += __shfl_xor(s, 4);
        const float mean = s * (1.0f / 64.0f);
        float vs = 0.f;
#pragma unroll
        for (int i = 0; i < 8; ++i) { y[i] -= mean; vs += y[i] * y[i]; }
        vs += __shfl_xor(vs, 1); vs += __shfl_xor(vs, 2); vs += __shfl_xor(vs, 4);
        const float rs = rsqrtf(vs * (1.0f / 64.0f) + 64e-5f);
        const float bon = BONUS[(size_t)row * 8 + head] + BONUS[((size_t)NTOK + row) * 8 + head];
        const u32x4 vz = *(const u32x4*)(Z + (size_t)row * ZLD + 1024 + c), gz = *(const u32x4*)(Z + (size_t)row * ZLD + 1536 + c);
        const f32x4 gn0 = *(const f32x4*)(kp->in[23] + c), gn1 = *(const f32x4*)(kp->in[23] + c + 4);
        const f32x4 gb0 = *(const f32x4*)(kp->in[24] + c), gb1 = *(const f32x4*)(kp->in[24] + c + 4);
        float o[8];
#pragma unroll
        for (int i = 0; i < 8; ++i) {
            const float vv = (i & 1) ? bfhi(vz[i >> 1]) : bflo(vz[i >> 1]);
            const float gg = (i & 1) ? bfhi(gz[i >> 1]) : bflo(gz[i >> 1]);
            const float gain = i < 4 ? gn0[i & 3] : gn1[i & 3], bias = i < 4 ? gb0[i & 3] : gb1[i & 3];
            o[i] = (y[i] * rs * gain + bias + bon * vv) * sigm(gg);
        }
        u32x4 ov;
#pragma unroll
        for (int i = 0; i < 4; ++i) ov[i] = pk_bf16(o[2 * i], o[2 * i + 1]);
        *(u32x4*)(YA + (size_t)row * DR + c) = ov;
        const bool lat = row >= NCTX;
        const int pos = lat ? ((row - NCTX) & 63) : (row & 255);
        const int last = lat ? 63 : 255;
        const bool vl = pos > 0, vr = pos < last;
        const int rl = vl ? row - 1 : row, rr = vr ? row + 1 : row;
        const u32x4 ccm = *(const u32x4*)(Z + (size_t)row * ZLD + 2560 + c), xcm = *(const u32x4*)(Z + (size_t)row * ZLD + 3072 + c);
        const u32x4 ccl = *(const u32x4*)(Z + (size_t)rl * ZLD + 2560 + c), xcl = *(const u32x4*)(Z + (size_t)rl * ZLD + 3072 + c);
        const u32x4 ccr = *(const u32x4*)(Z + (size_t)rr * ZLD + 2560 + c), xcr = *(const u32x4*)(Z + (size_t)rr * ZLD + 3072 + c);
        const u32x4 cbz = *(const u32x4*)(Z + (size_t)row * ZLD + 2048 + c);
        const float fl = vl ? 1.f : 0.f, frr = vr ? 1.f : 0.f;
#pragma unroll
        for (int i = 0; i < 8; ++i) {
            const int w = i >> 1; const bool hi = i & 1;
            const float um = (hi ? bfhi(ccm[w]) : bflo(ccm[w])) * (hi ? bfhi(xcm[w]) : bflo(xcm[w]));
            const float ul = (hi ? bfhi(ccl[w]) : bflo(ccl[w])) * (hi ? bfhi(xcl[w]) : bflo(xcl[w])) * fl;
            const float ur = (hi ? bfhi(ccr[w]) : bflo(ccr[w])) * (hi ? bfhi(xcr[w]) : bflo(xcr[w])) * frr;
            const float cb = hi ? bfhi(cbz[w]) : bflo(cbz[w]);
            const float cv = ul * kp->in[25][c + i] + um * kp->in[25][512 + c + i] + ur * kp->in[25][1024 + c + i] + kp->in[26][c + i];
            o[i] = cb * cv;
        }
#pragma unroll
        for (int i = 0; i < 4; ++i) ov[i] = pk_bf16(o[2 * i], o[2 * i + 1]);
        *(u32x4*)(YB + (size_t)row * DR + c) = ov;
    }
}

#define XB_TMO      128
#define XB_XCNT(j)  (256  + 64 * (j))
#define XB_XSUB(j)  (1280 + 64 * (j))
#define XB_XGEN(j)  (2304 + 64 * (j))
#define XB_TOP      3328
#define XB_TOPGEN   3392
#define XCD_BAR_WORDS 3456
#define XB_SPIN_CAP (1u << 18)
#define XLAS __attribute__((address_space(3)))
__device__ __forceinline__ unsigned xb_ld(unsigned* p)              { return __hip_atomic_load(p, __ATOMIC_RELAXED, __HIP_MEMORY_SCOPE_AGENT); }
__device__ __forceinline__ unsigned xb_add(unsigned* p, unsigned v) { return __hip_atomic_fetch_add(p, v, __ATOMIC_RELAXED, __HIP_MEMORY_SCOPE_AGENT); }
__device__ __forceinline__ unsigned xb_xcc_id() { return (unsigned)__builtin_amdgcn_s_getreg((3 << 11) | 20) & 0xFu; }
#define XB_SPIN(cond, bar) do { unsigned _sp = 0; while (cond) { __builtin_amdgcn_s_sleep(1); \
    if ((++_sp & 255u) == 0u) { if (xb_ld(&(bar)[XB_TMO])) break; if (_sp > XB_SPIN_CAP) { atomicAdd(&(bar)[XB_TMO], 1u); break; } } } } while (0)
struct XcdBarrier { unsigned* bar; unsigned x; volatile XLAS unsigned* st; };
__device__ __forceinline__ XcdBarrier xcd_barrier_post(unsigned* bar, volatile XLAS unsigned* st) {
    XcdBarrier b; b.bar = bar; b.x = xb_xcc_id(); b.st = st;
    if (threadIdx.x == 0) (void)xb_add(&bar[XB_XCNT(b.x)], 1u);
    return b;
}
__device__ __forceinline__ void xcd_barrier_complete(unsigned* bar, unsigned x, unsigned& nloc, unsigned& nx) {
    const unsigned G = gridDim.x * gridDim.y * gridDim.z;
    unsigned sum, cnt, mine, sp = 0u;
    for (;;) {
        sum = 0u; cnt = 0u; mine = 0u;
#pragma unroll
        for (unsigned j = 0; j < 16; ++j) { const unsigned c = xb_ld(&bar[XB_XCNT(j)]); sum += c; cnt += (c > 0u) ? 1u : 0u; mine = (j == x) ? c : mine; }
        if (sum == G) break;
        __builtin_amdgcn_s_sleep(1);
        if ((++sp & 255u) == 0u) { if (xb_ld(&bar[XB_TMO])) break; if (sp > XB_SPIN_CAP) { atomicAdd(&bar[XB_TMO], 1u); break; } }
    }
    nloc = mine > 0u ? mine : 1u; nx = cnt > 0u ? cnt : 1u;
}
__device__ __forceinline__ void xcd_barrier(const XcdBarrier& b) {
    asm volatile("s_waitcnt vmcnt(0)" ::: "memory");
    __syncthreads();
    if (threadIdx.x == 0) {
        unsigned* bar = b.bar;
        __builtin_amdgcn_s_waitcnt(0);
        unsigned nloc = b.st[0], nx = b.st[1];
        if (nloc == 0u) { xcd_barrier_complete(bar, b.x, nloc, nx); b.st[0] = nloc; b.st[1] = nx; }
        const unsigned old = xb_add(&bar[XB_XSUB(b.x)], 1u);
        const unsigned gen = old / nloc;
        if (old + 1u == (gen + 1u) * nloc) {
            __builtin_amdgcn_fence(__ATOMIC_RELEASE, "agent");
            asm volatile("s_waitcnt vmcnt(0)" ::: "memory");
            const unsigned og = xb_add(&bar[XB_TOP], 1u);
            const unsigned tg = og / nx;
            if (og + 1u == (tg + 1u) * nx) xb_add(&bar[XB_TOPGEN], 1u);
            else XB_SPIN(xb_ld(&bar[XB_TOPGEN]) == tg, bar);
            __builtin_amdgcn_fence(__ATOMIC_ACQUIRE, "agent");
            xb_add(&bar[XB_XGEN(b.x)], 1u);
            asm volatile("s_waitcnt vmcnt(0)" ::: "memory");
        } else {
            XB_SPIN(xb_ld(&bar[XB_XGEN(b.x)]) == gen, bar);
            __builtin_amdgcn_fence(__ATOMIC_ACQUIRE, "agent");
            asm volatile("s_waitcnt vmcnt(0)" ::: "memory");
        }
    }
    __syncthreads();
}

struct RowJob { const float* xc; const float* xl; const bf16_t* P; float* xdst; bf16_t* hdst; int gA, mGate, gB, mShift, mScale; float sA; };

__global__ void __launch_bounds__(NTHREADS) fwd_megakernel(Params p) {
    extern __shared__ __attribute__((aligned(16))) char shm[];
    volatile XLAS unsigned* st = (volatile XLAS unsigned*)((XLAS unsigned char*)shm + LDS_STAGE);
    if (threadIdx.x < 4) st[threadIdx.x] = 0u;
    __syncthreads();
    const XcdBarrier xb = xcd_barrier_post((unsigned*)(kargs()->ws + OFF_BAR), st);
    const int ph_lo = kargs()->phase_lo, ph_hi = kargs()->phase_hi;
    for (int ph = ph_lo; ph < ph_hi; ++ph) {
        KParams* kp0 = kargs();
        char* ws = kp0->ws;
        bf16_t* H = (bf16_t*)(ws + OFF_H);
        bf16_t* R1 = (bf16_t*)(ws + OFF_R1);
        float* R2f = (float*)(ws + OFF_R2);
        float* out = kp0->out;
        const float* xlat_out = out + (size_t)NCTX * DM;
        int kind = 0;
        int cv_set = -1, cv_first = 0;
        RowJob R{}; GemmJob J{};
        switch (ph) {
        case 1: kind = 1; R = RowJob{kargs()->in[0], kargs()->in[1], nullptr, nullptr, H, 0, 0, 0, 0, 1, 0.f}; break;
        case 4: kind = 1; R = RowJob{kargs()->in[0], kargs()->in[1], (const bf16_t*)R2f, out, H, 1, 2, 2, 3, 4, 0.5f}; break;
        case 11: kind = 1; R = RowJob{out, xlat_out, (const bf16_t*)R1, out, H, 3, 5, 4, 6, 7, 1.0f}; break;
        case 14: kind = 1; R = RowJob{out, xlat_out, (const bf16_t*)R2f, out, nullptr, 5, 8, 0, 0, 0, 0.5f}; break;
        case 2: case 12: kind = 2;
            J.A0 = J.A1 = H; J.Bt0 = J.Bt1 = (const bf16_t*)(ws + (ph == 2 ? OFF_W13A : OFF_W13B)); J.lda = DM; J.ldb = DM; J.nN = 22; J.nsplit = 1; J.nt = DM / BK; J.kstride = 0; J.mode = 0; J.o1 = R1; break;
        case 3: case 13: kind = 2;
            J.A0 = J.A1 = R1; J.Bt0 = J.Bt1 = (const bf16_t*)(ws + (ph == 3 ? OFF_W2A : OFF_W2B)); J.lda = DFF; J.ldb = DFF; J.nN = 4; J.nsplit = 2; J.nt = 22; J.kstride = 22 * BK; J.mode = 1; J.o1 = R2f; break;
        case 5: kind = 2;
            J.A0 = J.A1 = H; J.Bt0 = J.Bt1 = (const bf16_t*)(ws + OFF_WIN); J.lda = DM; J.ldb = DM; J.nN = 24; J.nsplit = 1; J.nt = DM / BK; J.kstride = 0; J.mode = 2; J.o1 = R1; break;
        case 9: kind = 2;
            J.A0 = (const bf16_t*)(ws + OFF_R2 + R2_YA); J.A1 = (const bf16_t*)(ws + OFF_R2 + R2_YB); J.Bt0 = (const bf16_t*)(ws + OFF_WA); J.Bt1 = (const bf16_t*)(ws + OFF_WB);
            J.lda = DR; J.ldb = DR; J.nN = 4; J.nsplit = 2; J.nt = DR / BK; J.kstride = 0; J.mode = 3; J.o1 = ws + OFF_R2 + R2_GA; J.o2 = ws + OFF_R2 + R2_GB; J.Z = R1; break;
        case 10: kind = 2;
            J.A0 = (const bf16_t*)(ws + OFF_R2 + R2_GA); J.A1 = (const bf16_t*)(ws + OFF_R2 + R2_GB); J.Bt0 = J.Bt1 = (const bf16_t*)(ws + OFF_WO); J.lda = DM; J.ldb = DM; J.nN = 4; J.nsplit = 2; J.nt = DM / BK; J.kstride = 0; J.mode = 1; J.o1 = R1; break;
        default: break;
        }
        for (int rep = 0; rep <= ((REPEAT_MASK >> ph) & 1); ++rep) {
        if (rep) xcd_barrier(xb);
        if (kind == 1) phase_rowop(R.xc, R.xl, R.P, R.gA, R.mGate, R.sA, R.xdst, R.gB, R.mShift, R.mScale, R.hdst);
        else if (kind == 2) phase_gemm(shm, J);
        else if (ph == 0) { phase_convert(shm); cv_set = 0; cv_first = 0; }
        else if (ph == 6) phase_prep(shm);
        else if (ph == 7) { phase_scan(shm); cv_set = 1; cv_first = ((int)gridDim.x == 256) ? 128 : 0; }
        else if (ph == 8) phase_post();
        }
        if (cv_set >= 0 && (int)blockIdx.x >= cv_first)
            convert_tiles(shm, cv_set, ((int)blockIdx.x - cv_first) * 8 + (int)(threadIdx.x >> 6), ((int)gridDim.x - cv_first) * 8);
        if (ph + 1 < ph_hi) xcd_barrier(xb);
    }
}

extern "C" void kernel_launch(void* const* d_in, const int* in_sizes, int n_in, void* d_out, int out_size, void* d_ws, size_t ws_size, hipStream_t stream) {
    static int grid_blocks = 0;
    if (grid_blocks == 0) {
        if (ws_size < WS_END) { fprintf(stderr, "kernel_launch: workspace too small: %zu < %zu\n", ws_size, (size_t)WS_END); grid_blocks = -1; return; }
        int dev = 0, cus = 0, per_cu = 0;
        hipGetDevice(&dev);
        hipDeviceGetAttribute(&cus, hipDeviceAttributeMultiprocessorCount, dev);
        if (hipFuncSetAttribute((const void*)fwd_megakernel, hipFuncAttributeMaxDynamicSharedMemorySize, LDS_BYTES) != hipSuccess) { fprintf(stderr, "hipFuncSetAttribute failed\n"); grid_blocks = -1; return; }
        hipOccupancyMaxActiveBlocksPerMultiprocessor(&per_cu, (const void*)fwd_megakernel, NTHREADS, LDS_BYTES);
        if (per_cu < 1) { fprintf(stderr, "occupancy query says %d\n", per_cu); per_cu = 1; }
        if (per_cu > 1) per_cu = 1;
        grid_blocks = cus * per_cu;
    }
    if (grid_blocks < 0) return;
    Params p{};
    for (int i = 0; i < 30; ++i) p.in[i] = (const float*)d_in[i];
    p.out = (float*)d_out; p.ws = (char*)d_ws; p.phase_lo = 0; p.phase_hi = 15;
    if (hipMemsetAsync((char*)d_ws + OFF_BAR, 0, 16384, stream) != hipSuccess) { fprintf(stderr, "memset of barrier words failed\n"); return; }
    void* args[] = {&p};
    hipError_t e = hipLaunchCooperativeKernel((const void*)fwd_megakernel, dim3(grid_blocks), dim3(NTHREADS), args, LDS_BYTES, stream);
    if (e != hipSuccess) fprintf(stderr, "cooperative launch failed: %s (grid %d)\n", hipGetErrorString(e), grid_blocks);
}
```

```cpp
#include <hip/hip_runtime.h>
#include <hip/hip_cooperative_groups.h>
#include <cstdio>
namespace cg = cooperative_groups;

typedef unsigned short bf16_t;
typedef short bf16x8 __attribute__((ext_vector_type(8)));
typedef float f32x4 __attribute__((ext_vector_type(4)));
typedef unsigned u32x4 __attribute__((ext_vector_type(4)));
typedef unsigned u32x2 __attribute__((ext_vector_type(2)));

constexpr int DM = 1024, NTOK = 8192, NCTX = 4096, DFF = 2816, NIN = 6144, ZLD = 6144, DR = 512;
constexpr int NTHREADS = 512;
#define REPEAT_MASK 0
constexpr int LDS_STAGE = 131072;
constexpr int LDS_BYTES = LDS_STAGE + 16;

constexpr size_t SZ_W13 = (size_t)5632 * 1024 * 2, SZ_W2 = (size_t)1024 * 2816 * 2;
constexpr size_t OFF_W13A = 0;
constexpr size_t OFF_W2A = OFF_W13A + SZ_W13;
constexpr size_t OFF_W13B = OFF_W2A + SZ_W2;
constexpr size_t OFF_W2B = OFF_W13B + SZ_W13;
constexpr size_t OFF_WIN = OFF_W2B + SZ_W2;
constexpr size_t OFF_WA = OFF_WIN + (size_t)6144 * 1024 * 2;
constexpr size_t OFF_WB = OFF_WA + (size_t)1024 * 512 * 2;
constexpr size_t OFF_WO = OFF_WB + (size_t)1024 * 512 * 2;
constexpr size_t OFF_L2 = OFF_WO + (size_t)1024 * 1024 * 2;
constexpr size_t OFF_MOD = OFF_L2 + (size_t)4 * 512 * 64 * 2;
constexpr size_t OFF_BONUS = OFF_MOD + (size_t)2 * 3 * 9216 * 4;
constexpr size_t OFF_H = OFF_BONUS + (size_t)2 * 8192 * 8 * 4;
constexpr size_t OFF_R1 = OFF_H + (size_t)8192 * 1024 * 2;
constexpr size_t OFF_R2 = OFF_R1 + (size_t)8192 * 6144 * 2;
constexpr size_t OFF_BAR = OFF_R2 + (size_t)72 * 1024 * 1024;
constexpr size_t OFF_YB2 = OFF_BAR + 16384;
constexpr size_t WS_END = OFF_YB2 + (size_t)8192 * 512 * 2;
constexpr size_t R2_KK = 0;
constexpr size_t R2_WD = R2_KK + (size_t)8192 * 512 * 2;
constexpr size_t R2_KD = R2_WD + (size_t)2 * 8192 * 512 * 4;
constexpr size_t R2_BB = R2_KD + (size_t)2 * 8192 * 512 * 2;
constexpr size_t R2_YA = 0;
constexpr size_t R2_YB = R2_YA + (size_t)8192 * 512 * 2;
constexpr size_t R2_GA = R2_YB + (size_t)8192 * 512 * 2;
constexpr size_t R2_GB = R2_GA + (size_t)8192 * 1024 * 2;

struct Params {
    const float* in[30];
    float* out;
    char* ws;
    int phase_lo, phase_hi;
};


typedef const __attribute__((address_space(4))) Params KParams;
__device__ __forceinline__ KParams* kargs() {
    KParams* k = (KParams*)__builtin_amdgcn_kernarg_segment_ptr();
    asm volatile("" : "+s"(k));
    return k;
}

__device__ __forceinline__ int tid_l() { int t = threadIdx.x; asm volatile("" : "+v"(t)); return t; }
__device__ __forceinline__ float bf2f(unsigned short u) { return __uint_as_float(((unsigned)u) << 16); }
__device__ __forceinline__ float bflo(unsigned u) { return __uint_as_float(u << 16); }
__device__ __forceinline__ float bfhi(unsigned u) { return __uint_as_float(u & 0xffff0000u); }
__device__ __forceinline__ unsigned pk_bf16(float lo, float hi) { unsigned r; asm("v_cvt_pk_bf16_f32 %0, %1, %2" : "=v"(r) : "v"(lo), "v"(hi)); return r; }
__device__ __forceinline__ void st_wt16(void* p, u32x4 v) { asm volatile("global_store_dwordx4 %0, %1, off sc1\n\ts_nop 1" :: "v"(p), "v"(v) : "memory"); }
__device__ __forceinline__ void st_wt16f_nc(void* p, f32x4 v) { asm volatile("global_store_dwordx4 %0, %1, off sc1\n\ts_nop 1" :: "v"(p), "v"(v)); }
__device__ __forceinline__ void st_wt8_nc(void* p, u32x2 v) { asm volatile("global_store_dwordx2 %0, %1, off sc1\n\ts_nop 1" :: "v"(p), "v"(v)); }
__device__ __forceinline__ float sigm(float x) { return __builtin_amdgcn_rcpf(1.0f + __expf(-x)); }
__device__ __forceinline__ float wave_sum(float v) {
#pragma unroll
    for (int o = 32; o > 0; o >>= 1) v += __shfl_xor(v, o);
    return v;
}
template <int CTRL> __device__ __forceinline__ float dppf(float x) {
    return __int_as_float(__builtin_amdgcn_update_dpp(0, __float_as_int(x), CTRL, 0xf, 0xf, true));
}
__device__ __forceinline__ float red16(float x) {
    x += dppf<0xB1>(x);
    x += dppf<0x4E>(x);
    x += dppf<0x141>(x);
    x += dppf<0x140>(x);
    return x;
}

__device__ __forceinline__ void conv_tile_w(char* wl, const float* __restrict__ src, int src_ld, int k0, int c0,
                                            bf16_t* __restrict__ dst, int dst_ld, int n0, const float* __restrict__ mu, int mode, const int lane) {
    float v[64];
    const float* s = src + (size_t)k0 * src_ld + c0 + lane;
#pragma unroll
    for (int i = 0; i < 64; ++i) v[i] = __builtin_nontemporal_load(s + (size_t)i * src_ld);
    if (mode) {
#pragma unroll
        for (int i = 0; i < 64; ++i) { const float m = mu[k0 + i]; v[i] *= (mode == 1) ? m : (1.0f - m); }
    }
#pragma unroll
    for (int q = 0; q < 8; ++q) {
        u32x4 o;
#pragma unroll
        for (int i = 0; i < 4; ++i) o[i] = pk_bf16(v[8 * q + 2 * i], v[8 * q + 2 * i + 1]);
        *(u32x4*)(wl + lane * 144 + q * 16) = o;
    }
    asm volatile("s_waitcnt lgkmcnt(0)" ::: "memory");
#pragma unroll
    for (int i = 0; i < 8; ++i) {
        const int id = i * 64 + lane, r = id >> 3, ch = id & 7;
        const u32x4 o = *(const u32x4*)(wl + r * 144 + ch * 16);
        st_wt16(dst + (size_t)(n0 + r) * dst_ld + k0 + ch * 8, o);
    }
    asm volatile("s_waitcnt lgkmcnt(0)" ::: "memory");
}

__device__ void phase_convert(char* shm) {
    KParams* kp = kargs();
    float* lds = (float*)shm;
    const int tid = tid_l(), lane = tid & 63, wave = __builtin_amdgcn_readfirstlane(tid >> 6);
    float* sc = lds;
    float* red = lds + 3072;
    for (int i = tid; i < 3072; i += NTHREADS) {
        const int mi = i >> 10, k = i & 1023;
        const float cv = (mi == 0) ? kp->in[4][k] : kp->in[2][(mi - 1) * 1024 + k];
        sc[i] = cv * sigm(cv);
    }
    __syncthreads();
    float* modp = (float*)(kp->ws + OFF_MOD);
    for (int task = blockIdx.x; task < 288; task += gridDim.x) {
        const int kh = task / 144, cgp = task % 144, col = cgp * 64 + lane;
        const int kb = kh * 512 + wave * 64;
        const float* wm = kp->in[5] + (size_t)kb * 9216 + col;
        float a0 = 0.f, a1 = 0.f, a2 = 0.f;
#pragma unroll 16
        for (int i = 0; i < 64; ++i) {
            const float w = __builtin_nontemporal_load(wm + (size_t)i * 9216);
            a0 += sc[kb + i] * w; a1 += sc[1024 + kb + i] * w; a2 += sc[2048 + kb + i] * w;
        }
        red[(wave * 3 + 0) * 64 + lane] = a0; red[(wave * 3 + 1) * 64 + lane] = a1; red[(wave * 3 + 2) * 64 + lane] = a2;
        __syncthreads();
        if (tid < 192) {
            const int m = tid >> 6, cc = tid & 63;
            float s = kh == 0 ? kp->in[6][cgp * 64 + cc] : 0.f;
#pragma unroll
            for (int g = 0; g < 8; ++g) s += red[(g * 3 + m) * 64 + cc];
            modp[(kh * 3 + m) * 9216 + cgp * 64 + cc] = s;
        }
        __syncthreads();
    }
}

constexpr int T_W13 = 88 * 16, T_W2 = 16 * 44, T_WIN = 88 * 16, T_LORA = 8 * 16, T_WAB = 16 * 8, T_WO = 16 * 16, T_L2 = 32;
constexpr int CV_TOTAL = 2 * T_W13 + 2 * T_W2 + T_WIN + T_LORA + 2 * T_WAB + T_WO + T_L2;
constexpr int CV_SET1 = T_W13 + T_W2 + 2 * T_WAB + T_WO, CV_SET0 = CV_TOTAL - CV_SET1;
__device__ void convert_tiles(char* shm, int set, int gw, int nw) {
    KParams* kp = kargs();
    const int tid = tid_l(), lane = tid & 63, wave = __builtin_amdgcn_readfirstlane(tid >> 6);
    char* wl = shm + 20480 + wave * (64 * 144);
    const int cnt = set ? CV_SET1 : CV_SET0;
    for (int n = gw; n < cnt; n += nw) {
        int id;
        if (set == 0) id = n < T_W13 ? n : (n < T_W13 + T_W2 ? n + T_W13 : (n < T_W13 + T_W2 + T_WIN + T_LORA ? n + T_W13 + T_W2 : n + T_W13 + T_W2 + 2 * T_WAB + T_WO));
        else id = n < T_W13 ? n + T_W13 : (n < T_W13 + T_W2 ? n + T_W13 + T_W2 : n + T_W13 + T_W2 + T_WIN + T_LORA);
        if (id < 2 * T_W13) {
            const int which = id / T_W13; id -= which * T_W13;
            const int nt = id >> 4, kt = id & 15, j = nt >> 2, w = nt & 3;
            const int c0 = (w < 2) ? (128 * j + 64 * w) : (2816 + 128 * j + 64 * (w - 2));
            conv_tile_w(wl, kp->in[which ? 10 : 8], 5632, kt * 64, c0, (bf16_t*)(kp->ws + (which ? OFF_W13B : OFF_W13A)), 1024, nt * 64, nullptr, 0, lane);
            continue;
        }
        id -= 2 * T_W13;
        if (id < 2 * T_W2) {
            const int which = id / T_W2; id -= which * T_W2;
            const int nt = id / 44, kt = id % 44;
            conv_tile_w(wl, kp->in[which ? 11 : 9], 1024, kt * 64, nt * 64, (bf16_t*)(kp->ws + (which ? OFF_W2B : OFF_W2A)), 2816, nt * 64, nullptr, 0, lane);
            continue;
        }
        id -= 2 * T_W2;
        if (id < T_WIN) {
            const int nt = id >> 4, kt = id & 15;
            conv_tile_w(wl, kp->in[12], 5632, kt * 64, nt * 64, (bf16_t*)(kp->ws + OFF_WIN), 1024, nt * 64, nullptr, 0, lane);
            continue;
        }
        id -= T_WIN;
        if (id < T_LORA) {
            const int nt = id >> 4, kt = id & 15;
            const int pq = nt & 1, l = (nt >> 1) & 1, d = nt >> 2;
            const float* src = kp->in[l ? 18 : 15] + (size_t)d * 1024 * 64;
            conv_tile_w(wl, src, 64, kt * 64, 0, (bf16_t*)(kp->ws + OFF_WIN), 1024, 5632 + nt * 64, kp->in[13] + (d * 2 + l) * 1024, pq ? 1 : 2, lane);
            continue;
        }
        id -= T_LORA;
        if (id < 2 * T_WAB) {
            const int which = id / T_WAB; id -= which * T_WAB;
            const int nt = id >> 3, kt = id & 7;
            conv_tile_w(wl, kp->in[which ? 28 : 27], 1024, kt * 64, nt * 64, (bf16_t*)(kp->ws + (which ? OFF_WB : OFF_WA)), 512, nt * 64, nullptr, 0, lane);
            continue;
        }
        id -= 2 * T_WAB;
        if (id < T_WO) {
            const int nt = id >> 4, kt = id & 15;
            conv_tile_w(wl, kp->in[29], 1024, kt * 64, nt * 64, (bf16_t*)(kp->ws + OFF_WO), 1024, nt * 64, nullptr, 0, lane);
            continue;
        }
        id -= T_WO;
        {
            const int dl = id >> 3, nt = id & 7, d = dl >> 1, l = dl & 1;
            const float* src = kp->in[l ? 19 : 16] + (size_t)d * 64 * 512;
            conv_tile_w(wl, src, 512, 0, nt * 64, (bf16_t*)(kp->ws + OFF_L2) + (size_t)dl * 512 * 64, 64, nt * 64, nullptr, 0, lane);
        }
    }
}

__device__ void phase_rowop(const float* __restrict__ xctx, const float* __restrict__ xlat, const bf16_t* __restrict__ P,
                            int gA, int mGate, float sA, float* __restrict__ xdst, int gB, int mShift, int mScale, bf16_t* __restrict__ hdst) {
    KParams* kp = kargs();
    const int tid = tid_l(), lane = tid & 63, wave = tid >> 6;
    const float* G = kp->in[7];
    const float* MOD = (const float*)(kp->ws + OFF_MOD);
    constexpr int RW = 4;
    for (int row0 = (blockIdx.x * 8 + wave) * RW; row0 < NTOK; row0 += gridDim.x * 8 * RW) {
        const int mi = row0 < NCTX ? 0 : 1 + ((row0 - NCTX) >> 11);
        const float* mod = MOD + mi * 9216;
        const float* xs = row0 < NCTX ? xctx + (size_t)row0 * DM : xlat + (size_t)(row0 - NCTX) * DM;
        f32x4 x[RW][4];
#pragma unroll
        for (int r = 0; r < RW; ++r)
#pragma unroll
            for (int i = 0; i < 4; ++i) x[r][i] = __builtin_nontemporal_load((const f32x4*)(xs + (size_t)r * DM + (i * 64 + lane) * 4));
        if (P) {
            u32x2 p0[RW][4], p1[RW][4];
#pragma unroll
            for (int r = 0; r < RW; ++r)
#pragma unroll
                for (int i = 0; i < 4; ++i) {
                    const size_t o = (size_t)(row0 + r) * DM + (i * 64 + lane) * 4;
                    p0[r][i] = __builtin_nontemporal_load((const u32x2*)(P + o)); p1[r][i] = __builtin_nontemporal_load((const u32x2*)(P + (size_t)NTOK * DM + o));
                }
            f32x4 gm[4];
#pragma unroll
            for (int i = 0; i < 4; ++i) {
                const int c = (i * 64 + lane) * 4;
                gm[i] = *(const f32x4*)(G + gA * DM + c) * (*(const f32x4*)(mod + mGate * DM + c) + *(const f32x4*)(mod + 27648 + mGate * DM + c));
            }
            float ss[RW];
#pragma unroll
            for (int r = 0; r < RW; ++r) {
                ss[r] = 0.f;
#pragma unroll
                for (int i = 0; i < 4; ++i) {
                    const f32x4 f = (f32x4){bflo(p0[r][i][0]) + bflo(p1[r][i][0]), bfhi(p0[r][i][0]) + bfhi(p1[r][i][0]), bflo(p0[r][i][1]) + bflo(p1[r][i][1]), bfhi(p0[r][i][1]) + bfhi(p1[r][i][1])};
                    ss[r] += f[0] * f[0] + f[1] * f[1] + f[2] * f[2] + f[3] * f[3];
                }
            }
#pragma unroll
            for (int o = 32; o > 0; o >>= 1) {
#pragma unroll
                for (int r = 0; r < RW; ++r) ss[r] += __shfl_xor(ss[r], o);
            }
#pragma unroll
            for (int r = 0; r < RW; ++r) {
                const float rstd = rsqrtf(ss[r] * (1.0f / DM) + 1e-6f) * sA;
#pragma unroll
                for (int i = 0; i < 4; ++i) {
                    const int c = (i * 64 + lane) * 4;
                    const f32x4 f = (f32x4){bflo(p0[r][i][0]) + bflo(p1[r][i][0]), bfhi(p0[r][i][0]) + bfhi(p1[r][i][0]), bflo(p0[r][i][1]) + bflo(p1[r][i][1]), bfhi(p0[r][i][1]) + bfhi(p1[r][i][1])};
                    x[r][i] += gm[i] * (f * rstd);
                    st_wt16f_nc(xdst + (size_t)(row0 + r) * DM + c, x[r][i]);
                }
            }
        }
        if (hdst) {
            f32x4 gs[4], sh[4];
#pragma unroll
            for (int i = 0; i < 4; ++i) {
                const int c = (i * 64 + lane) * 4;
                gs[i] = *(const f32x4*)(G + gB * DM + c) * (*(const f32x4*)(mod + mScale * DM + c) + *(const f32x4*)(mod + 27648 + mScale * DM + c) + 1.0f);
                sh[i] = *(const f32x4*)(mod + mShift * DM + c) + *(const f32x4*)(mod + 27648 + mShift * DM + c);
            }
            float ss[RW];
#pragma unroll
            for (int r = 0; r < RW; ++r) {
                ss[r] = 0.f;
#pragma unroll
                for (int i = 0; i < 4; ++i) ss[r] += x[r][i][0] * x[r][i][0] + x[r][i][1] * x[r][i][1] + x[r][i][2] * x[r][i][2] + x[r][i][3] * x[r][i][3];
            }
#pragma unroll
            for (int o = 32; o > 0; o >>= 1) {
#pragma unroll
                for (int r = 0; r < RW; ++r) ss[r] += __shfl_xor(ss[r], o);
            }
#pragma unroll
            for (int r = 0; r < RW; ++r) {
                const float rstd = rsqrtf(ss[r] * (1.0f / DM) + 1e-6f);
#pragma unroll
                for (int i = 0; i < 4; ++i) {
                    const int c = (i * 64 + lane) * 4;
                    const f32x4 h = (x[r][i] * rstd) * gs[i] + sh[i];
                    u32x2 o; o[0] = pk_bf16(h[0], h[1]); o[1] = pk_bf16(h[2], h[3]);
                    st_wt8_nc(hdst + (size_t)(row0 + r) * DM + c, o);
                }
            }
        }
    }
}

constexpr int BM = 256, BK = 64, HALF = 128, HT = HALF * BK;
__device__ __forceinline__ int lds_byte(int r, int c) {
    const int st = (r >> 4) * 2 + (c >> 5), rr = r & 15, cc = c & 31, ob = rr * 64 + cc * 2;
    return st * 1024 + (ob ^ (((ob >> 9) & 1) << 5));
}
__device__ __forceinline__ void stage_rc(int b, int& R, int& C) {
    const int st = b / 1024, sb = b % 1024, swz = sb ^ (((sb >> 9) & 1) << 5);
    R = (st >> 1) * 16 + swz / 64; C = (st & 1) * 32 + (swz % 64) / 2;
}
__device__ __forceinline__ void unit_map(int wgid, int nM, int nN, int& pm, int& pn) {
    const int NXCD = 8, WGM = 8, nwg = nM * nN;
    { const int q = nwg / NXCD, r = nwg % NXCD, xcd = wgid % NXCD, off = wgid / NXCD; wgid = (xcd < r ? xcd * (q + 1) : r * (q + 1) + (xcd - r) * q) + off; }
    const int nig = WGM * nN, gid = wgid / nig, fm = gid * WGM, gsz = min(nM - fm, WGM);
    pm = fm + ((wgid % nig) % gsz); pn = (wgid % nig) / gsz;
}

#define LAS __attribute__((address_space(3)))
constexpr int HTB = HALF * BK * 2;
__device__ __forceinline__ void gemm_tile(char* shmc, const bf16_t* __restrict__ A, int lda, const bf16_t* __restrict__ Bt, int ldb,
                                          int brow, int bcol, int nt, f32x4 (&acc)[2][2][4][2], const int tid) {
    LAS unsigned char* lds = (LAS unsigned char*)shmc;
    const int wid = __builtin_amdgcn_readfirstlane(tid >> 6), lane = tid & 63, wr = wid >> 2, wc = wid & 3, fr = lane & 15, fq = lane >> 4;
    unsigned voffA[2], voffB[2];
#pragma unroll
    for (int i = 0; i < 2; ++i) { int R, C; stage_rc(tid * 16 + i * 8192, R, C); voffA[i] = (unsigned)(R * lda + C) * 2u; voffB[i] = (unsigned)(R * ldb + C) * 2u; }
    const size_t kstep = (size_t)(BK * 2);
    const size_t hstepA = (size_t)HALF * lda * 2, hstepB = (size_t)HALF * ldb * 2;
    const unsigned ldsw = (unsigned)wid * 1024u;
    const int aoff = lds_byte(wr * 64 + fr, fq * 8), boff = lds_byte(wc * 32 + fr, fq * 8);
    const char* cA = (const char*)A + (size_t)brow * lda * 2;
    const char* cB = (const char*)Bt + (size_t)bcol * ldb * 2;
#define SA(b, h) (((b) * 2 + (h)) * HTB)
#define SB(b, h) ((4 + (b) * 2 + (h)) * HTB)
#define STAGE(bufoff, gbase, voff) do { _Pragma("unroll") for (int _i = 0; _i < 2; ++_i) \
    __builtin_amdgcn_global_load_lds((const unsigned*)((const char*)(gbase) + (voff)[_i]), (LAS unsigned*)(lds + (bufoff) + ldsw + _i * 8192), 16, 0, 0); } while (0)
#define LDA(dst, b, h) do { _Pragma("unroll") for (int m = 0; m < 4; ++m) _Pragma("unroll") for (int k = 0; k < 2; ++k) dst[m][k] = *(const LAS bf16x8*)(lds + SA(b, h) + aoff + m * 2048 + k * 1024); } while (0)
#define LDB(dst, b, h) do { _Pragma("unroll") for (int n = 0; n < 2; ++n) _Pragma("unroll") for (int k = 0; k < 2; ++k) dst[n][k] = *(const LAS bf16x8*)(lds + SB(b, h) + boff + n * 2048 + k * 1024); } while (0)
#define MMA(ai, bj, At_, Bt_) do { __builtin_amdgcn_s_setprio(1); _Pragma("unroll") for (int m = 0; m < 4; ++m) _Pragma("unroll") for (int n = 0; n < 2; ++n) _Pragma("unroll") for (int k = 0; k < 2; ++k) \
      acc[ai][bj][m][n] = __builtin_amdgcn_mfma_f32_16x16x32_bf16(Bt_[n][k], At_[m][k], acc[ai][bj][m][n], 0, 0, 0); \
    __builtin_amdgcn_s_setprio(0); } while (0)
#define WAIT_V(n) asm volatile("s_waitcnt vmcnt(" #n ")" ::: "memory")
#define WAIT_L(n) asm volatile("s_waitcnt lgkmcnt(" #n ")" ::: "memory")
#define BAR __builtin_amdgcn_s_barrier()
#define SCHED __builtin_amdgcn_sched_barrier(0)
#pragma unroll
    for (int a = 0; a < 2; ++a)
#pragma unroll
        for (int b = 0; b < 2; ++b)
#pragma unroll
            for (int m = 0; m < 4; ++m)
#pragma unroll
                for (int n = 0; n < 2; ++n) acc[a][b][m][n] = (f32x4){0.f, 0.f, 0.f, 0.f};
    bf16x8 At[4][2], B0[2][2], B1[2][2];
    STAGE(SB(0, 0), cB, voffB); STAGE(SA(0, 0), cA, voffA); STAGE(SB(0, 1), cB + hstepB, voffB); STAGE(SA(0, 1), cA + hstepA, voffA);
    if (wr == 1) BAR;
    WAIT_V(4); BAR;
    STAGE(SB(1, 0), cB + kstep, voffB); STAGE(SA(1, 0), cA + kstep, voffA); STAGE(SB(1, 1), cB + hstepB + kstep, voffB);
    WAIT_V(6); BAR;
    for (int t = 0; t < nt - 2; t += 2) {
        const char* a1 = cA + (size_t)(t + 1) * kstep;
        const char* a2 = cA + (size_t)(t + 2) * kstep; const char* b2 = cB + (size_t)(t + 2) * kstep;
        const char* a3 = a2 + kstep; const char* b3 = b2 + kstep;
        LDB(B0, 0, 0); SCHED; LDA(At, 0, 0); STAGE(SA(1, 1), a1 + hstepA, voffA);
        WAIT_L(8); BAR; WAIT_L(0); MMA(0, 0, At, B0); BAR; SCHED;
        LDB(B1, 0, 1); STAGE(SB(0, 0), b2, voffB);
        BAR; WAIT_L(0); MMA(0, 1, At, B1); BAR;
        LDA(At, 0, 1); STAGE(SA(0, 0), a2, voffA);
        BAR; WAIT_L(0); MMA(1, 0, At, B0); BAR; SCHED;
        STAGE(SB(0, 1), b2 + hstepB, voffB);
        WAIT_V(6); BAR; MMA(1, 1, At, B1); BAR;
        LDB(B0, 1, 0); SCHED; LDA(At, 1, 0); STAGE(SA(0, 1), a2 + hstepA, voffA);
        WAIT_L(8); BAR; WAIT_L(0); MMA(0, 0, At, B0); BAR; SCHED;
        LDB(B1, 1, 1); STAGE(SB(1, 0), b3, voffB);
        BAR; WAIT_L(0); MMA(0, 1, At, B1); BAR;
        LDA(At, 1, 1); STAGE(SA(1, 0), a3, voffA);
        BAR; WAIT_L(0); MMA(1, 0, At, B0); BAR; SCHED;
        STAGE(SB(1, 1), b3 + hstepB, voffB);
        WAIT_V(6); BAR; MMA(1, 1, At, B1); BAR;
    }
    { const char* a1 = cA + (size_t)(nt - 1) * kstep;
      LDB(B0, 0, 0); LDA(At, 0, 0); STAGE(SA(1, 1), a1 + hstepA, voffA);
      BAR; WAIT_L(0); MMA(0, 0, At, B0); BAR;
      LDB(B1, 0, 1); BAR; WAIT_L(0); MMA(0, 1, At, B1); BAR;
      LDA(At, 0, 1); WAIT_V(4); BAR; WAIT_L(0); MMA(1, 0, At, B0); MMA(1, 1, At, B1); BAR; }
    { LDB(B0, 1, 0); LDA(At, 1, 0); WAIT_V(2); BAR; WAIT_L(0); MMA(0, 0, At, B0); BAR;
      LDB(B1, 1, 1); WAIT_V(0); BAR; WAIT_L(0); MMA(0, 1, At, B1); BAR;
      LDA(At, 1, 1); BAR; WAIT_L(0); MMA(1, 0, At, B0); MMA(1, 1, At, B1); BAR; }
    if (wr == 0) BAR;
#undef SA
#undef SB
#undef STAGE
#undef LDA
#undef LDB
#undef MMA
}

struct GemmJob {
    const bf16_t* A0; const bf16_t* A1; const bf16_t* Bt0; const bf16_t* Bt1;
    int lda, ldb, nN, nsplit, nt, kstride, mode, pad;
    void* o1; void* o2; const bf16_t* Z;
};
__device__ void phase_gemm(char* shm, const GemmJob& J) {
    const int tid = tid_l();
    const int wid = __builtin_amdgcn_readfirstlane(tid >> 6), wr = wid >> 2, wc = wid & 3;
    const int nM = 32, nN = J.nN, nMN = nM * nN;
    const int mode = J.mode;
    for (int u = blockIdx.x; u < nMN * J.nsplit; u += gridDim.x) {
        const int ks = u / nMN;
        int pm, pn; unit_map(u - ks * nMN, nM, nN, pm, pn);
        {
            const int sub = ks;
            f32x4 acc[2][2][4][2];
            const size_t koff = (size_t)ks * J.kstride;
            gemm_tile(shm, (ks ? J.A1 : J.A0) + koff, J.lda, (ks ? J.Bt1 : J.Bt0) + koff, J.ldb, pm * BM, pn * BM, J.nt, acc, tid);
            int lane_e = tid & 63; asm volatile("" : "+v"(lane_e));
            const int fr = lane_e & 15, fq = lane_e >> 4;
            const int NBJ = (mode == 0) ? 1 : 2;
            const int W8 = NBJ * 16;
            const int pitch = NBJ * 256 + 32;
            bf16_t* obase; int old_, col0;
            if (mode == 0)      { obase = (bf16_t*)J.o1; old_ = DFF; col0 = pn * 128; }
            else if (mode == 1) { obase = (bf16_t*)J.o1 + (size_t)ks * NTOK * DM; old_ = DM; col0 = pn * BM; }
            else if (mode == 2) { obase = (bf16_t*)J.o1; old_ = ZLD; col0 = pn * BM; }
            else                { obase = (bf16_t*)(sub ? J.o2 : J.o1); old_ = DM; col0 = pn * BM; }
            const bf16_t* Zg = J.Z + (sub ? 4608 : 3584);
#pragma unroll
            for (int ai = 0; ai < 2; ++ai) {
#pragma unroll
                for (int m = 0; m < 4; ++m) {
                    const int rloc = wr * 64 + m * 16 + fr;
                    const int row = pm * BM + ai * HALF + rloc;
#pragma unroll
                    for (int n = 0; n < 2; ++n) {
                        if (mode == 0) {
                            const f32x4 g = acc[ai][0][m][n], up = acc[ai][1][m][n];
                            float o[4];
#pragma unroll
                            for (int j = 0; j < 4; ++j) o[j] = g[j] * sigm(g[j]) * up[j];
                            u32x2 v; v[0] = pk_bf16(o[0], o[1]); v[1] = pk_bf16(o[2], o[3]);
                            *(u32x2*)(shm + rloc * pitch + (wc * 32 + n * 16 + fq * 4) * 2) = v;
                        } else {
#pragma unroll
                            for (int bj = 0; bj < 2; ++bj) {
                                const int cl = bj * HALF + wc * 32 + n * 16 + fq * 4;
                                f32x4 a = acc[ai][bj][m][n];
                                if (mode == 3) {
                                    const u32x2 gz = *(const u32x2*)(Zg + (size_t)row * ZLD + col0 + cl);
                                    a[0] *= sigm(bflo(gz[0])); a[1] *= sigm(bfhi(gz[0])); a[2] *= sigm(bflo(gz[1])); a[3] *= sigm(bfhi(gz[1]));
                                }
                                u32x2 v; v[0] = pk_bf16(a[0], a[1]); v[1] = pk_bf16(a[2], a[3]);
                                *(u32x2*)(shm + rloc * pitch + cl * 2) = v;
                            }
                        }
                    }
                }
                __syncthreads();
                const int w8sh = (mode == 0) ? 4 : 5;
                for (int c = tid; c < 128 * W8; c += NTHREADS) {
                    const int r = c >> w8sh, cc = c & (W8 - 1);
                    const u32x4 v = *(const u32x4*)(shm + r * pitch + cc * 16);
                    st_wt16(obase + (size_t)(pm * BM + ai * HALF + r) * old_ + col0 + cc * 8, v);
                }
                __syncthreads();
            }
        }
    }
}

__device__ void phase_prep(char* shm) {
    KParams* kp = kargs();
    const int tid = tid_l(), lane = tid & 63, wave = tid >> 6, fr = lane & 15, fq = lane >> 4;
    float* wt = (float*)shm + wave * (16 * 68);
    const bf16_t* Z = (const bf16_t*)(kp->ws + OFF_R1);
    const bf16_t* L2T = (const bf16_t*)(kp->ws + OFF_L2);
    bf16_t* KK = (bf16_t*)(kp->ws + OFF_R2 + R2_KK);
    float* WD = (float*)(kp->ws + OFF_R2 + R2_WD);
    bf16_t* KD = (bf16_t*)(kp->ws + OFF_R2 + R2_KD);
    bf16_t* BB = (bf16_t*)(kp->ws + OFF_R2 + R2_BB);
    float* BONUS = (float*)(kp->ws + OFF_BONUS);
    for (int unit = blockIdx.x * 8 + wave; unit < 2048; unit += gridDim.x * 8) {
        const int hq = unit & 1, d = (unit >> 1) & 1, tg = unit >> 2;
        const int row = tg * 16 + fr;
        const bool lat = row >= NCTX;
        const int pos = lat ? ((row - NCTX) & 2047) : (row & 255);
        const int T = lat ? 2048 : 256;
        const bool valid = d == 0 ? (pos > 0) : (pos < T - 1);
        const int srow = valid ? (d == 0 ? row - 1 : row + 1) : row;
        bf16x8 Bz[2][2];
#pragma unroll
        for (int l = 0; l < 2; ++l)
#pragma unroll
            for (int ks = 0; ks < 2; ++ks) {
                const int k = ks * 32 + fq * 8;
                const u32x4 Pv = *(const u32x4*)(Z + (size_t)row * ZLD + 5632 + ((d * 2 + l) * 2 + 0) * 64 + k);
                u32x4 Qv = *(const u32x4*)(Z + (size_t)srow * ZLD + 5632 + ((d * 2 + l) * 2 + 1) * 64 + k);
                if (!valid) Qv = (u32x4){0u, 0u, 0u, 0u};
                u32x4 o;
#pragma unroll
                for (int i = 0; i < 4; ++i) {
                    float z0 = bflo(Pv[i]) + bflo(Qv[i]), z1 = bfhi(Pv[i]) + bfhi(Qv[i]);
                    if (l == 0) {
                        z0 = 1.0f - 2.0f * __builtin_amdgcn_rcpf(__expf(2.0f * z0) + 1.0f);
                        z1 = 1.0f - 2.0f * __builtin_amdgcn_rcpf(__expf(2.0f * z1) + 1.0f);
                    }
                    o[i] = pk_bf16(z0, z1);
                }
                Bz[l][ks] = __builtin_bit_cast(bf16x8, o);
            }
        for (int hh = hq * 4; hh < hq * 4 + 4; ++hh) {
            f32x4 accw[4], acca[4];
#pragma unroll
            for (int mt = 0; mt < 4; ++mt) {
                accw[mt] = (f32x4){0.f, 0.f, 0.f, 0.f}; acca[mt] = (f32x4){0.f, 0.f, 0.f, 0.f};
#pragma unroll
                for (int ks = 0; ks < 2; ++ks) {
                    const bf16x8 Aw = *(const bf16x8*)(L2T + ((size_t)(d * 2 + 0) * 512 + hh * 64 + mt * 16 + fr) * 64 + ks * 32 + fq * 8);
                    const bf16x8 Aa = *(const bf16x8*)(L2T + ((size_t)(d * 2 + 1) * 512 + hh * 64 + mt * 16 + fr) * 64 + ks * 32 + fq * 8);
                    accw[mt] = __builtin_amdgcn_mfma_f32_16x16x32_bf16(Aw, Bz[0][ks], accw[mt], 0, 0, 0);
                    acca[mt] = __builtin_amdgcn_mfma_f32_16x16x32_bf16(Aa, Bz[1][ks], acca[mt], 0, 0, 0);
                }
            }
            float ss = 0.f, bon = 0.f;
            f32x4 kkr[4], kd[4];
#pragma unroll
            for (int mt = 0; mt < 4; ++mt) {
                const int c = hh * 64 + mt * 16 + fq * 4;
                const f32x4 w0 = *(const f32x4*)(kp->in[14] + d * 512 + c), a0 = *(const f32x4*)(kp->in[17] + d * 512 + c);
                const f32x4 kkp = *(const f32x4*)(kp->in[20] + c), kap = *(const f32x4*)(kp->in[21] + c), rkp = *(const f32x4*)(kp->in[22] + c);
                const u32x2 kz = *(const u32x2*)(Z + (size_t)row * ZLD + 512 + c), rz = *(const u32x2*)(Z + (size_t)row * ZLD + c);
                const float kv[4] = {bflo(kz[0]), bfhi(kz[0]), bflo(kz[1]), bfhi(kz[1])};
                const float rv[4] = {bflo(rz[0]), bfhi(rz[0]), bflo(rz[1]), bfhi(rz[1])};
#pragma unroll
                for (int j = 0; j < 4; ++j) {
                    const float xw = accw[mt][j] + w0[j];
                    accw[mt][j] = __expf(-0.60653065971f * sigm(xw));
                    const float a = sigm(acca[mt][j] + a0[j]);
                    acca[mt][j] = a;
                    const float kr = kv[j] * kkp[j];
                    kkr[mt][j] = kr; ss += kr * kr;
                    const float kdd = kv[j] * (1.0f + (a - 1.0f) * kap[j]);
                    kd[mt][j] = kdd;
                    bon += rv[j] * kdd * rkp[j];
                }
            }
            ss += __shfl_xor(ss, 16); ss += __shfl_xor(ss, 32);
            bon += __shfl_xor(bon, 16); bon += __shfl_xor(bon, 32);
            const float inv = rsqrtf(ss + 1e-12f);
            const int row0 = tg * 16;
#pragma unroll
            for (int pass = 0; pass < 4; ++pass) {
                if (pass == 3 && d != 0) break;
#pragma unroll
                for (int mt = 0; mt < 4; ++mt) {
                    f32x4 val;
                    if (pass == 0) val = accw[mt];
                    else if (pass == 1) val = kd[mt];
                    else if (pass == 2) val = kkr[mt] * inv * acca[mt];
                    else val = kkr[mt] * inv;
                    *(f32x4*)(wt + fr * 68 + mt * 16 + fq * 4) = val;
                }
                asm volatile("s_waitcnt lgkmcnt(0)" ::: "memory");
#pragma unroll
                for (int i = 0; i < 4; ++i) {
                    const int id = i * 64 + lane, tk = id >> 4, c4 = (id & 15) * 4;
                    const f32x4 val = *(const f32x4*)(wt + tk * 68 + c4);
                    const size_t o = ((size_t)d * NTOK + row0 + tk) * DR + hh * 64 + c4;
                    if (pass == 0) *(f32x4*)(WD + o) = val;
                    else {
                        u32x2 v; v[0] = pk_bf16(val[0], val[1]); v[1] = pk_bf16(val[2], val[3]);
                        if (pass == 1) *(u32x2*)(KD + o) = v;
                        else if (pass == 2) *(u32x2*)(BB + o) = v;
                        else *(u32x2*)(KK + (size_t)(row0 + tk) * DR + hh * 64 + c4) = v;
                    }
                }
                asm volatile("s_waitcnt lgkmcnt(0)" ::: "memory");
            }
            if (fq == 0) BONUS[((size_t)d * NTOK + row) * 8 + hh] = bon;
        }
    }
}

__device__ __forceinline__ float red16x4(float p0, float p1, float p2, float p3, const bool b0, const bool b1) {
    const float own01 = b0 ? p1 : p0, snd01 = b0 ? p0 : p1;
    const float own23 = b0 ? p3 : p2, snd23 = b0 ? p2 : p3;
    const float r01 = own01 + dppf<0xB1>(snd01);
    const float r23 = own23 + dppf<0xB1>(snd23);
    const float own = b1 ? r23 : r01, snd = b1 ? r01 : r23;
    float r = own + dppf<0x4E>(snd);
    r += dppf<0x124>(r);
    r += dppf<0x128>(r);
    return r;
}
constexpr int TC = 32, STEP_F = 352;
typedef float f32x2 __attribute__((ext_vector_type(2)));
constexpr int SCAN_IN_F = TC * STEP_F;
constexpr int SCAN_Y_OFF = 2 * SCAN_IN_F;
struct ChunkDesc { int base, T, d, h, rq, c, b; bool first, last; };
template <bool LAT> __device__ __forceinline__ ChunkDesc chunk_desc(int slot, int g) {
    ChunkDesc q;
    if (LAT) {
        const int chain = slot >> 2; q.rq = slot & 3; q.b = chain >> 4; q.h = (chain >> 1) & 7; q.d = chain & 1;
        q.T = 2048; q.base = NCTX + q.b * 2048; q.c = g; q.first = g == 0; q.last = false;
    } else {
        const int u = slot * 4 + (g >> 3), chain = u >> 1; q.rq = u & 1; q.b = chain >> 4; q.h = (chain >> 1) & 7; q.d = chain & 1;
        q.T = 256; q.base = q.b * 256; q.c = g & 7; q.first = q.c == 0; q.last = q.c == 7;
    }
    return q;
}
__device__ __forceinline__ void st4(float* dst, unsigned a, unsigned b) {
    *(f32x4*)dst = (f32x4){bflo(a), bfhi(a), bflo(b), bfhi(b)};
}
struct LReg { u32x4 r8, k8, kk8, b8, v8; f32x4 w0, w1; };

template <bool LAT> __device__ __forceinline__ void scan_pass(char* shm, const int tid, const int slot) {
    constexpr int NSW = 4, RPL = LAT ? 1 : 2, RB = NSW * 4 * RPL, NCH = LAT ? 64 : 32;
    KParams* kp = kargs();
    float* lds = (float*)shm;
    const int wave = __builtin_amdgcn_readfirstlane(tid >> 6), lane = tid & 63;
    const bf16_t* Z = (const bf16_t*)(kp->ws + OFF_R1);
    const bf16_t* KK = (const bf16_t*)(kp->ws + OFF_R2 + R2_KK);
    const float* WD = (const float*)(kp->ws + OFF_R2 + R2_WD);
    const bf16_t* KD = (const bf16_t*)(kp->ws + OFF_R2 + R2_KD);
    const bf16_t* BB = (const bf16_t*)(kp->ws + OFF_R2 + R2_BB);
    bf16_t* Y = (bf16_t*)(kp->ws + OFF_H);
    float* OST = kp->out + (size_t)NTOK * DM;
    const float* ST0 = kp->in[3];
    {
        if (wave >= 4) {
            const int lt = tid - 256, s = lt >> 3, cg8 = (lt & 7) * 8;
            constexpr int NV = TC * RB / 8;
            LReg R;
            auto ld_chunk = [&](int g) {
                const ChunkDesc q = chunk_desc<LAT>(slot, g);
                const int tt = q.c * TC + s, t = q.d ? q.T - 1 - tt : tt, row = q.base + t;
                const int ch = q.h * 64 + cg8;
                const size_t od = ((size_t)q.d * NTOK + row) * DR + ch;
                R.r8 = *(const u32x4*)(Z + (size_t)row * ZLD + ch);
                R.w0 = *(const f32x4*)(WD + od); R.w1 = *(const f32x4*)(WD + od + 4);
                R.k8 = *(const u32x4*)(KD + od);
                R.kk8 = *(const u32x4*)(KK + (size_t)row * DR + ch);
                R.b8 = *(const u32x4*)(BB + od);
                if (lt < NV) {
                    const int s2 = lt / (RB / 8), hf = lt % (RB / 8);
                    const int tt2 = q.c * TC + s2, t2 = q.d ? q.T - 1 - tt2 : tt2, row2 = q.base + t2;
                    R.v8 = *(const u32x4*)(Z + (size_t)row2 * ZLD + 1024 + q.h * 64 + q.rq * RB + hf * 8);
                }
            };
            ld_chunk(0);
            for (int g = -1; g <= NCH; ++g) {
                if (g + 1 <= NCH - 1) {
                    float* buf = lds + ((g + 1) & 1) * SCAN_IN_F;
                    float* L = buf + s * STEP_F + cg8;
                    st4(L, R.r8[0], R.r8[1]); st4(L + 4, R.r8[2], R.r8[3]);
                    *(f32x4*)(L + 64) = R.w0; *(f32x4*)(L + 68) = R.w1;
                    st4(L + 128, R.k8[0], R.k8[1]); st4(L + 132, R.k8[2], R.k8[3]);
                    st4(L + 192, R.kk8[0], R.kk8[1]); st4(L + 196, R.kk8[2], R.kk8[3]);
                    st4(L + 256, R.b8[0], R.b8[1]); st4(L + 260, R.b8[2], R.b8[3]);
                    if (lt < NV) {
                        const int s2 = lt / (RB / 8), hf = lt % (RB / 8);
                        float* Lv = buf + s2 * STEP_F + 320 + hf * 8;
                        st4(Lv, R.v8[0], R.v8[1]); st4(Lv + 4, R.v8[2], R.v8[3]);
                    }
                }
                if (g + 2 <= NCH - 1) ld_chunk(g + 2);
                if (g >= 1) {
                    const ChunkDesc q = chunk_desc<LAT>(slot, g - 1);
                    const float* yb = lds + SCAN_Y_OFF + ((g - 1) & 1) * (TC * RB);
#pragma unroll
                    for (int i = lt; i < TC * RB / 2; i += 256) {
                        const int sy = i / (RB / 2), r2 = (i % (RB / 2)) * 2;
                        const int tt = q.c * TC + sy, t = q.d ? q.T - 1 - tt : tt, row = q.base + t;
                        const f32x2 yv = *(const f32x2*)(yb + sy * RB + r2);
                        *(unsigned*)(Y + ((size_t)q.d * NTOK + row) * DR + q.h * 64 + q.rq * RB + r2) = pk_bf16(yv[0], yv[1]);
                    }
                }
                __syncthreads();
            }
        } else if (wave < NSW) {
            const int rl = lane >> 4, qq = lane & 15;
            f32x2 Sa[RPL], Sb[RPL];
#pragma unroll
            for (int j = 0; j < RPL; ++j) { Sa[j] = (f32x2){0.f, 0.f}; Sb[j] = (f32x2){0.f, 0.f}; }
            __syncthreads();
            for (int g = 0; g <= NCH - 1; ++g) {
                const ChunkDesc q = chunk_desc<LAT>(slot, g);
                const float* buf = lds + (g & 1) * SCAN_IN_F;
                const int rloc = wave * RPL * 4 + rl;
                float* yb = lds + SCAN_Y_OFF + (g & 1) * (TC * RB) + rloc;
                if (q.first) {
#pragma unroll
                    for (int j = 0; j < RPL; ++j) {
                        if (LAT) {
                            const int irow = q.rq * RB + rloc + 4 * j;
                            const f32x4 s = *(const f32x4*)(ST0 + ((size_t)((q.b * 2 + q.d) * 8 + q.h) * 64 + irow) * 64 + qq * 4);
                            Sa[j] = (f32x2){s[0], s[1]}; Sb[j] = (f32x2){s[2], s[3]};
                        } else { Sa[j] = (f32x2){0.f, 0.f}; Sb[j] = (f32x2){0.f, 0.f}; }
                    }
                }
                const float* Lq = buf + qq * 4;
                const float* Lv = buf + 320 + rloc;
                f32x4 r4 = *(const f32x4*)(Lq), w4 = *(const f32x4*)(Lq + 64), k4 = *(const f32x4*)(Lq + 128), n4 = *(const f32x4*)(Lq + 192), b4 = *(const f32x4*)(Lq + 256);
                f32x4 r4n = *(const f32x4*)(Lq + STEP_F), w4n = *(const f32x4*)(Lq + STEP_F + 64), k4n = *(const f32x4*)(Lq + STEP_F + 128), n4n = *(const f32x4*)(Lq + STEP_F + 192), b4n = *(const f32x4*)(Lq + STEP_F + 256);
                float v[RPL], vn[RPL], yp[RPL][4];
                const bool qb0 = (qq & 1) != 0, qb1 = (qq & 2) != 0;
                float* ybq = yb + (qq & 3) * RB;
#pragma unroll
                for (int j = 0; j < RPL; ++j) { v[j] = Lv[4 * j]; vn[j] = Lv[STEP_F + 4 * j]; }
#pragma unroll
                for (int s = 0; s < TC; ++s) {
                    const int s2 = (s + 2 < TC) ? s + 2 : TC - 1;
                    const float* Ln = Lq + s2 * STEP_F;
                    const f32x4 r4m = *(const f32x4*)(Ln), w4m = *(const f32x4*)(Ln + 64), k4m = *(const f32x4*)(Ln + 128), n4m = *(const f32x4*)(Ln + 192), b4m = *(const f32x4*)(Ln + 256);
                    float vm[RPL];
#pragma unroll
                    for (int j = 0; j < RPL; ++j) vm[j] = Lv[s2 * STEP_F + 4 * j];
#pragma unroll
                    for (int j = 0; j < RPL; ++j) {
                        f32x2 pp = Sa[j] * (f32x2){n4[0], n4[1]};
                        pp = Sb[j] * (f32x2){n4[2], n4[3]} + pp;
                        float pd = pp[0] + pp[1];
                        const f32x2 vv = {v[j], v[j]};
                        f32x2 Ta = (f32x2){k4[0], k4[1]} * vv, Tb = (f32x2){k4[2], k4[3]} * vv;
                        Ta = Sa[j] * (f32x2){w4[0], w4[1]} + Ta; Tb = Sb[j] * (f32x2){w4[2], w4[3]} + Tb;
                        pd = red16(pd);
                        const f32x2 np = {-pd, -pd};
                        Sa[j] = (f32x2){b4[0], b4[1]} * np + Ta; Sb[j] = (f32x2){b4[2], b4[3]} * np + Tb;
                        f32x2 yy = Sa[j] * (f32x2){r4[0], r4[1]};
                        yy = Sb[j] * (f32x2){r4[2], r4[3]} + yy;
                        yp[j][s & 3] = yy[0] + yy[1];
                        if ((s & 3) == 3) ybq[(s - 3) * RB + 4 * j] = red16x4(yp[j][0], yp[j][1], yp[j][2], yp[j][3], qb0, qb1);
                    }
                    r4 = r4n; w4 = w4n; k4 = k4n; n4 = n4n; b4 = b4n;
                    r4n = r4m; w4n = w4m; k4n = k4m; n4n = n4m; b4n = b4m;
#pragma unroll
                    for (int j = 0; j < RPL; ++j) { v[j] = vn[j]; vn[j] = vm[j]; }
                }
                if (!LAT && q.last) {
#pragma unroll
                    for (int j = 0; j < RPL; ++j) {
                        const int irow = q.rq * RB + rloc + 4 * j;
                        *(f32x4*)(OST + ((size_t)((q.b * 2 + q.d) * 8 + q.h) * 64 + irow) * 64 + qq * 4) = (f32x4){Sa[j][0], Sa[j][1], Sb[j][0], Sb[j][1]};
                    }
                }
                __syncthreads();
            }
            __syncthreads();
        } else {
            for (int g = -1; g <= NCH; ++g) __syncthreads();
        }
    }
}
__device__ void phase_scan(char* shm) {
    const int tid = tid_l();
    for (int slot = blockIdx.x; slot < 256; slot += gridDim.x) {
        if (slot < 128) scan_pass<true>(shm, tid, slot);
        else scan_pass<false>(shm, tid, slot - 128);
        __syncthreads();
    }
}

__device__ void phase_post() {
    KParams* kp = kargs();
    const int tid = tid_l(), lane = tid & 63, wave = tid >> 6;
    const bf16_t* Z = (const bf16_t*)(kp->ws + OFF_R1);
    const bf16_t* Y = (const bf16_t*)(kp->ws + OFF_H);
    const float* BONUS = (const float*)(kp->ws + OFF_BONUS);
    bf16_t* YA = (bf16_t*)(kp->ws + OFF_R2 + R2_YA);
    bf16_t* YB = (bf16_t*)(kp->ws + OFF_R2 + R2_YB);
    const int c = lane * 8, head = lane >> 3;
    for (int row = blockIdx.x * 8 + wave; row < NTOK; row += gridDim.x * 8) {
        const u32x4 y0 = *(const u32x4*)(Y + (size_t)row * DR + c), y1 = *(const u32x4*)(Y + ((size_t)NTOK + row) * DR + c);
        float y[8];
#pragma unroll
        for (int i = 0; i < 4; ++i) { y[2 * i] = bflo(y0[i]) + bflo(y1[i]); y[2 * i + 1] = bfhi(y0[i]) + bfhi(y1[i]); }
        float s = 0.f;
#pragma unroll
        for (int i = 0; i < 8; ++i) s += y[i];
        s += __shfl_xor(s, 1); s += __shfl_xor(s, 2); s += __shfl_xor(s, 4);
        const float mean = s * (1.0f / 64.0f);
        float vs = 0.f;
#pragma unroll
        for (int i = 0; i < 8; ++i) { y[i] -= mean; vs += y[i] * y[i]; }
        vs += __shfl_xor(vs, 1); vs += __shfl_xor(vs, 2); vs += __shfl_xor(vs, 4);
        const float rs = rsqrtf(vs * (1.0f / 64.0f) + 64e-5f);
        const float bon = BONUS[(size_t)row * 8 + head] + BONUS[((size_t)NTOK + row) * 8 + head];
        const u32x4 vz = *(const u32x4*)(Z + (size_t)row * ZLD + 1024 + c), gz = *(const u32x4*)(Z + (size_t)row * ZLD + 1536 + c);
        const f32x4 gn0 = *(const f32x4*)(kp->in[23] + c), gn1 = *(const f32x4*)(kp->in[23] + c + 4);
        const f32x4 gb0 = *(const f32x4*)(kp->in[24] + c), gb1 = *(const f32x4*)(kp->in[24] + c + 4);
        float o[8];
#pragma unroll
        for (int i = 0; i < 8; ++i) {
            const float vv = (i & 1) ? bfhi(vz[i >> 1]) : bflo(vz[i >> 1]);
            const float gg = (i & 1) ? bfhi(gz[i >> 1]) : bflo(gz[i >> 1]);
            const float gain = i < 4 ? gn0[i & 3] : gn1[i & 3], bias = i < 4 ? gb0[i & 3] : gb1[i & 3];
            o[i] = (y[i] * rs * gain + bias + bon * vv) * sigm(gg);
        }
        u32x4 ov;
#pragma unroll
        for (int i = 0; i < 4; ++i) ov[i] = pk_bf16(o[2 * i], o[2 * i + 1]);
        *(u32x4*)(YA + (size_t)row * DR + c) = ov;
    }
}

__device__ void phase_convb(int gw, int nw) {
    KParams* kp = kargs();
    const int tid = tid_l(), lane = tid & 63;
    const bf16_t* Z = (const bf16_t*)(kp->ws + OFF_R1);
    bf16_t* YB = (bf16_t*)(kp->ws + OFF_YB2);
    const int c = lane * 8;
    for (int row = gw; row < NTOK; row += nw) {
        float o[8]; u32x4 ov;
        const bool lat = row >= NCTX;
        const int pos = lat ? ((row - NCTX) & 63) : (row & 255);
        const int last = lat ? 63 : 255;
        const bool vl = pos > 0, vr = pos < last;
        const int rl = vl ? row - 1 : row, rr = vr ? row + 1 : row;
        const u32x4 ccm = *(const u32x4*)(Z + (size_t)row * ZLD + 2560 + c), xcm = *(const u32x4*)(Z + (size_t)row * ZLD + 3072 + c);
        const u32x4 ccl = *(const u32x4*)(Z + (size_t)rl * ZLD + 2560 + c), xcl = *(const u32x4*)(Z + (size_t)rl * ZLD + 3072 + c);
        const u32x4 ccr = *(const u32x4*)(Z + (size_t)rr * ZLD + 2560 + c), xcr = *(const u32x4*)(Z + (size_t)rr * ZLD + 3072 + c);
        const u32x4 cbz = *(const u32x4*)(Z + (size_t)row * ZLD + 2048 + c);
        const float fl = vl ? 1.f : 0.f, frr = vr ? 1.f : 0.f;
#pragma unroll
        for (int i = 0; i < 8; ++i) {
            const int w = i >> 1; const bool hi = i & 1;
            const float um = (hi ? bfhi(ccm[w]) : bflo(ccm[w])) * (hi ? bfhi(xcm[w]) : bflo(xcm[w]));
            const float ul = (hi ? bfhi(ccl[w]) : bflo(ccl[w])) * (hi ? bfhi(xcl[w]) : bflo(xcl[w])) * fl;
            const float ur = (hi ? bfhi(ccr[w]) : bflo(ccr[w])) * (hi ? bfhi(xcr[w]) : bflo(xcr[w])) * frr;
            const float cb = hi ? bfhi(cbz[w]) : bflo(cbz[w]);
            const float cv = ul * kp->in[25][c + i] + um * kp->in[25][512 + c + i] + ur * kp->in[25][1024 + c + i] + kp->in[26][c + i];
            o[i] = cb * cv;
        }
#pragma unroll
        for (int i = 0; i < 4; ++i) ov[i] = pk_bf16(o[2 * i], o[2 * i + 1]);
        *(u32x4*)(YB + (size_t)row * DR + c) = ov;
    }
}

#define XB_TMO      128
#define XB_XCNT(j)  (256  + 64 * (j))
#define XB_XSUB(j)  (1280 + 64 * (j))
#define XB_XGEN(j)  (2304 + 64 * (j))
#define XB_TOP      3328
#define XB_TOPGEN   3392
#define XCD_BAR_WORDS 3456
#define XB_SPIN_CAP (1u << 18)
#define XLAS __attribute__((address_space(3)))
__device__ __forceinline__ unsigned xb_ld(unsigned* p)              { return __hip_atomic_load(p, __ATOMIC_RELAXED, __HIP_MEMORY_SCOPE_AGENT); }
__device__ __forceinline__ unsigned xb_add(unsigned* p, unsigned v) { return __hip_atomic_fetch_add(p, v, __ATOMIC_RELAXED, __HIP_MEMORY_SCOPE_AGENT); }
__device__ __forceinline__ unsigned xb_xcc_id() { return (unsigned)__builtin_amdgcn_s_getreg((3 << 11) | 20) & 0xFu; }
#define XB_SPIN(cond, bar) do { unsigned _sp = 0; while (cond) { __builtin_amdgcn_s_sleep(1); \
    if ((++_sp & 255u) == 0u) { if (xb_ld(&(bar)[XB_TMO])) break; if (_sp > XB_SPIN_CAP) { atomicAdd(&(bar)[XB_TMO], 1u); break; } } } } while (0)
struct XcdBarrier { unsigned* bar; unsigned x; volatile XLAS unsigned* st; };
__device__ __forceinline__ XcdBarrier xcd_barrier_post(unsigned* bar, volatile XLAS unsigned* st) {
    XcdBarrier b; b.bar = bar; b.x = xb_xcc_id(); b.st = st;
    if (threadIdx.x == 0) (void)xb_add(&bar[XB_XCNT(b.x)], 1u);
    return b;
}
__device__ __forceinline__ void xcd_barrier_complete(unsigned* bar, unsigned x, unsigned& nloc, unsigned& nx) {
    const unsigned G = gridDim.x * gridDim.y * gridDim.z;
    unsigned sum, cnt, mine, sp = 0u;
    for (;;) {
        sum = 0u; cnt = 0u; mine = 0u;
#pragma unroll
        for (unsigned j = 0; j < 16; ++j) { const unsigned c = xb_ld(&bar[XB_XCNT(j)]); sum += c; cnt += (c > 0u) ? 1u : 0u; mine = (j == x) ? c : mine; }
        if (sum == G) break;
        __builtin_amdgcn_s_sleep(1);
        if ((++sp & 255u) == 0u) { if (xb_ld(&bar[XB_TMO])) break; if (sp > XB_SPIN_CAP) { atomicAdd(&bar[XB_TMO], 1u); break; } }
    }
    nloc = mine > 0u ? mine : 1u; nx = cnt > 0u ? cnt : 1u;
}
__device__ __forceinline__ void xcd_barrier(const XcdBarrier& b) {
    asm volatile("s_waitcnt vmcnt(0)" ::: "memory");
    __syncthreads();
    if (threadIdx.x == 0) {
        unsigned* bar = b.bar;
        __builtin_amdgcn_s_waitcnt(0);
        unsigned nloc = b.st[0], nx = b.st[1];
        if (nloc == 0u) { xcd_barrier_complete(bar, b.x, nloc, nx); b.st[0] = nloc; b.st[1] = nx; }
        const unsigned old = xb_add(&bar[XB_XSUB(b.x)], 1u);
        const unsigned gen = old / nloc;
        if (old + 1u == (gen + 1u) * nloc) {
            __builtin_amdgcn_fence(__ATOMIC_RELEASE, "agent");
            asm volatile("s_waitcnt vmcnt(0)" ::: "memory");
            const unsigned og = xb_add(&bar[XB_TOP], 1u);
            const unsigned tg = og / nx;
            if (og + 1u == (tg + 1u) * nx) xb_add(&bar[XB_TOPGEN], 1u);
            else XB_SPIN(xb_ld(&bar[XB_TOPGEN]) == tg, bar);
            __builtin_amdgcn_fence(__ATOMIC_ACQUIRE, "agent");
            xb_add(&bar[XB_XGEN(b.x)], 1u);
            asm volatile("s_waitcnt vmcnt(0)" ::: "memory");
        } else {
            XB_SPIN(xb_ld(&bar[XB_XGEN(b.x)]) == gen, bar);
            __builtin_amdgcn_fence(__ATOMIC_ACQUIRE, "agent");
            asm volatile("s_waitcnt vmcnt(0)" ::: "memory");
        }
    }
    __syncthreads();
}

struct RowJob { const float* xc; const float* xl; const bf16_t* P; float* xdst; bf16_t* hdst; int gA, mGate, gB, mShift, mScale; float sA; };

__global__ void __launch_bounds__(NTHREADS) fwd_megakernel(Params p) {
    extern __shared__ __attribute__((aligned(16))) char shm[];
    volatile XLAS unsigned* st = (volatile XLAS unsigned*)((XLAS unsigned char*)shm + LDS_STAGE);
    if (threadIdx.x < 4) st[threadIdx.x] = 0u;
    __syncthreads();
    const XcdBarrier xb = xcd_barrier_post((unsigned*)(kargs()->ws + OFF_BAR), st);
    const int ph_lo = kargs()->phase_lo, ph_hi = kargs()->phase_hi;
    for (int ph = ph_lo; ph < ph_hi; ++ph) {
        KParams* kp0 = kargs();
        char* ws = kp0->ws;
        bf16_t* H = (bf16_t*)(ws + OFF_H);
        bf16_t* R1 = (bf16_t*)(ws + OFF_R1);
        float* R2f = (float*)(ws + OFF_R2);
        float* out = kp0->out;
        const float* xlat_out = out + (size_t)NCTX * DM;
        int kind = 0;
        int cv_set = -1, cv_first = 0;
        RowJob R{}; GemmJob J{};
        switch (ph) {
        case 1: kind = 1; R = RowJob{kargs()->in[0], kargs()->in[1], nullptr, nullptr, H, 0, 0, 0, 0, 1, 0.f}; break;
        case 4: kind = 1; R = RowJob{kargs()->in[0], kargs()->in[1], (const bf16_t*)R2f, out, H, 1, 2, 2, 3, 4, 0.5f}; break;
        case 11: kind = 1; R = RowJob{out, xlat_out, (const bf16_t*)R1, out, H, 3, 5, 4, 6, 7, 1.0f}; break;
        case 14: kind = 1; R = RowJob{out, xlat_out, (const bf16_t*)R2f, out, nullptr, 5, 8, 0, 0, 0, 0.5f}; break;
        case 2: case 12: kind = 2;
            J.A0 = J.A1 = H; J.Bt0 = J.Bt1 = (const bf16_t*)(ws + (ph == 2 ? OFF_W13A : OFF_W13B)); J.lda = DM; J.ldb = DM; J.nN = 22; J.nsplit = 1; J.nt = DM / BK; J.kstride = 0; J.mode = 0; J.o1 = R1; break;
        case 3: case 13: kind = 2;
            J.A0 = J.A1 = R1; J.Bt0 = J.Bt1 = (const bf16_t*)(ws + (ph == 3 ? OFF_W2A : OFF_W2B)); J.lda = DFF; J.ldb = DFF; J.nN = 4; J.nsplit = 2; J.nt = 22; J.kstride = 22 * BK; J.mode = 1; J.o1 = R2f; break;
        case 5: kind = 2;
            J.A0 = J.A1 = H; J.Bt0 = J.Bt1 = (const bf16_t*)(ws + OFF_WIN); J.lda = DM; J.ldb = DM; J.nN = 24; J.nsplit = 1; J.nt = DM / BK; J.kstride = 0; J.mode = 2; J.o1 = R1; break;
        case 9: kind = 2;
            J.A0 = (const bf16_t*)(ws + OFF_R2 + R2_YA); J.A1 = (const bf16_t*)(ws + OFF_YB2); J.Bt0 = (const bf16_t*)(ws + OFF_WA); J.Bt1 = (const bf16_t*)(ws + OFF_WB);
            J.lda = DR; J.ldb = DR; J.nN = 4; J.nsplit = 2; J.nt = DR / BK; J.kstride = 0; J.mode = 3; J.o1 = ws + OFF_R2 + R2_GA; J.o2 = ws + OFF_R2 + R2_GB; J.Z = R1; break;
        case 10: kind = 2;
            J.A0 = (const bf16_t*)(ws + OFF_R2 + R2_GA); J.A1 = (const bf16_t*)(ws + OFF_R2 + R2_GB); J.Bt0 = J.Bt1 = (const bf16_t*)(ws + OFF_WO); J.lda = DM; J.ldb = DM; J.nN = 4; J.nsplit = 2; J.nt = DM / BK; J.kstride = 0; J.mode = 1; J.o1 = R1; break;
        default: break;
        }
        for (int rep = 0; rep <= ((REPEAT_MASK >> ph) & 1); ++rep) {
        if (rep) xcd_barrier(xb);
        if (kind == 1) phase_rowop(R.xc, R.xl, R.P, R.gA, R.mGate, R.sA, R.xdst, R.gB, R.mShift, R.mScale, R.hdst);
        else if (kind == 2) phase_gemm(shm, J);
        else if (ph == 0) { phase_convert(shm); cv_set = 0; cv_first = 0; }
        else if (ph == 6) phase_prep(shm);
        else if (ph == 7) { phase_scan(shm); cv_set = 1; cv_first = ((int)gridDim.x == 256) ? 128 : 0; }
        else if (ph == 8) phase_post();
        }
        if (cv_set >= 0 && (int)blockIdx.x >= cv_first)
            convert_tiles(shm, cv_set, ((int)blockIdx.x - cv_first) * 8 + (int)(threadIdx.x >> 6), ((int)gridDim.x - cv_first) * 8);
        if (ph == 7 && (int)blockIdx.x >= cv_first)
            phase_convb(((int)blockIdx.x - cv_first) * 8 + (int)(threadIdx.x >> 6), ((int)gridDim.x - cv_first) * 8);
        if (ph + 1 < ph_hi) xcd_barrier(xb);
    }
}

extern "C" void kernel_launch(void* const* d_in, const int* in_sizes, int n_in, void* d_out, int out_size, void* d_ws, size_t ws_size, hipStream_t stream) {
    static int grid_blocks = 0;
    if (grid_blocks == 0) {
        if (ws_size < WS_END) { fprintf(stderr, "kernel_launch: workspace too small: %zu < %zu\n", ws_size, (size_t)WS_END); grid_blocks = -1; return; }
        int dev = 0, cus = 0, per_cu = 0;
        hipGetDevice(&dev);
        hipDeviceGetAttribute(&cus, hipDeviceAttributeMultiprocessorCount, dev);
        if (hipFuncSetAttribute((const void*)fwd_megakernel, hipFuncAttributeMaxDynamicSharedMemorySize, LDS_BYTES) != hipSuccess) { fprintf(stderr, "hipFuncSetAttribute failed\n"); grid_blocks = -1; return; }
        hipOccupancyMaxActiveBlocksPerMultiprocessor(&per_cu, (const void*)fwd_megakernel, NTHREADS, LDS_BYTES);
        if (per_cu < 1) { fprintf(stderr, "occupancy query says %d\n", per_cu); per_cu = 1; }
        if (per_cu > 1) per_cu = 1;
        grid_blocks = cus * per_cu;
    }
    if (grid_blocks < 0) return;
    Params p{};
    for (int i = 0; i < 30; ++i) p.in[i] = (const float*)d_in[i];
    p.out = (float*)d_out; p.ws = (char*)d_ws; p.phase_lo = 0; p.phase_hi = 15;
    if (hipMemsetAsync((char*)d_ws + OFF_BAR, 0, 16384, stream) != hipSuccess) { fprintf(stderr, "memset of barrier words failed\n"); return; }
    void* args[] = {&p};
    hipError_t e = hipLaunchCooperativeKernel((const void*)fwd_megakernel, dim3(grid_blocks), dim3(NTHREADS), args, LDS_BYTES, stream);
    if (e != hipSuccess) fprintf(stderr, "cooperative launch failed: %s (grid %d)\n", hipGetErrorString(e), grid_blocks);
}
```

```cpp
#include <hip/hip_runtime.h>
#include <hip/hip_cooperative_groups.h>
#include <cstdio>
namespace cg = cooperative_groups;

typedef unsigned short bf16_t;
typedef short bf16x8 __attribute__((ext_vector_type(8)));
typedef float f32x4 __attribute__((ext_vector_type(4)));
typedef unsigned u32x4 __attribute__((ext_vector_type(4)));
typedef unsigned u32x2 __attribute__((ext_vector_type(2)));

constexpr int DM = 1024, NTOK = 8192, NCTX = 4096, DFF = 2816, NIN = 6144, ZLD = 6144, DR = 512;
constexpr int NTHREADS = 512;
#define REPEAT_MASK 0
constexpr int LDS_STAGE = 131072;
constexpr int LDS_BYTES = LDS_STAGE + 16;

constexpr size_t SZ_W13 = (size_t)5632 * 1024 * 2, SZ_W2 = (size_t)1024 * 2816 * 2;
constexpr size_t OFF_W13A = 0;
constexpr size_t OFF_W2A = OFF_W13A + SZ_W13;
constexpr size_t OFF_W13B = OFF_W2A + SZ_W2;
constexpr size_t OFF_W2B = OFF_W13B + SZ_W13;
constexpr size_t OFF_WIN = OFF_W2B + SZ_W2;
constexpr size_t OFF_WA = OFF_WIN + (size_t)6144 * 1024 * 2;
constexpr size_t OFF_WB = OFF_WA + (size_t)1024 * 512 * 2;
constexpr size_t OFF_WO = OFF_WB + (size_t)1024 * 512 * 2;
constexpr size_t OFF_L2 = OFF_WO + (size_t)1024 * 1024 * 2;
constexpr size_t OFF_MOD = OFF_L2 + (size_t)4 * 512 * 64 * 2;
constexpr size_t OFF_BONUS = OFF_MOD + (size_t)2 * 3 * 9216 * 4;
constexpr size_t OFF_H = OFF_BONUS + (size_t)2 * 8192 * 8 * 4;
constexpr size_t OFF_R1 = OFF_H + (size_t)8192 * 1024 * 2;
constexpr size_t OFF_R2 = OFF_R1 + (size_t)8192 * 6144 * 2;
constexpr size_t OFF_BAR = OFF_R2 + (size_t)72 * 1024 * 1024;
constexpr size_t OFF_YB2 = OFF_BAR + 16384;
constexpr size_t WS_END = OFF_YB2 + (size_t)8192 * 512 * 2;
constexpr size_t R2_KK = 0;
constexpr size_t R2_WD = R2_KK + (size_t)8192 * 512 * 2;
constexpr size_t R2_KD = R2_WD + (size_t)2 * 8192 * 512 * 4;
constexpr size_t R2_BB = R2_KD + (size_t)2 * 8192 * 512 * 2;
constexpr size_t R2_YA = 0;
constexpr size_t R2_YB = R2_YA + (size_t)8192 * 512 * 2;
constexpr size_t R2_GA = R2_YB + (size_t)8192 * 512 * 2;
constexpr size_t R2_GB = R2_GA + (size_t)8192 * 1024 * 2;

struct Params {
    const float* in[30];
    float* out;
    char* ws;
    int phase_lo, phase_hi;
};


typedef const __attribute__((address_space(4))) Params KParams;
__device__ __forceinline__ KParams* kargs() {
    KParams* k = (KParams*)__builtin_amdgcn_kernarg_segment_ptr();
    asm volatile("" : "+s"(k));
    return k;
}

__device__ __forceinline__ int tid_l() { int t = threadIdx.x; asm volatile("" : "+v"(t)); return t; }
__device__ __forceinline__ float bf2f(unsigned short u) { return __uint_as_float(((unsigned)u) << 16); }
__device__ __forceinline__ float bflo(unsigned u) { return __uint_as_float(u << 16); }
__device__ __forceinline__ float bfhi(unsigned u) { return __uint_as_float(u & 0xffff0000u); }
__device__ __forceinline__ unsigned pk_bf16(float lo, float hi) { unsigned r; asm("v_cvt_pk_bf16_f32 %0, %1, %2" : "=v"(r) : "v"(lo), "v"(hi)); return r; }
__device__ __forceinline__ void st_wt16(void* p, u32x4 v) { asm volatile("global_store_dwordx4 %0, %1, off sc1\n\ts_nop 1" :: "v"(p), "v"(v) : "memory"); }
__device__ __forceinline__ void st_wt16f_nc(void* p, f32x4 v) { asm volatile("global_store_dwordx4 %0, %1, off sc1\n\ts_nop 1" :: "v"(p), "v"(v)); }
__device__ __forceinline__ void st_wt8_nc(void* p, u32x2 v) { asm volatile("global_store_dwordx2 %0, %1, off sc1\n\ts_nop 1" :: "v"(p), "v"(v)); }
__device__ __forceinline__ float sigm(float x) { return __builtin_amdgcn_rcpf(1.0f + __expf(-x)); }
__device__ __forceinline__ float wave_sum(float v) {
#pragma unroll
    for (int o = 32; o > 0; o >>= 1) v += __shfl_xor(v, o);
    return v;
}
template <int CTRL> __device__ __forceinline__ float dppf(float x) {
    return __int_as_float(__builtin_amdgcn_update_dpp(0, __float_as_int(x), CTRL, 0xf, 0xf, true));
}
__device__ __forceinline__ float red16(float x) {
    x += dppf<0xB1>(x);
    x += dppf<0x4E>(x);
    x += dppf<0x141>(x);
    x += dppf<0x140>(x);
    return x;
}

__device__ __forceinline__ void conv_tile_w(char* wl, const float* __restrict__ src, int src_ld, int k0, int c0,
                                            bf16_t* __restrict__ dst, int dst_ld, int n0, const float* __restrict__ mu, int mode, const int lane) {
    float v[64];
    const float* s = src + (size_t)k0 * src_ld + c0 + lane;
#pragma unroll
    for (int i = 0; i < 64; ++i) v[i] = __builtin_nontemporal_load(s + (size_t)i * src_ld);
    if (mode) {
#pragma unroll
        for (int i = 0; i < 64; ++i) { const float m = mu[k0 + i]; v[i] *= (mode == 1) ? m : (1.0f - m); }
    }
#pragma unroll
    for (int q = 0; q < 8; ++q) {
        u32x4 o;
#pragma unroll
        for (int i = 0; i < 4; ++i) o[i] = pk_bf16(v[8 * q + 2 * i], v[8 * q + 2 * i + 1]);
        *(u32x4*)(wl + lane * 144 + q * 16) = o;
    }
    asm volatile("s_waitcnt lgkmcnt(0)" ::: "memory");
#pragma unroll
    for (int i = 0; i < 8; ++i) {
        const int id = i * 64 + lane, r = id >> 3, ch = id & 7;
        const u32x4 o = *(const u32x4*)(wl + r * 144 + ch * 16);
        st_wt16(dst + (size_t)(n0 + r) * dst_ld + k0 + ch * 8, o);
    }
    asm volatile("s_waitcnt lgkmcnt(0)" ::: "memory");
}

__device__ void phase_convert(char* shm) {
    KParams* kp = kargs();
    float* lds = (float*)shm;
    const int tid = tid_l(), lane = tid & 63, wave = __builtin_amdgcn_readfirstlane(tid >> 6);
    float* sc = lds;
    float* red = lds + 3072;
    for (int i = tid; i < 3072; i += NTHREADS) {
        const int mi = i >> 10, k = i & 1023;
        const float cv = (mi == 0) ? kp->in[4][k] : kp->in[2][(mi - 1) * 1024 + k];
        sc[i] = cv * sigm(cv);
    }
    __syncthreads();
    float* modp = (float*)(kp->ws + OFF_MOD);
    for (int task = blockIdx.x; task < 288; task += gridDim.x) {
        const int kh = task / 144, cgp = task % 144, col = cgp * 64 + lane;
        const int kb = kh * 512 + wave * 64;
        const float* wm = kp->in[5] + (size_t)kb * 9216 + col;
        float a0 = 0.f, a1 = 0.f, a2 = 0.f;
#pragma unroll 16
        for (int i = 0; i < 64; ++i) {
            const float w = __builtin_nontemporal_load(wm + (size_t)i * 9216);
            a0 += sc[kb + i] * w; a1 += sc[1024 + kb + i] * w; a2 += sc[2048 + kb + i] * w;
        }
        red[(wave * 3 + 0) * 64 + lane] = a0; red[(wave * 3 + 1) * 64 + lane] = a1; red[(wave * 3 + 2) * 64 + lane] = a2;
        __syncthreads();
        if (tid < 192) {
            const int m = tid >> 6, cc = tid & 63;
            float s = kh == 0 ? kp->in[6][cgp * 64 + cc] : 0.f;
#pragma unroll
            for (int g = 0; g < 8; ++g) s += red[(g * 3 + m) * 64 + cc];
            modp[(kh * 3 + m) * 9216 + cgp * 64 + cc] = s;
        }
        __syncthreads();
    }
}

constexpr int T_W13 = 88 * 16, T_W2 = 16 * 44, T_WIN = 88 * 16, T_LORA = 8 * 16, T_WAB = 16 * 8, T_WO = 16 * 16, T_L2 = 32;
constexpr int CV_TOTAL = 2 * T_W13 + 2 * T_W2 + T_WIN + T_LORA + 2 * T_WAB + T_WO + T_L2;
constexpr int CV_SET1 = T_W13 + T_W2 + 2 * T_WAB + T_WO, CV_SET0 = CV_TOTAL - CV_SET1;
__device__ void convert_tiles(char* shm, int set, int gw, int nw) {
    KParams* kp = kargs();
    const int tid = tid_l(), lane = tid & 63, wave = __builtin_amdgcn_readfirstlane(tid >> 6);
    char* wl = shm + 20480 + wave * (64 * 144);
    const int cnt = set ? CV_SET1 : CV_SET0;
    for (int n = gw; n < cnt; n += nw) {
        int id;
        if (set == 0) id = n < T_W13 ? n : (n < T_W13 + T_W2 ? n + T_W13 : (n < T_W13 + T_W2 + T_WIN + T_LORA ? n + T_W13 + T_W2 : n + T_W13 + T_W2 + 2 * T_WAB + T_WO));
        else id = n < T_W13 ? n + T_W13 : (n < T_W13 + T_W2 ? n + T_W13 + T_W2 : n + T_W13 + T_W2 + T_WIN + T_LORA);
        if (id < 2 * T_W13) {
            const int which = id / T_W13; id -= which * T_W13;
            const int nt = id >> 4, kt = id & 15, j = nt >> 2, w = nt & 3;
            const int c0 = (w < 2) ? (128 * j + 64 * w) : (2816 + 128 * j + 64 * (w - 2));
            conv_tile_w(wl, kp->in[which ? 10 : 8], 5632, kt * 64, c0, (bf16_t*)(kp->ws + (which ? OFF_W13B : OFF_W13A)), 1024, nt * 64, nullptr, 0, lane);
            continue;
        }
        id -= 2 * T_W13;
        if (id < 2 * T_W2) {
            const int which = id / T_W2; id -= which * T_W2;
            const int nt = id / 44, kt = id % 44;
            conv_tile_w(wl, kp->in[which ? 11 : 9], 1024, kt * 64, nt * 64, (bf16_t*)(kp->ws + (which ? OFF_W2B : OFF_W2A)), 2816, nt * 64, nullptr, 0, lane);
            continue;
        }
        id -= 2 * T_W2;
        if (id < T_WIN) {
            const int nt = id >> 4, kt = id & 15;
            conv_tile_w(wl, kp->in[12], 5632, kt * 64, nt * 64, (bf16_t*)(kp->ws + OFF_WIN), 1024, nt * 64, nullptr, 0, lane);
            continue;
        }
        id -= T_WIN;
        if (id < T_LORA) {
            const int nt = id >> 4, kt = id & 15;
            const int pq = nt & 1, l = (nt >> 1) & 1, d = nt >> 2;
            const float* src = kp->in[l ? 18 : 15] + (size_t)d * 1024 * 64;
            conv_tile_w(wl, src, 64, kt * 64, 0, (bf16_t*)(kp->ws + OFF_WIN), 1024, 5632 + nt * 64, kp->in[13] + (d * 2 + l) * 1024, pq ? 1 : 2, lane);
            continue;
        }
        id -= T_LORA;
        if (id < 2 * T_WAB) {
            const int which = id / T_WAB; id -= which * T_WAB;
            const int nt = id >> 3, kt = id & 7;
            conv_tile_w(wl, kp->in[which ? 28 : 27], 1024, kt * 64, nt * 64, (bf16_t*)(kp->ws + (which ? OFF_WB : OFF_WA)), 512, nt * 64, nullptr, 0, lane);
            continue;
        }
        id -= 2 * T_WAB;
        if (id < T_WO) {
            const int nt = id >> 4, kt = id & 15;
            conv_tile_w(wl, kp->in[29], 1024, kt * 64, nt * 64, (bf16_t*)(kp->ws + OFF_WO), 1024, nt * 64, nullptr, 0, lane);
            continue;
        }
        id -= T_WO;
        {
            const int dl = id >> 3, nt = id & 7, d = dl >> 1, l = dl & 1;
            const float* src = kp->in[l ? 19 : 16] + (size_t)d * 64 * 512;
            conv_tile_w(wl, src, 512, 0, nt * 64, (bf16_t*)(kp->ws + OFF_L2) + (size_t)dl * 512 * 64, 64, nt * 64, nullptr, 0, lane);
        }
    }
}

__device__ void phase_rowop(const float* __restrict__ xctx, const float* __restrict__ xlat, const bf16_t* __restrict__ P,
                            int gA, int mGate, float sA, float* __restrict__ xdst, int gB, int mShift, int mScale, bf16_t* __restrict__ hdst) {
    KParams* kp = kargs();
    const int tid = tid_l(), lane = tid & 63, wave = tid >> 6;
    const float* G = kp->in[7];
    const float* MOD = (const float*)(kp->ws + OFF_MOD);
    constexpr int RW = 4;
    for (int row0 = (blockIdx.x * 8 + wave) * RW; row0 < NTOK; row0 += gridDim.x * 8 * RW) {
        const int mi = row0 < NCTX ? 0 : 1 + ((row0 - NCTX) >> 11);
        const float* mod = MOD + mi * 9216;
        const float* xs = row0 < NCTX ? xctx + (size_t)row0 * DM : xlat + (size_t)(row0 - NCTX) * DM;
        f32x4 x[RW][4];
#pragma unroll
        for (int r = 0; r < RW; ++r)
#pragma unroll
            for (int i = 0; i < 4; ++i) x[r][i] = __builtin_nontemporal_load((const f32x4*)(xs + (size_t)r * DM + (i * 64 + lane) * 4));
        if (P) {
            u32x2 p0[RW][4], p1[RW][4];
#pragma unroll
            for (int r = 0; r < RW; ++r)
#pragma unroll
                for (int i = 0; i < 4; ++i) {
                    const size_t o = (size_t)(row0 + r) * DM + (i * 64 + lane) * 4;
                    p0[r][i] = __builtin_nontemporal_load((const u32x2*)(P + o)); p1[r][i] = __builtin_nontemporal_load((const u32x2*)(P + (size_t)NTOK * DM + o));
                }
            f32x4 gm[4];
#pragma unroll
            for (int i = 0; i < 4; ++i) {
                const int c = (i * 64 + lane) * 4;
                gm[i] = *(const f32x4*)(G + gA * DM + c) * (*(const f32x4*)(mod + mGate * DM + c) + *(const f32x4*)(mod + 27648 + mGate * DM + c));
            }
            float ss[RW];
#pragma unroll
            for (int r = 0; r < RW; ++r) {
                ss[r] = 0.f;
#pragma unroll
                for (int i = 0; i < 4; ++i) {
                    const f32x4 f = (f32x4){bflo(p0[r][i][0]) + bflo(p1[r][i][0]), bfhi(p0[r][i][0]) + bfhi(p1[r][i][0]), bflo(p0[r][i][1]) + bflo(p1[r][i][1]), bfhi(p0[r][i][1]) + bfhi(p1[r][i][1])};
                    ss[r] += f[0] * f[0] + f[1] * f[1] + f[2] * f[2] + f[3] * f[3];
                }
            }
#pragma unroll
            for (int o = 32; o > 0; o >>= 1) {
#pragma unroll
                for (int r = 0; r < RW; ++r) ss[r] += __shfl_xor(ss[r], o);
            }
#pragma unroll
            for (int r = 0; r < RW; ++r) {
                const float rstd = rsqrtf(ss[r] * (1.0f / DM) + 1e-6f) * sA;
#pragma unroll
                for (int i = 0; i < 4; ++i) {
                    const int c = (i * 64 + lane) * 4;
                    const f32x4 f = (f32x4){bflo(p0[r][i][0]) + bflo(p1[r][i][0]), bfhi(p0[r][i][0]) + bfhi(p1[r][i][0]), bflo(p0[r][i][1]) + bflo(p1[r][i][1]), bfhi(p0[r][i][1]) + bfhi(p1[r][i][1])};
                    x[r][i] += gm[i] * (f * rstd);
                    st_wt16f_nc(xdst + (size_t)(row0 + r) * DM + c, x[r][i]);
                }
            }
        }
        if (hdst) {
            f32x4 gs[4], sh[4];
#pragma unroll
            for (int i = 0; i < 4; ++i) {
                const int c = (i * 64 + lane) * 4;
                gs[i] = *(const f32x4*)(G + gB * DM + c) * (*(const f32x4*)(mod + mScale * DM + c) + *(const f32x4*)(mod + 27648 + mScale * DM + c) + 1.0f);
                sh[i] = *(const f32x4*)(mod + mShift * DM + c) + *(const f32x4*)(mod + 27648 + mShift * DM + c);
            }
            float ss[RW];
#pragma unroll
            for (int r = 0; r < RW; ++r) {
                ss[r] = 0.f;
#pragma unroll
                for (int i = 0; i < 4; ++i) ss[r] += x[r][i][0] * x[r][i][0] + x[r][i][1] * x[r][i][1] + x[r][i][2] * x[r][i][2] + x[r][i][3] * x[r][i][3];
            }
#pragma unroll
            for (int o = 32; o > 0; o >>= 1) {
#pragma unroll
                for (int r = 0; r < RW; ++r) ss[r] += __shfl_xor(ss[r], o);
            }
#pragma unroll
            for (int r = 0; r < RW; ++r) {
                const float rstd = rsqrtf(ss[r] * (1.0f / DM) + 1e-6f);
#pragma unroll
                for (int i = 0; i < 4; ++i) {
                    const int c = (i * 64 + lane) * 4;
                    const f32x4 h = (x[r][i] * rstd) * gs[i] + sh[i];
                    u32x2 o; o[0] = pk_bf16(h[0], h[1]); o[1] = pk_bf16(h[2], h[3]);
                    st_wt8_nc(hdst + (size_t)(row0 + r) * DM + c, o);
                }
            }
        }
    }
}

constexpr int BM = 256, BK = 64, HALF = 128, HT = HALF * BK;
__device__ __forceinline__ int lds_byte(int r, int c) {
    const int st = (r >> 4) * 2 + (c >> 5), rr = r & 15, cc = c & 31, ob = rr * 64 + cc * 2;
    return st * 1024 + (ob ^ (((ob >> 9) & 1) << 5));
}
__device__ __forceinline__ void stage_rc(int b, int& R, int& C) {
    const int st = b / 1024, sb = b % 1024, swz = sb ^ (((sb >> 9) & 1) << 5);
    R = (st >> 1) * 16 + swz / 64; C = (st & 1) * 32 + (swz % 64) / 2;
}
__device__ __forceinline__ void unit_map(int wgid, int nM, int nN, int& pm, int& pn) {
    const int NXCD = 8, WGM = 8, nwg = nM * nN;
    { const int q = nwg / NXCD, r = nwg % NXCD, xcd = wgid % NXCD, off = wgid / NXCD; wgid = (xcd < r ? xcd * (q + 1) : r * (q + 1) + (xcd - r) * q) + off; }
    const int nig = WGM * nN, gid = wgid / nig, fm = gid * WGM, gsz = min(nM - fm, WGM);
    pm = fm + ((wgid % nig) % gsz); pn = (wgid % nig) / gsz;
}

#define LAS __attribute__((address_space(3)))
constexpr int HTB = HALF * BK * 2;
__device__ __forceinline__ void gemm_tile(char* shmc, const bf16_t* __restrict__ A, int lda, const bf16_t* __restrict__ Bt, int ldb,
                                          int brow, int bcol, int nt, f32x4 (&acc)[2][2][4][2], const int tid) {
    LAS unsigned char* lds = (LAS unsigned char*)shmc;
    const int wid = __builtin_amdgcn_readfirstlane(tid >> 6), lane = tid & 63, wr = wid >> 2, wc = wid & 3, fr = lane & 15, fq = lane >> 4;
    unsigned voffA[2], voffB[2];
#pragma unroll
    for (int i = 0; i < 2; ++i) { int R, C; stage_rc(tid * 16 + i * 8192, R, C); voffA[i] = (unsigned)(R * lda + C) * 2u; voffB[i] = (unsigned)(R * ldb + C) * 2u; }
    const size_t kstep = (size_t)(BK * 2);
    const size_t hstepA = (size_t)HALF * lda * 2, hstepB = (size_t)HALF * ldb * 2;
    const unsigned ldsw = (unsigned)wid * 1024u;
    const int aoff = lds_byte(wr * 64 + fr, fq * 8), boff = lds_byte(wc * 32 + fr, fq * 8);
    const char* cA = (const char*)A + (size_t)brow * lda * 2;
    const char* cB = (const char*)Bt + (size_t)bcol * ldb * 2;
#define SA(b, h) (((b) * 2 + (h)) * HTB)
#define SB(b, h) ((4 + (b) * 2 + (h)) * HTB)
#define STAGE(bufoff, gbase, voff) do { _Pragma("unroll") for (int _i = 0; _i < 2; ++_i) \
    __builtin_amdgcn_global_load_lds((const unsigned*)((const char*)(gbase) + (voff)[_i]), (LAS unsigned*)(lds + (bufoff) + ldsw + _i * 8192), 16, 0, 0); } while (0)
#define LDA(dst, b, h) do { _Pragma("unroll") for (int m = 0; m < 4; ++m) _Pragma("unroll") for (int k = 0; k < 2; ++k) dst[m][k] = *(const LAS bf16x8*)(lds + SA(b, h) + aoff + m * 2048 + k * 1024); } while (0)
#define LDB(dst, b, h) do { _Pragma("unroll") for (int n = 0; n < 2; ++n) _Pragma("unroll") for (int k = 0; k < 2; ++k) dst[n][k] = *(const LAS bf16x8*)(lds + SB(b, h) + boff + n * 2048 + k * 1024); } while (0)
#define MMA(ai, bj, At_, Bt_) do { __builtin_amdgcn_s_setprio(1); _Pragma("unroll") for (int m = 0; m < 4; ++m) _Pragma("unroll") for (int n = 0; n < 2; ++n) _Pragma("unroll") for (int k = 0; k < 2; ++k) \
      acc[ai][bj][m][n] = __builtin_amdgcn_mfma_f32_16x16x32_bf16(Bt_[n][k], At_[m][k], acc[ai][bj][m][n], 0, 0, 0); \
    __builtin_amdgcn_s_setprio(0); } while (0)
#define WAIT_V(n) asm volatile("s_waitcnt vmcnt(" #n ")" ::: "memory")
#define WAIT_L(n) asm volatile("s_waitcnt lgkmcnt(" #n ")" ::: "memory")
#define BAR __builtin_amdgcn_s_barrier()
#define SCHED __builtin_amdgcn_sched_barrier(0)
#pragma unroll
    for (int a = 0; a < 2; ++a)
#pragma unroll
        for (int b = 0; b < 2; ++b)
#pragma unroll
            for (int m = 0; m < 4; ++m)
#pragma unroll
                for (int n = 0; n < 2; ++n) acc[a][b][m][n] = (f32x4){0.f, 0.f, 0.f, 0.f};
    bf16x8 At[4][2], B0[2][2], B1[2][2];
    STAGE(SB(0, 0), cB, voffB); STAGE(SA(0, 0), cA, voffA); STAGE(SB(0, 1), cB + hstepB, voffB); STAGE(SA(0, 1), cA + hstepA, voffA);
    if (wr == 1) BAR;
    WAIT_V(4); BAR;
    STAGE(SB(1, 0), cB + kstep, voffB); STAGE(SA(1, 0), cA + kstep, voffA); STAGE(SB(1, 1), cB + hstepB + kstep, voffB);
    WAIT_V(6); BAR;
    for (int t = 0; t < nt - 2; t += 2) {
        const char* a1 = cA + (size_t)(t + 1) * kstep;
        const char* a2 = cA + (size_t)(t + 2) * kstep; const char* b2 = cB + (size_t)(t + 2) * kstep;
        const char* a3 = a2 + kstep; const char* b3 = b2 + kstep;
        LDB(B0, 0, 0); SCHED; LDA(At, 0, 0); STAGE(SA(1, 1), a1 + hstepA, voffA);
        WAIT_L(8); BAR; WAIT_L(0); MMA(0, 0, At, B0); BAR; SCHED;
        LDB(B1, 0, 1); STAGE(SB(0, 0), b2, voffB);
        BAR; WAIT_L(0); MMA(0, 1, At, B1); BAR;
        LDA(At, 0, 1); STAGE(SA(0, 0), a2, voffA);
        BAR; WAIT_L(0); MMA(1, 0, At, B0); BAR; SCHED;
        STAGE(SB(0, 1), b2 + hstepB, voffB);
        WAIT_V(6); BAR; MMA(1, 1, At, B1); BAR;
        LDB(B0, 1, 0); SCHED; LDA(At, 1, 0); STAGE(SA(0, 1), a2 + hstepA, voffA);
        WAIT_L(8); BAR; WAIT_L(0); MMA(0, 0, At, B0); BAR; SCHED;
        LDB(B1, 1, 1); STAGE(SB(1, 0), b3, voffB);
        BAR; WAIT_L(0); MMA(0, 1, At, B1); BAR;
        LDA(At, 1, 1); STAGE(SA(1, 0), a3, voffA);
        BAR; WAIT_L(0); MMA(1, 0, At, B0); BAR; SCHED;
        STAGE(SB(1, 1), b3 + hstepB, voffB);
        WAIT_V(6); BAR; MMA(1, 1, At, B1); BAR;
    }
    { const char* a1 = cA + (size_t)(nt - 1) * kstep;
      LDB(B0, 0, 0); LDA(At, 0, 0); STAGE(SA(1, 1), a1 + hstepA, voffA);
      BAR; WAIT_L(0); MMA(0, 0, At, B0); BAR;
      LDB(B1, 0, 1); BAR; WAIT_L(0); MMA(0, 1, At, B1); BAR;
      LDA(At, 0, 1); WAIT_V(4); BAR; WAIT_L(0); MMA(1, 0, At, B0); MMA(1, 1, At, B1); BAR; }
    { LDB(B0, 1, 0); LDA(At, 1, 0); WAIT_V(2); BAR; WAIT_L(0); MMA(0, 0, At, B0); BAR;
      LDB(B1, 1, 1); WAIT_V(0); BAR; WAIT_L(0); MMA(0, 1, At, B1); BAR;
      LDA(At, 1, 1); BAR; WAIT_L(0); MMA(1, 0, At, B0); MMA(1, 1, At, B1); BAR; }
    if (wr == 0) BAR;
#undef SA
#undef SB
#undef STAGE
#undef LDA
#undef LDB
#undef MMA
}

struct GemmJob {
    const bf16_t* A0; const bf16_t* A1; const bf16_t* Bt0; const bf16_t* Bt1;
    int lda, ldb, nN, nsplit, nt, kstride, mode, pad;
    void* o1; void* o2; const bf16_t* Z;
};
__device__ void phase_gemm(char* shm, const GemmJob& J) {
    const int tid = tid_l();
    const int wid = __builtin_amdgcn_readfirstlane(tid >> 6), wr = wid >> 2, wc = wid & 3;
    const int nM = 32, nN = J.nN, nMN = nM * nN;
    const int mode = J.mode;
    for (int u = blockIdx.x; u < nMN * J.nsplit; u += gridDim.x) {
        const int ks = u / nMN;
        int pm, pn; unit_map(u - ks * nMN, nM, nN, pm, pn);
        {
            const int sub = ks;
            f32x4 acc[2][2][4][2];
            const size_t koff = (size_t)ks * J.kstride;
            gemm_tile(shm, (ks ? J.A1 : J.A0) + koff, J.lda, (ks ? J.Bt1 : J.Bt0) + koff, J.ldb, pm * BM, pn * BM, J.nt, acc, tid);
            int lane_e = tid & 63; asm volatile("" : "+v"(lane_e));
            const int fr = lane_e & 15, fq = lane_e >> 4;
            const int NBJ = (mode == 0) ? 1 : 2;
            const int W8 = NBJ * 16;
            const int pitch = NBJ * 256 + 32;
            bf16_t* obase; int old_, col0;
            if (mode == 0)      { obase = (bf16_t*)J.o1; old_ = DFF; col0 = pn * 128; }
            else if (mode == 1) { obase = (bf16_t*)J.o1 + (size_t)ks * NTOK * DM; old_ = DM; col0 = pn * BM; }
            else if (mode == 2) { obase = (bf16_t*)J.o1; old_ = ZLD; col0 = pn * BM; }
            else                { obase = (bf16_t*)(sub ? J.o2 : J.o1); old_ = DM; col0 = pn * BM; }
            const bf16_t* Zg = J.Z + (sub ? 4608 : 3584);
#pragma unroll
            for (int ai = 0; ai < 2; ++ai) {
#pragma unroll
                for (int m = 0; m < 4; ++m) {
                    const int rloc = wr * 64 + m * 16 + fr;
                    const int row = pm * BM + ai * HALF + rloc;
#pragma unroll
                    for (int n = 0; n < 2; ++n) {
                        if (mode == 0) {
                            const f32x4 g = acc[ai][0][m][n], up = acc[ai][1][m][n];
                            float o[4];
#pragma unroll
                            for (int j = 0; j < 4; ++j) o[j] = g[j] * sigm(g[j]) * up[j];
                            u32x2 v; v[0] = pk_bf16(o[0], o[1]); v[1] = pk_bf16(o[2], o[3]);
                            *(u32x2*)(shm + rloc * pitch + (wc * 32 + n * 16 + fq * 4) * 2) = v;
                        } else {
#pragma unroll
                            for (int bj = 0; bj < 2; ++bj) {
                                const int cl = bj * HALF + wc * 32 + n * 16 + fq * 4;
                                f32x4 a = acc[ai][bj][m][n];
                                if (mode == 3) {
                                    const u32x2 gz = *(const u32x2*)(Zg + (size_t)row * ZLD + col0 + cl);
                                    a[0] *= sigm(bflo(gz[0])); a[1] *= sigm(bfhi(gz[0])); a[2] *= sigm(bflo(gz[1])); a[3] *= sigm(bfhi(gz[1]));
                                }
                                u32x2 v; v[0] = pk_bf16(a[0], a[1]); v[1] = pk_bf16(a[2], a[3]);
                                *(u32x2*)(shm + rloc * pitch + cl * 2) = v;
                            }
                        }
                    }
                }
                __syncthreads();
                const int w8sh = (mode == 0) ? 4 : 5;
                for (int c = tid; c < 128 * W8; c += NTHREADS) {
                    const int r = c >> w8sh, cc = c & (W8 - 1);
                    const u32x4 v = *(const u32x4*)(shm + r * pitch + cc * 16);
                    st_wt16(obase + (size_t)(pm * BM + ai * HALF + r) * old_ + col0 + cc * 8, v);
                }
                __syncthreads();
            }
        }
    }
}

__device__ void phase_prep(char* shm) {
    KParams* kp = kargs();
    const int tid = tid_l(), lane = tid & 63, wave = tid >> 6, fr = lane & 15, fq = lane >> 4;
    float* wt = (float*)shm + wave * (16 * 68);
    const bf16_t* Z = (const bf16_t*)(kp->ws + OFF_R1);
    const bf16_t* L2T = (const bf16_t*)(kp->ws + OFF_L2);
    bf16_t* KK = (bf16_t*)(kp->ws + OFF_R2 + R2_KK);
    float* WD = (float*)(kp->ws + OFF_R2 + R2_WD);
    bf16_t* KD = (bf16_t*)(kp->ws + OFF_R2 + R2_KD);
    bf16_t* BB = (bf16_t*)(kp->ws + OFF_R2 + R2_BB);
    float* BONUS = (float*)(kp->ws + OFF_BONUS);
    for (int unit = blockIdx.x * 8 + wave; unit < 2048; unit += gridDim.x * 8) {
        const int hq = unit & 1, d = (unit >> 1) & 1, tg = unit >> 2;
        const int row = tg * 16 + fr;
        const bool lat = row >= NCTX;
        const int pos = lat ? ((row - NCTX) & 2047) : (row & 255);
        const int T = lat ? 2048 : 256;
        const bool valid = d == 0 ? (pos > 0) : (pos < T - 1);
        const int srow = valid ? (d == 0 ? row - 1 : row + 1) : row;
        bf16x8 Bz[2][2];
#pragma unroll
        for (int l = 0; l < 2; ++l)
#pragma unroll
            for (int ks = 0; ks < 2; ++ks) {
                const int k = ks * 32 + fq * 8;
                const u32x4 Pv = *(const u32x4*)(Z + (size_t)row * ZLD + 5632 + ((d * 2 + l) * 2 + 0) * 64 + k);
                u32x4 Qv = *(const u32x4*)(Z + (size_t)srow * ZLD + 5632 + ((d * 2 + l) * 2 + 1) * 64 + k);
                if (!valid) Qv = (u32x4){0u, 0u, 0u, 0u};
                u32x4 o;
#pragma unroll
                for (int i = 0; i < 4; ++i) {
                    float z0 = bflo(Pv[i]) + bflo(Qv[i]), z1 = bfhi(Pv[i]) + bfhi(Qv[i]);
                    if (l == 0) {
                        z0 = 1.0f - 2.0f * __builtin_amdgcn_rcpf(__expf(2.0f * z0) + 1.0f);
                        z1 = 1.0f - 2.0f * __builtin_amdgcn_rcpf(__expf(2.0f * z1) + 1.0f);
                    }
                    o[i] = pk_bf16(z0, z1);
                }
                Bz[l][ks] = __builtin_bit_cast(bf16x8, o);
            }
        for (int hh = hq * 4; hh < hq * 4 + 4; ++hh) {
            f32x4 accw[4], acca[4];
#pragma unroll
            for (int mt = 0; mt < 4; ++mt) {
                accw[mt] = (f32x4){0.f, 0.f, 0.f, 0.f}; acca[mt] = (f32x4){0.f, 0.f, 0.f, 0.f};
#pragma unroll
                for (int ks = 0; ks < 2; ++ks) {
                    const bf16x8 Aw = *(const bf16x8*)(L2T + ((size_t)(d * 2 + 0) * 512 + hh * 64 + mt * 16 + fr) * 64 + ks * 32 + fq * 8);
                    const bf16x8 Aa = *(const bf16x8*)(L2T + ((size_t)(d * 2 + 1) * 512 + hh * 64 + mt * 16 + fr) * 64 + ks * 32 + fq * 8);
                    accw[mt] = __builtin_amdgcn_mfma_f32_16x16x32_bf16(Aw, Bz[0][ks], accw[mt], 0, 0, 0);
                    acca[mt] = __builtin_amdgcn_mfma_f32_16x16x32_bf16(Aa, Bz[1][ks], acca[mt], 0, 0, 0);
                }
            }
            float ss = 0.f, bon = 0.f;
            f32x4 kkr[4], kd[4];
#pragma unroll
            for (int mt = 0; mt < 4; ++mt) {
                const int c = hh * 64 + mt * 16 + fq * 4;
                const f32x4 w0 = *(const f32x4*)(kp->in[14] + d * 512 + c), a0 = *(const f32x4*)(kp->in[17] + d * 512 + c);
                const f32x4 kkp = *(const f32x4*)(kp->in[20] + c), kap = *(const f32x4*)(kp->in[21] + c), rkp = *(const f32x4*)(kp->in[22] + c);
                const u32x2 kz = *(const u32x2*)(Z + (size_t)row * ZLD + 512 + c), rz = *(const u32x2*)(Z + (size_t)row * ZLD + c);
                const float kv[4] = {bflo(kz[0]), bfhi(kz[0]), bflo(kz[1]), bfhi(kz[1])};
                const float rv[4] = {bflo(rz[0]), bfhi(rz[0]), bflo(rz[1]), bfhi(rz[1])};
#pragma unroll
                for (int j = 0; j < 4; ++j) {
                    const float xw = accw[mt][j] + w0[j];
                    accw[mt][j] = __expf(-0.60653065971f * sigm(xw));
                    const float a = sigm(acca[mt][j] + a0[j]);
                    acca[mt][j] = a;
                    const float kr = kv[j] * kkp[j];
                    kkr[mt][j] = kr; ss += kr * kr;
                    const float kdd = kv[j] * (1.0f + (a - 1.0f) * kap[j]);
                    kd[mt][j] = kdd;
                    bon += rv[j] * kdd * rkp[j];
                }
            }
            ss += __shfl_xor(ss, 16); ss += __shfl_xor(ss, 32);
            bon += __shfl_xor(bon, 16); bon += __shfl_xor(bon, 32);
            const float inv = rsqrtf(ss + 1e-12f);
            const int row0 = tg * 16;
#pragma unroll
            for (int pass = 0; pass < 4; ++pass) {
                if (pass == 3 && d != 0) break;
#pragma unroll
                for (int mt = 0; mt < 4; ++mt) {
                    f32x4 val;
                    if (pass == 0) val = accw[mt];
                    else if (pass == 1) val = kd[mt];
                    else if (pass == 2) val = kkr[mt] * inv * acca[mt];
                    else val = kkr[mt] * inv;
                    *(f32x4*)(wt + fr * 68 + mt * 16 + fq * 4) = val;
                }
                asm volatile("s_waitcnt lgkmcnt(0)" ::: "memory");
#pragma unroll
                for (int i = 0; i < 4; ++i) {
                    const int id = i * 64 + lane, tk = id >> 4, c4 = (id & 15) * 4;
                    const f32x4 val = *(const f32x4*)(wt + tk * 68 + c4);
                    const size_t o = ((size_t)d * NTOK + row0 + tk) * DR + hh * 64 + c4;
                    if (pass == 0) *(f32x4*)(WD + o) = val;
                    else {
                        u32x2 v; v[0] = pk_bf16(val[0], val[1]); v[1] = pk_bf16(val[2], val[3]);
                        if (pass == 1) *(u32x2*)(KD + o) = v;
                        else if (pass == 2) *(u32x2*)(BB + o) = v;
                        else *(u32x2*)(KK + (size_t)(row0 + tk) * DR + hh * 64 + c4) = v;
                    }
                }
                asm volatile("s_waitcnt lgkmcnt(0)" ::: "memory");
            }
            if (fq == 0) BONUS[((size_t)d * NTOK + row) * 8 + hh] = bon;
        }
    }
}

__device__ __forceinline__ float red16x4(float p0, float p1, float p2, float p3, const bool b0, const bool b1) {
    const float own01 = b0 ? p1 : p0, snd01 = b0 ? p0 : p1;
    const float own23 = b0 ? p3 : p2, snd23 = b0 ? p2 : p3;
    const float r01 = own01 + dppf<0xB1>(snd01);
    const float r23 = own23 + dppf<0xB1>(snd23);
    const float own = b1 ? r23 : r01, snd = b1 ? r01 : r23;
    float r = own + dppf<0x4E>(snd);
    r += dppf<0x124>(r);
    r += dppf<0x128>(r);
    return r;
}
constexpr int TC = 32, STEP_F = 352;
typedef float f32x2 __attribute__((ext_vector_type(2)));
constexpr int SCAN_IN_F = TC * STEP_F;
constexpr int SCAN_Y_OFF = 2 * SCAN_IN_F;
constexpr int SCAN_VT_OFF = SCAN_Y_OFF + 2 * TC * 32;
struct ChunkDesc { int base, T, d, h, rq, c, b; bool first, last; };
template <bool LAT> __device__ __forceinline__ ChunkDesc chunk_desc(int slot, int g) {
    ChunkDesc q;
    if (LAT) {
        const int chain = slot >> 2; q.rq = slot & 3; q.b = chain >> 4; q.h = (chain >> 1) & 7; q.d = chain & 1;
        q.T = 2048; q.base = NCTX + q.b * 2048; q.c = g; q.first = g == 0; q.last = false;
    } else {
        const int u = slot * 4 + (g >> 3), chain = u >> 1; q.rq = u & 1; q.b = chain >> 4; q.h = (chain >> 1) & 7; q.d = chain & 1;
        q.T = 256; q.base = q.b * 256; q.c = g & 7; q.first = q.c == 0; q.last = q.c == 7;
    }
    return q;
}
__device__ __forceinline__ void st4(float* dst, unsigned a, unsigned b) {
    *(f32x4*)dst = (f32x4){bflo(a), bfhi(a), bflo(b), bfhi(b)};
}
struct LReg { u32x4 r8, k8, kk8, b8, v8; f32x4 w0, w1; };

template <bool LAT> __device__ __forceinline__ void scan_pass(char* shm, const int tid, const int slot) {
    constexpr int NSW = 4, RPL = LAT ? 1 : 2, RB = NSW * 4 * RPL, NCH = LAT ? 64 : 32;
    KParams* kp = kargs();
    float* lds = (float*)shm;
    const int wave = __builtin_amdgcn_readfirstlane(tid >> 6), lane = tid & 63;
    const bf16_t* Z = (const bf16_t*)(kp->ws + OFF_R1);
    const bf16_t* KK = (const bf16_t*)(kp->ws + OFF_R2 + R2_KK);
    const float* WD = (const float*)(kp->ws + OFF_R2 + R2_WD);
    const bf16_t* KD = (const bf16_t*)(kp->ws + OFF_R2 + R2_KD);
    const bf16_t* BB = (const bf16_t*)(kp->ws + OFF_R2 + R2_BB);
    bf16_t* Y = (bf16_t*)(kp->ws + OFF_H);
    float* OST = kp->out + (size_t)NTOK * DM;
    const float* ST0 = kp->in[3];
    {
        if (wave >= 4) {
            const int lt = tid - 256, s = lt >> 3, cg8 = (lt & 7) * 8;
            constexpr int NV = TC * RB / 8;
            LReg R;
            auto ld_chunk = [&](int g) {
                const ChunkDesc q = chunk_desc<LAT>(slot, g);
                const int tt = q.c * TC + s, t = q.d ? q.T - 1 - tt : tt, row = q.base + t;
                const int ch = q.h * 64 + cg8;
                const size_t od = ((size_t)q.d * NTOK + row) * DR + ch;
                R.r8 = *(const u32x4*)(Z + (size_t)row * ZLD + ch);
                R.w0 = *(const f32x4*)(WD + od); R.w1 = *(const f32x4*)(WD + od + 4);
                R.k8 = *(const u32x4*)(KD + od);
                R.kk8 = *(const u32x4*)(KK + (size_t)row * DR + ch);
                R.b8 = *(const u32x4*)(BB + od);
                if (lt < NV) {
                    const int s2 = lt / (RB / 8), hf = lt % (RB / 8);
                    const int tt2 = q.c * TC + s2, t2 = q.d ? q.T - 1 - tt2 : tt2, row2 = q.base + t2;
                    R.v8 = *(const u32x4*)(Z + (size_t)row2 * ZLD + 1024 + q.h * 64 + q.rq * RB + hf * 8);
                }
            };
            ld_chunk(0);
            for (int g = -1; g <= NCH; ++g) {
                if (g + 1 <= NCH - 1) {
                    float* buf = lds + ((g + 1) & 1) * SCAN_IN_F;
                    float* L = buf + s * STEP_F + cg8;
                    st4(L, R.r8[0], R.r8[1]); st4(L + 4, R.r8[2], R.r8[3]);
                    *(f32x4*)(L + 64) = R.w0; *(f32x4*)(L + 68) = R.w1;
                    st4(L + 128, R.k8[0], R.k8[1]); st4(L + 132, R.k8[2], R.k8[3]);
                    st4(L + 192, R.kk8[0], R.kk8[1]); st4(L + 196, R.kk8[2], R.kk8[3]);
                    st4(L + 256, R.b8[0], R.b8[1]); st4(L + 260, R.b8[2], R.b8[3]);
                    if (lt < NV) {
                        const int s2 = lt / (RB / 8), hf = lt % (RB / 8);
                        float* Vt = lds + SCAN_VT_OFF + ((g + 1) & 1) * (32 * TC) + (hf * 8) * TC + s2;
#pragma unroll
                        for (int i = 0; i < 4; ++i) { Vt[(2 * i) * TC] = bflo(R.v8[i]); Vt[(2 * i + 1) * TC] = bfhi(R.v8[i]); }
                    }
                }
                if (g + 2 <= NCH - 1) ld_chunk(g + 2);
                if (g >= 1) {
                    const ChunkDesc q = chunk_desc<LAT>(slot, g - 1);
                    const float* yb = lds + SCAN_Y_OFF + ((g - 1) & 1) * (TC * RB);
#pragma unroll
                    for (int i = lt; i < TC * RB / 2; i += 256) {
                        const int sy = i / (RB / 2), r2 = (i % (RB / 2)) * 2;
                        const int tt = q.c * TC + sy, t = q.d ? q.T - 1 - tt : tt, row = q.base + t;
                        const f32x2 yv = *(const f32x2*)(yb + sy * RB + r2);
                        *(unsigned*)(Y + ((size_t)q.d * NTOK + row) * DR + q.h * 64 + q.rq * RB + r2) = pk_bf16(yv[0], yv[1]);
                    }
                }
                __syncthreads();
            }
        } else if (wave < NSW) {
            const int rl = lane >> 4, qq = lane & 15;
            f32x2 Sa[RPL], Sb[RPL];
#pragma unroll
            for (int j = 0; j < RPL; ++j) { Sa[j] = (f32x2){0.f, 0.f}; Sb[j] = (f32x2){0.f, 0.f}; }
            __syncthreads();
            for (int g = 0; g <= NCH - 1; ++g) {
                const ChunkDesc q = chunk_desc<LAT>(slot, g);
                const float* buf = lds + (g & 1) * SCAN_IN_F;
                const int rloc = wave * RPL * 4 + rl;
                float* yb = lds + SCAN_Y_OFF + (g & 1) * (TC * RB) + rloc;
                if (q.first) {
#pragma unroll
                    for (int j = 0; j < RPL; ++j) {
                        if (LAT) {
                            const int irow = q.rq * RB + rloc + 4 * j;
                            const f32x4 s = *(const f32x4*)(ST0 + ((size_t)((q.b * 2 + q.d) * 8 + q.h) * 64 + irow) * 64 + qq * 4);
                            Sa[j] = (f32x2){s[0], s[1]}; Sb[j] = (f32x2){s[2], s[3]};
                        } else { Sa[j] = (f32x2){0.f, 0.f}; Sb[j] = (f32x2){0.f, 0.f}; }
                    }
                }
                const float* Lq = buf + qq * 4;
                const float* Lv = lds + SCAN_VT_OFF + (g & 1) * (32 * TC) + rloc * TC;
                f32x4 r4 = *(const f32x4*)(Lq), w4 = *(const f32x4*)(Lq + 64), k4 = *(const f32x4*)(Lq + 128), n4 = *(const f32x4*)(Lq + 192), b4 = *(const f32x4*)(Lq + 256);
                f32x4 r4n = *(const f32x4*)(Lq + STEP_F), w4n = *(const f32x4*)(Lq + STEP_F + 64), k4n = *(const f32x4*)(Lq + STEP_F + 128), n4n = *(const f32x4*)(Lq + STEP_F + 192), b4n = *(const f32x4*)(Lq + STEP_F + 256);
                f32x4 v4[RPL], v4n[RPL], v4m[RPL];
                float yp[RPL][4];
                const bool qb0 = (qq & 1) != 0, qb1 = (qq & 2) != 0;
                float* ybq = yb + (qq & 3) * RB;
#pragma unroll
                for (int j = 0; j < RPL; ++j) { v4[j] = *(const f32x4*)(Lv + 4 * j * TC); v4n[j] = *(const f32x4*)(Lv + 4 * j * TC + 4); }
#pragma unroll
                for (int s = 0; s < TC; ++s) {
                    const int s2 = (s + 2 < TC) ? s + 2 : TC - 1;
                    const float* Ln = Lq + s2 * STEP_F;
                    const f32x4 r4m = *(const f32x4*)(Ln), w4m = *(const f32x4*)(Ln + 64), k4m = *(const f32x4*)(Ln + 128), n4m = *(const f32x4*)(Ln + 192), b4m = *(const f32x4*)(Ln + 256);
                    if ((s & 3) == 0) {
                        const int sg = (s + 8 < TC) ? s + 8 : TC - 4;
#pragma unroll
                        for (int j = 0; j < RPL; ++j) v4m[j] = *(const f32x4*)(Lv + 4 * j * TC + sg);
                    }
#pragma unroll
                    for (int j = 0; j < RPL; ++j) {
                        f32x2 pp = Sa[j] * (f32x2){n4[0], n4[1]};
                        pp = Sb[j] * (f32x2){n4[2], n4[3]} + pp;
                        float pd = pp[0] + pp[1];
                        const float vj = v4[j][s & 3];
                        const f32x2 vv = {vj, vj};
                        f32x2 Ta = (f32x2){k4[0], k4[1]} * vv, Tb = (f32x2){k4[2], k4[3]} * vv;
                        Ta = Sa[j] * (f32x2){w4[0], w4[1]} + Ta; Tb = Sb[j] * (f32x2){w4[2], w4[3]} + Tb;
                        pd = red16(pd);
                        const f32x2 np = {-pd, -pd};
                        Sa[j] = (f32x2){b4[0], b4[1]} * np + Ta; Sb[j] = (f32x2){b4[2], b4[3]} * np + Tb;
                        f32x2 yy = Sa[j] * (f32x2){r4[0], r4[1]};
                        yy = Sb[j] * (f32x2){r4[2], r4[3]} + yy;
                        yp[j][s & 3] = yy[0] + yy[1];
                        if ((s & 3) == 3) ybq[(s - 3) * RB + 4 * j] = red16x4(yp[j][0], yp[j][1], yp[j][2], yp[j][3], qb0, qb1);
                    }
                    r4 = r4n; w4 = w4n; k4 = k4n; n4 = n4n; b4 = b4n;
                    r4n = r4m; w4n = w4m; k4n = k4m; n4n = n4m; b4n = b4m;
#pragma unroll
                    for (int j = 0; j < RPL; ++j) { if ((s & 3) == 3) { v4[j] = v4n[j]; v4n[j] = v4m[j]; } }
                }
                if (!LAT && q.last) {
#pragma unroll
                    for (int j = 0; j < RPL; ++j) {
                        const int irow = q.rq * RB + rloc + 4 * j;
                        *(f32x4*)(OST + ((size_t)((q.b * 2 + q.d) * 8 + q.h) * 64 + irow) * 64 + qq * 4) = (f32x4){Sa[j][0], Sa[j][1], Sb[j][0], Sb[j][1]};
                    }
                }
                __syncthreads();
            }
            __syncthreads();
        } else {
            for (int g = -1; g <= NCH; ++g) __syncthreads();
        }
    }
}
__device__ void phase_scan(char* shm) {
    const int tid = tid_l();
    for (int slot = blockIdx.x; slot < 256; slot += gridDim.x) {
        if (slot < 128) scan_pass<true>(shm, tid, slot);
        else scan_pass<false>(shm, tid, slot - 128);
        __syncthreads();
    }
}

__device__ void phase_post() {
    KParams* kp = kargs();
    const int tid = tid_l(), lane = tid & 63, wave = tid >> 6;
    const bf16_t* Z = (const bf16_t*)(kp->ws + OFF_R1);
    const bf16_t* Y = (const bf16_t*)(kp->ws + OFF_H);
    const float* BONUS = (const float*)(kp->ws + OFF_BONUS);
    bf16_t* YA = (bf16_t*)(kp->ws + OFF_R2 + R2_YA);
    bf16_t* YB = (bf16_t*)(kp->ws + OFF_R2 + R2_YB);
    const int c = lane * 8, head = lane >> 3;
    for (int row = blockIdx.x * 8 + wave; row < NTOK; row += gridDim.x * 8) {
        const u32x4 y0 = *(const u32x4*)(Y + (size_t)row * DR + c), y1 = *(const u32x4*)(Y + ((size_t)NTOK + row) * DR + c);
        float y[8];
#pragma unroll
        for (int i = 0; i < 4; ++i) { y[2 * i] = bflo(y0[i]) + bflo(y1[i]); y[2 * i + 1] = bfhi(y0[i]) + bfhi(y1[i]); }
        float s = 0.f;
#pragma unroll
        for (int i = 0; i < 8; ++i) s += y[i];
        s += __shfl_xor(s, 1); s += __shfl_xor(s, 2); s += __shfl_xor(s, 4);
        const float mean = s * (1.0f / 64.0f);
        float vs = 0.f;
#pragma unroll
        for (int i = 0; i < 8; ++i) { y[i] -= mean; vs += y[i] * y[i]; }
        vs += __shfl_xor(vs, 1); vs += __shfl_xor(vs, 2); vs += __shfl_xor(vs, 4);
        const float rs = rsqrtf(vs * (1.0f / 64.0f) + 64e-5f);
        const float bon = BONUS[(size_t)row * 8 + head] + BONUS[((size_t)NTOK + row) * 8 + head];
        const u32x4 vz = *(const u32x4*)(Z + (size_t)row * ZLD + 1024 + c), gz = *(const u32x4*)(Z + (size_t)row * ZLD + 1536 + c);
        const f32x4 gn0 = *(const f32x4*)(kp->in[23] + c), gn1 = *(const f32x4*)(kp->in[23] + c + 4);
        const f32x4 gb0 = *(const f32x4*)(kp->in[24] + c), gb1 = *(const f32x4*)(kp->in[24] + c + 4);
        float o[8];
#pragma unroll
        for (int i = 0; i < 8; ++i) {
            const float vv = (i & 1) ? bfhi(vz[i >> 1]) : bflo(vz[i >> 1]);
            const float gg = (i & 1) ? bfhi(gz[i >> 1]) : bflo(gz[i >> 1]);
            const float gain = i < 4 ? gn0[i & 3] : gn1[i & 3], bias = i < 4 ? gb0[i & 3] : gb1[i & 3];
            o[i] = (y[i] * rs * gain + bias + bon * vv) * sigm(gg);
        }
        u32x4 ov;
#pragma unroll
        for (int i = 0; i < 4; ++i) ov[i] = pk_bf16(o[2 * i], o[2 * i + 1]);
        *(u32x4*)(YA + (size_t)row * DR + c) = ov;
    }
}

__device__ void phase_convb(int gw, int nw) {
    KParams* kp = kargs();
    const int tid = tid_l(), lane = tid & 63;
    const bf16_t* Z = (const bf16_t*)(kp->ws + OFF_R1);
    bf16_t* YB = (bf16_t*)(kp->ws + OFF_YB2);
    const int c = lane * 8;
    for (int row = gw; row < NTOK; row += nw) {
        float o[8]; u32x4 ov;
        const bool lat = row >= NCTX;
        const int pos = lat ? ((row - NCTX) & 63) : (row & 255);
        const int last = lat ? 63 : 255;
        const bool vl = pos > 0, vr = pos < last;
        const int rl = vl ? row - 1 : row, rr = vr ? row + 1 : row;
        const u32x4 ccm = *(const u32x4*)(Z + (size_t)row * ZLD + 2560 + c), xcm = *(const u32x4*)(Z + (size_t)row * ZLD + 3072 + c);
        const u32x4 ccl = *(const u32x4*)(Z + (size_t)rl * ZLD + 2560 + c), xcl = *(const u32x4*)(Z + (size_t)rl * ZLD + 3072 + c);
        const u32x4 ccr = *(const u32x4*)(Z + (size_t)rr * ZLD + 2560 + c), xcr = *(const u32x4*)(Z + (size_t)rr * ZLD + 3072 + c);
        const u32x4 cbz = *(const u32x4*)(Z + (size_t)row * ZLD + 2048 + c);
        const float fl = vl ? 1.f : 0.f, frr = vr ? 1.f : 0.f;
#pragma unroll
        for (int i = 0; i < 8; ++i) {
            const int w = i >> 1; const bool hi = i & 1;
            const float um = (hi ? bfhi(ccm[w]) : bflo(ccm[w])) * (hi ? bfhi(xcm[w]) : bflo(xcm[w]));
            const float ul = (hi ? bfhi(ccl[w]) : bflo(ccl[w])) * (hi ? bfhi(xcl[w]) : bflo(xcl[w])) * fl;
            const float ur = (hi ? bfhi(ccr[w]) : bflo(ccr[w])) * (hi ? bfhi(xcr[w]) : bflo(xcr[w])) * frr;
            const float cb = hi ? bfhi(cbz[w]) : bflo(cbz[w]);
            const float cv = ul * kp->in[25][c + i] + um * kp->in[25][512 + c + i] + ur * kp->in[25][1024 + c + i] + kp->in[26][c + i];
            o[i] = cb * cv;
        }
#pragma unroll
        for (int i = 0; i < 4; ++i) ov[i] = pk_bf16(o[2 * i], o[2 * i + 1]);
        *(u32x4*)(YB + (size_t)row * DR + c) = ov;
    }
}

#define XB_TMO      128
#define XB_XCNT(j)  (256  + 64 * (j))
#define XB_XSUB(j)  (1280 + 64 * (j))
#define XB_XGEN(j)  (2304 + 64 * (j))
#define XB_TOP      3328
#define XB_TOPGEN   3392
#define XCD_BAR_WORDS 3456
#define XB_SPIN_CAP (1u << 18)
#define XLAS __attribute__((address_space(3)))
__device__ __forceinline__ unsigned xb_ld(unsigned* p)              { return __hip_atomic_load(p, __ATOMIC_RELAXED, __HIP_MEMORY_SCOPE_AGENT); }
__device__ __forceinline__ unsigned xb_add(unsigned* p, unsigned v) { return __hip_atomic_fetch_add(p, v, __ATOMIC_RELAXED, __HIP_MEMORY_SCOPE_AGENT); }
__device__ __forceinline__ unsigned xb_xcc_id() { return (unsigned)__builtin_amdgcn_s_getreg((3 << 11) | 20) & 0xFu; }
#define XB_SPIN(cond, bar) do { unsigned _sp = 0; while (cond) { __builtin_amdgcn_s_sleep(1); \
    if ((++_sp & 255u) == 0u) { if (xb_ld(&(bar)[XB_TMO])) break; if (_sp > XB_SPIN_CAP) { atomicAdd(&(bar)[XB_TMO], 1u); break; } } } } while (0)
struct XcdBarrier { unsigned* bar; unsigned x; volatile XLAS unsigned* st; };
__device__ __forceinline__ XcdBarrier xcd_barrier_post(unsigned* bar, volatile XLAS unsigned* st) {
    XcdBarrier b; b.bar = bar; b.x = xb_xcc_id(); b.st = st;
    if (threadIdx.x == 0) (void)xb_add(&bar[XB_XCNT(b.x)], 1u);
    return b;
}
__device__ __forceinline__ void xcd_barrier_complete(unsigned* bar, unsigned x, unsigned& nloc, unsigned& nx) {
    const unsigned G = gridDim.x * gridDim.y * gridDim.z;
    unsigned sum, cnt, mine, sp = 0u;
    for (;;) {
        sum = 0u; cnt = 0u; mine = 0u;
#pragma unroll
        for (unsigned j = 0; j < 16; ++j) { const unsigned c = xb_ld(&bar[XB_XCNT(j)]); sum += c; cnt += (c > 0u) ? 1u : 0u; mine = (j == x) ? c : mine; }
        if (sum == G) break;
        __builtin_amdgcn_s_sleep(1);
        if ((++sp & 255u) == 0u) { if (xb_ld(&bar[XB_TMO])) break; if (sp > XB_SPIN_CAP) { atomicAdd(&bar[XB_TMO], 1u); break; } }
    }
    nloc = mine > 0u ? mine : 1u; nx = cnt > 0u ? cnt : 1u;
}
__device__ __forceinline__ void xcd_barrier(const XcdBarrier& b) {
    asm volatile("s_waitcnt vmcnt(0)" ::: "memory");
    __syncthreads();
    if (threadIdx.x == 0) {
        unsigned* bar = b.bar;
        __builtin_amdgcn_s_waitcnt(0);
        unsigned nloc = b.st[0], nx = b.st[1];
        if (nloc == 0u) { xcd_barrier_complete(bar, b.x, nloc, nx); b.st[0] = nloc; b.st[1] = nx; }
        const unsigned old = xb_add(&bar[XB_XSUB(b.x)], 1u);
        const unsigned gen = old / nloc;
        if (old + 1u == (gen + 1u) * nloc) {
            __builtin_amdgcn_fence(__ATOMIC_RELEASE, "agent");
            asm volatile("s_waitcnt vmcnt(0)" ::: "memory");
            const unsigned og = xb_add(&bar[XB_TOP], 1u);
            const unsigned tg = og / nx;
            if (og + 1u == (tg + 1u) * nx) xb_add(&bar[XB_TOPGEN], 1u);
            else XB_SPIN(xb_ld(&bar[XB_TOPGEN]) == tg, bar);
            __builtin_amdgcn_fence(__ATOMIC_ACQUIRE, "agent");
            xb_add(&bar[XB_XGEN(b.x)], 1u);
            asm volatile("s_waitcnt vmcnt(0)" ::: "memory");
        } else {
            XB_SPIN(xb_ld(&bar[XB_XGEN(b.x)]) == gen, bar);
            __builtin_amdgcn_fence(__ATOMIC_ACQUIRE, "agent");
            asm volatile("s_waitcnt vmcnt(0)" ::: "memory");
        }
    }
    __syncthreads();
}

struct RowJob { const float* xc; const float* xl; const bf16_t* P; float* xdst; bf16_t* hdst; int gA, mGate, gB, mShift, mScale; float sA; };

__global__ void __launch_bounds__(NTHREADS) fwd_megakernel(Params p) {
    extern __shared__ __attribute__((aligned(16))) char shm[];
    volatile XLAS unsigned* st = (volatile XLAS unsigned*)((XLAS unsigned char*)shm + LDS_STAGE);
    if (threadIdx.x < 4) st[threadIdx.x] = 0u;
    __syncthreads();
    const XcdBarrier xb = xcd_barrier_post((unsigned*)(kargs()->ws + OFF_BAR), st);
    const int ph_lo = kargs()->phase_lo, ph_hi = kargs()->phase_hi;
    for (int ph = ph_lo; ph < ph_hi; ++ph) {
        KParams* kp0 = kargs();
        char* ws = kp0->ws;
        bf16_t* H = (bf16_t*)(ws + OFF_H);
        bf16_t* R1 = (bf16_t*)(ws + OFF_R1);
        float* R2f = (float*)(ws + OFF_R2);
        float* out = kp0->out;
        const float* xlat_out = out + (size_t)NCTX * DM;
        int kind = 0;
        int cv_set = -1, cv_first = 0;
        RowJob R{}; GemmJob J{};
        switch (ph) {
        case 1: kind = 1; R = RowJob{kargs()->in[0], kargs()->in[1], nullptr, nullptr, H, 0, 0, 0, 0, 1, 0.f}; break;
        case 4: kind = 1; R = RowJob{kargs()->in[0], kargs()->in[1], (const bf16_t*)R2f, out, H, 1, 2, 2, 3, 4, 0.5f}; break;
        case 11: kind = 1; R = RowJob{out, xlat_out, (const bf16_t*)R1, out, H, 3, 5, 4, 6, 7, 1.0f}; break;
        case 14: kind = 1; R = RowJob{out, xlat_out, (const bf16_t*)R2f, out, nullptr, 5, 8, 0, 0, 0, 0.5f}; break;
        case 2: case 12: kind = 2;
            J.A0 = J.A1 = H; J.Bt0 = J.Bt1 = (const bf16_t*)(ws + (ph == 2 ? OFF_W13A : OFF_W13B)); J.lda = DM; J.ldb = DM; J.nN = 22; J.nsplit = 1; J.nt = DM / BK; J.kstride = 0; J.mode = 0; J.o1 = R1; break;
        case 3: case 13: kind = 2;
            J.A0 = J.A1 = R1; J.Bt0 = J.Bt1 = (const bf16_t*)(ws + (ph == 3 ? OFF_W2A : OFF_W2B)); J.lda = DFF; J.ldb = DFF; J.nN = 4; J.nsplit = 2; J.nt = 22; J.kstride = 22 * BK; J.mode = 1; J.o1 = R2f; break;
        case 5: kind = 2;
            J.A0 = J.A1 = H; J.Bt0 = J.Bt1 = (const bf16_t*)(ws + OFF_WIN); J.lda = DM; J.ldb = DM; J.nN = 24; J.nsplit = 1; J.nt = DM / BK; J.kstride = 0; J.mode = 2; J.o1 = R1; break;
        case 9: kind = 2;
            J.A0 = (const bf16_t*)(ws + OFF_R2 + R2_YA); J.A1 = (const bf16_t*)(ws + OFF_YB2); J.Bt0 = (const bf16_t*)(ws + OFF_WA); J.Bt1 = (const bf16_t*)(ws + OFF_WB);
            J.lda = DR; J.ldb = DR; J.nN = 4; J.nsplit = 2; J.nt = DR / BK; J.kstride = 0; J.mode = 3; J.o1 = ws + OFF_R2 + R2_GA; J.o2 = ws + OFF_R2 + R2_GB; J.Z = R1; break;
        case 10: kind = 2;
            J.A0 = (const bf16_t*)(ws + OFF_R2 + R2_GA); J.A1 = (const bf16_t*)(ws + OFF_R2 + R2_GB); J.Bt0 = J.Bt1 = (const bf16_t*)(ws + OFF_WO); J.lda = DM; J.ldb = DM; J.nN = 4; J.nsplit = 2; J.nt = DM / BK; J.kstride = 0; J.mode = 1; J.o1 = R1; break;
        default: break;
        }
        for (int rep = 0; rep <= ((REPEAT_MASK >> ph) & 1); ++rep) {
        if (rep) xcd_barrier(xb);
        if (kind == 1) phase_rowop(R.xc, R.xl, R.P, R.gA, R.mGate, R.sA, R.xdst, R.gB, R.mShift, R.mScale, R.hdst);
        else if (kind == 2) phase_gemm(shm, J);
        else if (ph == 0) { phase_convert(shm); cv_set = 0; cv_first = 0; }
        else if (ph == 6) phase_prep(shm);
        else if (ph == 7) { phase_scan(shm); cv_set = 1; cv_first = ((int)gridDim.x == 256) ? 128 : 0; }
        else if (ph == 8) phase_post();
        }
        if (cv_set >= 0 && (int)blockIdx.x >= cv_first)
            convert_tiles(shm, cv_set, ((int)blockIdx.x - cv_first) * 8 + (int)(threadIdx.x >> 6), ((int)gridDim.x - cv_first) * 8);
        if (ph == 7 && (int)blockIdx.x >= cv_first)
            phase_convb(((int)blockIdx.x - cv_first) * 8 + (int)(threadIdx.x >> 6), ((int)gridDim.x - cv_first) * 8);
        if (ph + 1 < ph_hi) xcd_barrier(xb);
    }
}

extern "C" void kernel_launch(void* const* d_in, const int* in_sizes, int n_in, void* d_out, int out_size, void* d_ws, size_t ws_size, hipStream_t stream) {
    static int grid_blocks = 0;
    if (grid_blocks == 0) {
        if (ws_size < WS_END) { fprintf(stderr, "kernel_launch: workspace too small: %zu < %zu\n", ws_size, (size_t)WS_END); grid_blocks = -1; return; }
        int dev = 0, cus = 0, per_cu = 0;
        hipGetDevice(&dev);
        hipDeviceGetAttribute(&cus, hipDeviceAttributeMultiprocessorCount, dev);
        if (hipFuncSetAttribute((const void*)fwd_megakernel, hipFuncAttributeMaxDynamicSharedMemorySize, LDS_BYTES) != hipSuccess) { fprintf(stderr, "hipFuncSetAttribute failed\n"); grid_blocks = -1; return; }
        hipOccupancyMaxActiveBlocksPerMultiprocessor(&per_cu, (const void*)fwd_megakernel, NTHREADS, LDS_BYTES);
        if (per_cu < 1) { fprintf(stderr, "occupancy query says %d\n", per_cu); per_cu = 1; }
        if (per_cu > 1) per_cu = 1;
        grid_blocks = cus * per_cu;
    }
    if (grid_blocks < 0) return;
    Params p{};
    for (int i = 0; i < 30; ++i) p.in[i] = (const float*)d_in[i];
    p.out = (float*)d_out; p.ws = (char*)d_ws; p.phase_lo = 0; p.phase_hi = 15;
    if (hipMemsetAsync((char*)d_ws + OFF_BAR, 0, 16384, stream) != hipSuccess) { fprintf(stderr, "memset of barrier words failed\n"); return; }
    void* args[] = {&p};
    hipError_t e = hipLaunchCooperativeKernel((const void*)fwd_megakernel, dim3(grid_blocks), dim3(NTHREADS), args, LDS_BYTES, stream);
    if (e != hipSuccess) fprintf(stderr, "cooperative launch failed: %s (grid %d)\n", hipGetErrorString(e), grid_blocks);
}
```

```cpp
#include <hip/hip_runtime.h>
#include <hip/hip_cooperative_groups.h>
#include <cstdio>
namespace cg = cooperative_groups;

typedef unsigned short bf16_t;
typedef short bf16x8 __attribute__((ext_vector_type(8)));
typedef float f32x4 __attribute__((ext_vector_type(4)));
typedef unsigned u32x4 __attribute__((ext_vector_type(4)));
typedef unsigned u32x2 __attribute__((ext_vector_type(2)));

constexpr int DM = 1024, NTOK = 8192, NCTX = 4096, DFF = 2816, NIN = 6144, ZLD = 6144, DR = 512;
constexpr int NTHREADS = 512;
#define REPEAT_MASK 0
constexpr int LDS_STAGE = 131072;
constexpr int LDS_BYTES = LDS_STAGE + 16;

constexpr size_t SZ_W13 = (size_t)5632 * 1024 * 2, SZ_W2 = (size_t)1024 * 2816 * 2;
constexpr size_t OFF_W13A = 0;
constexpr size_t OFF_W2A = OFF_W13A + SZ_W13;
constexpr size_t OFF_W13B = OFF_W2A + SZ_W2;
constexpr size_t OFF_W2B = OFF_W13B + SZ_W13;
constexpr size_t OFF_WIN = OFF_W2B + SZ_W2;
constexpr size_t OFF_WA = OFF_WIN + (size_t)6144 * 1024 * 2;
constexpr size_t OFF_WB = OFF_WA + (size_t)1024 * 512 * 2;
constexpr size_t OFF_WO = OFF_WB + (size_t)1024 * 512 * 2;
constexpr size_t OFF_L2 = OFF_WO + (size_t)1024 * 1024 * 2;
constexpr size_t OFF_MOD = OFF_L2 + (size_t)4 * 512 * 64 * 2;
constexpr size_t OFF_BONUS = OFF_MOD + (size_t)2 * 3 * 9216 * 4;
constexpr size_t OFF_H = OFF_BONUS + (size_t)2 * 8192 * 8 * 4;
constexpr size_t OFF_R1 = OFF_H + (size_t)8192 * 1024 * 2;
constexpr size_t OFF_R2 = OFF_R1 + (size_t)8192 * 6144 * 2;
constexpr size_t OFF_BAR = OFF_R2 + (size_t)72 * 1024 * 1024;
constexpr size_t OFF_YB2 = OFF_BAR + 16384;
constexpr size_t WS_END = OFF_YB2 + (size_t)8192 * 512 * 2;
constexpr size_t R2_KK = 0;
constexpr size_t R2_WD = R2_KK + (size_t)8192 * 512 * 2;
constexpr size_t R2_KD = R2_WD + (size_t)2 * 8192 * 512 * 4;
constexpr size_t R2_BB = R2_KD + (size_t)2 * 8192 * 512 * 2;
constexpr size_t R2_YA = 0;
constexpr size_t R2_YB = R2_YA + (size_t)8192 * 512 * 2;
constexpr size_t R2_GA = R2_YB + (size_t)8192 * 512 * 2;
constexpr size_t R2_GB = R2_GA + (size_t)8192 * 1024 * 2;

struct Params {
    const float* in[30];
    float* out;
    char* ws;
    int phase_lo, phase_hi;
};


typedef const __attribute__((address_space(4))) Params KParams;
__device__ __forceinline__ KParams* kargs() {
    KParams* k = (KParams*)__builtin_amdgcn_kernarg_segment_ptr();
    asm volatile("" : "+s"(k));
    return k;
}

__device__ __forceinline__ int tid_l() { int t = threadIdx.x; asm volatile("" : "+v"(t)); return t; }
__device__ __forceinline__ float bf2f(unsigned short u) { return __uint_as_float(((unsigned)u) << 16); }
__device__ __forceinline__ float bflo(unsigned u) { return __uint_as_float(u << 16); }
__device__ __forceinline__ float bfhi(unsigned u) { return __uint_as_float(u & 0xffff0000u); }
__device__ __forceinline__ unsigned pk_bf16(float lo, float hi) { unsigned r; asm("v_cvt_pk_bf16_f32 %0, %1, %2" : "=v"(r) : "v"(lo), "v"(hi)); return r; }
__device__ __forceinline__ void st_wt16(void* p, u32x4 v) { asm volatile("global_store_dwordx4 %0, %1, off sc1\n\ts_nop 1" :: "v"(p), "v"(v) : "memory"); }
__device__ __forceinline__ void st_wt16f_nc(void* p, f32x4 v) { asm volatile("global_store_dwordx4 %0, %1, off sc1\n\ts_nop 1" :: "v"(p), "v"(v)); }
__device__ __forceinline__ void st_wt8_nc(void* p, u32x2 v) { asm volatile("global_store_dwordx2 %0, %1, off sc1\n\ts_nop 1" :: "v"(p), "v"(v)); }
__device__ __forceinline__ float sigm(float x) { return __builtin_amdgcn_rcpf(1.0f + __expf(-x)); }
__device__ __forceinline__ float wave_sum(float v) {
#pragma unroll
    for (int o = 32; o > 0; o >>= 1) v += __shfl_xor(v, o);
    return v;
}
template <int CTRL> __device__ __forceinline__ float dppf(float x) {
    return __int_as_float(__builtin_amdgcn_update_dpp(0, __float_as_int(x), CTRL, 0xf, 0xf, true));
}
__device__ __forceinline__ float red16(float x) {
    x += dppf<0xB1>(x);
    x += dppf<0x4E>(x);
    x += dppf<0x141>(x);
    x += dppf<0x140>(x);
    return x;
}

__device__ __forceinline__ void conv_tile_w(char* wl, const float* __restrict__ src, int src_ld, int k0, int c0,
                                            bf16_t* __restrict__ dst, int dst_ld, int n0, const float* __restrict__ mu, int mode, const int lane) {
    float v[64];
    const float* s = src + (size_t)k0 * src_ld + c0 + lane;
#pragma unroll
    for (int i = 0; i < 64; ++i) v[i] = __builtin_nontemporal_load(s + (size_t)i * src_ld);
    if (mode) {
#pragma unroll
        for (int i = 0; i < 64; ++i) { const float m = mu[k0 + i]; v[i] *= (mode == 1) ? m : (1.0f - m); }
    }
#pragma unroll
    for (int q = 0; q < 8; ++q) {
        u32x4 o;
#pragma unroll
        for (int i = 0; i < 4; ++i) o[i] = pk_bf16(v[8 * q + 2 * i], v[8 * q + 2 * i + 1]);
        *(u32x4*)(wl + lane * 144 + q * 16) = o;
    }
    asm volatile("s_waitcnt lgkmcnt(0)" ::: "memory");
#pragma unroll
    for (int i = 0; i < 8; ++i) {
        const int id = i * 64 + lane, r = id >> 3, ch = id & 7;
        const u32x4 o = *(const u32x4*)(wl + r * 144 + ch * 16);
        st_wt16(dst + (size_t)(n0 + r) * dst_ld + k0 + ch * 8, o);
    }
    asm volatile("s_waitcnt lgkmcnt(0)" ::: "memory");
}

__device__ void phase_convert(char* shm) {
    KParams* kp = kargs();
    float* lds = (float*)shm;
    const int tid = tid_l(), lane = tid & 63, wave = __builtin_amdgcn_readfirstlane(tid >> 6);
    float* sc = lds;
    float* red = lds + 3072;
    for (int i = tid; i < 3072; i += NTHREADS) {
        const int mi = i >> 10, k = i & 1023;
        const float cv = (mi == 0) ? kp->in[4][k] : kp->in[2][(mi - 1) * 1024 + k];
        sc[i] = cv * sigm(cv);
    }
    __syncthreads();
    float* modp = (float*)(kp->ws + OFF_MOD);
    for (int task = blockIdx.x; task < 288; task += gridDim.x) {
        const int kh = task / 144, cgp = task % 144, col = cgp * 64 + lane;
        const int kb = kh * 512 + wave * 64;
        const float* wm = kp->in[5] + (size_t)kb * 9216 + col;
        float a0 = 0.f, a1 = 0.f, a2 = 0.f;
        float wv[64];
#pragma unroll
        for (int i = 0; i < 64; ++i) wv[i] = __builtin_nontemporal_load(wm + (size_t)i * 9216);
#pragma unroll
        for (int i = 0; i < 64; i += 4) {
            const f32x4 s0 = *(const f32x4*)(sc + kb + i), s1 = *(const f32x4*)(sc + 1024 + kb + i), s2 = *(const f32x4*)(sc + 2048 + kb + i);
#pragma unroll
            for (int j = 0; j < 4; ++j) { a0 += s0[j] * wv[i + j]; a1 += s1[j] * wv[i + j]; a2 += s2[j] * wv[i + j]; }
        }
        red[(wave * 3 + 0) * 64 + lane] = a0; red[(wave * 3 + 1) * 64 + lane] = a1; red[(wave * 3 + 2) * 64 + lane] = a2;
        __syncthreads();
        if (tid < 192) {
            const int m = tid >> 6, cc = tid & 63;
            float s = kh == 0 ? kp->in[6][cgp * 64 + cc] : 0.f;
#pragma unroll
            for (int g = 0; g < 8; ++g) s += red[(g * 3 + m) * 64 + cc];
            modp[(kh * 3 + m) * 9216 + cgp * 64 + cc] = s;
        }
        __syncthreads();
    }
}

constexpr int T_W13 = 88 * 16, T_W2 = 16 * 44, T_WIN = 88 * 16, T_LORA = 8 * 16, T_WAB = 16 * 8, T_WO = 16 * 16, T_L2 = 32;
constexpr int CV_TOTAL = 2 * T_W13 + 2 * T_W2 + T_WIN + T_LORA + 2 * T_WAB + T_WO + T_L2;
constexpr int CV_SET1 = T_W13 + T_W2 + 2 * T_WAB + T_WO, CV_SET0 = CV_TOTAL - CV_SET1;
__device__ void convert_tiles(char* shm, int set, int gw, int nw) {
    KParams* kp = kargs();
    const int tid = tid_l(), lane = tid & 63, wave = __builtin_amdgcn_readfirstlane(tid >> 6);
    char* wl = shm + 20480 + wave * (64 * 144);
    const int cnt = set ? CV_SET1 : CV_SET0;
    for (int n = gw; n < cnt; n += nw) {
        int id;
        if (set == 0) id = n < T_W13 ? n : (n < T_W13 + T_W2 ? n + T_W13 : (n < T_W13 + T_W2 + T_WIN + T_LORA ? n + T_W13 + T_W2 : n + T_W13 + T_W2 + 2 * T_WAB + T_WO));
        else id = n < T_W13 ? n + T_W13 : (n < T_W13 + T_W2 ? n + T_W13 + T_W2 : n + T_W13 + T_W2 + T_WIN + T_LORA);
        if (id < 2 * T_W13) {
            const int which = id / T_W13; id -= which * T_W13;
            const int nt = id >> 4, kt = id & 15, j = nt >> 2, w = nt & 3;
            const int c0 = (w < 2) ? (128 * j + 64 * w) : (2816 + 128 * j + 64 * (w - 2));
            conv_tile_w(wl, kp->in[which ? 10 : 8], 5632, kt * 64, c0, (bf16_t*)(kp->ws + (which ? OFF_W13B : OFF_W13A)), 1024, nt * 64, nullptr, 0, lane);
            continue;
        }
        id -= 2 * T_W13;
        if (id < 2 * T_W2) {
            const int which = id / T_W2; id -= which * T_W2;
            const int nt = id / 44, kt = id % 44;
            conv_tile_w(wl, kp->in[which ? 11 : 9], 1024, kt * 64, nt * 64, (bf16_t*)(kp->ws + (which ? OFF_W2B : OFF_W2A)), 2816, nt * 64, nullptr, 0, lane);
            continue;
        }
        id -= 2 * T_W2;
        if (id < T_WIN) {
            const int nt = id >> 4, kt = id & 15;
            conv_tile_w(wl, kp->in[12], 5632, kt * 64, nt * 64, (bf16_t*)(kp->ws + OFF_WIN), 1024, nt * 64, nullptr, 0, lane);
            continue;
        }
        id -= T_WIN;
        if (id < T_LORA) {
            const int nt = id >> 4, kt = id & 15;
            const int pq = nt & 1, l = (nt >> 1) & 1, d = nt >> 2;
            const float* src = kp->in[l ? 18 : 15] + (size_t)d * 1024 * 64;
            conv_tile_w(wl, src, 64, kt * 64, 0, (bf16_t*)(kp->ws + OFF_WIN), 1024, 5632 + nt * 64, kp->in[13] + (d * 2 + l) * 1024, pq ? 1 : 2, lane);
            continue;
        }
        id -= T_LORA;
        if (id < 2 * T_WAB) {
            const int which = id / T_WAB; id -= which * T_WAB;
            const int nt = id >> 3, kt = id & 7;
            conv_tile_w(wl, kp->in[which ? 28 : 27], 1024, kt * 64, nt * 64, (bf16_t*)(kp->ws + (which ? OFF_WB : OFF_WA)), 512, nt * 64, nullptr, 0, lane);
            continue;
        }
        id -= 2 * T_WAB;
        if (id < T_WO) {
            const int nt = id >> 4, kt = id & 15;
            conv_tile_w(wl, kp->in[29], 1024, kt * 64, nt * 64, (bf16_t*)(kp->ws + OFF_WO), 1024, nt * 64, nullptr, 0, lane);
            continue;
        }
        id -= T_WO;
        {
            const int dl = id >> 3, nt = id & 7, d = dl >> 1, l = dl & 1;
            const float* src = kp->in[l ? 19 : 16] + (size_t)d * 64 * 512;
            conv_tile_w(wl, src, 512, 0, nt * 64, (bf16_t*)(kp->ws + OFF_L2) + (size_t)dl * 512 * 64, 64, nt * 64, nullptr, 0, lane);
        }
    }
}

__device__ void phase_rowop(const float* __restrict__ xctx, const float* __restrict__ xlat, const bf16_t* __restrict__ P,
                            int gA, int mGate, float sA, float* __restrict__ xdst, int gB, int mShift, int mScale, bf16_t* __restrict__ hdst) {
    KParams* kp = kargs();
    const int tid = tid_l(), lane = tid & 63, wave = tid >> 6;
    const float* G = kp->in[7];
    const float* MOD = (const float*)(kp->ws + OFF_MOD);
    constexpr int RW = 4;
    for (int row0 = (blockIdx.x * 8 + wave) * RW; row0 < NTOK; row0 += gridDim.x * 8 * RW) {
        const int mi = row0 < NCTX ? 0 : 1 + ((row0 - NCTX) >> 11);
        const float* mod = MOD + mi * 9216;
        const float* xs = row0 < NCTX ? xctx + (size_t)row0 * DM : xlat + (size_t)(row0 - NCTX) * DM;
        f32x4 x[RW][4];
#pragma unroll
        for (int r = 0; r < RW; ++r)
#pragma unroll
            for (int i = 0; i < 4; ++i) x[r][i] = __builtin_nontemporal_load((const f32x4*)(xs + (size_t)r * DM + (i * 64 + lane) * 4));
        if (P) {
            u32x2 p0[RW][4], p1[RW][4];
#pragma unroll
            for (int r = 0; r < RW; ++r)
#pragma unroll
                for (int i = 0; i < 4; ++i) {
                    const size_t o = (size_t)(row0 + r) * DM + (i * 64 + lane) * 4;
                    p0[r][i] = __builtin_nontemporal_load((const u32x2*)(P + o)); p1[r][i] = __builtin_nontemporal_load((const u32x2*)(P + (size_t)NTOK * DM + o));
                }
            f32x4 gm[4];
#pragma unroll
            for (int i = 0; i < 4; ++i) {
                const int c = (i * 64 + lane) * 4;
                gm[i] = *(const f32x4*)(G + gA * DM + c) * (*(const f32x4*)(mod + mGate * DM + c) + *(const f32x4*)(mod + 27648 + mGate * DM + c));
            }
            float ss[RW];
#pragma unroll
            for (int r = 0; r < RW; ++r) {
                ss[r] = 0.f;
#pragma unroll
                for (int i = 0; i < 4; ++i) {
                    const f32x4 f = (f32x4){bflo(p0[r][i][0]) + bflo(p1[r][i][0]), bfhi(p0[r][i][0]) + bfhi(p1[r][i][0]), bflo(p0[r][i][1]) + bflo(p1[r][i][1]), bfhi(p0[r][i][1]) + bfhi(p1[r][i][1])};
                    ss[r] += f[0] * f[0] + f[1] * f[1] + f[2] * f[2] + f[3] * f[3];
                }
            }
#pragma unroll
            for (int o = 32; o > 0; o >>= 1) {
#pragma unroll
                for (int r = 0; r < RW; ++r) ss[r] += __shfl_xor(ss[r], o);
            }
#pragma unroll
            for (int r = 0; r < RW; ++r) {
                const float rstd = rsqrtf(ss[r] * (1.0f / DM) + 1e-6f) * sA;
#pragma unroll
                for (int i = 0; i < 4; ++i) {
                    const int c = (i * 64 + lane) * 4;
                    const f32x4 f = (f32x4){bflo(p0[r][i][0]) + bflo(p1[r][i][0]), bfhi(p0[r][i][0]) + bfhi(p1[r][i][0]), bflo(p0[r][i][1]) + bflo(p1[r][i][1]), bfhi(p0[r][i][1]) + bfhi(p1[r][i][1])};
                    x[r][i] += gm[i] * (f * rstd);
                    st_wt16f_nc(xdst + (size_t)(row0 + r) * DM + c, x[r][i]);
                }
            }
        }
        if (hdst) {
            f32x4 gs[4], sh[4];
#pragma unroll
            for (int i = 0; i < 4; ++i) {
                const int c = (i * 64 + lane) * 4;
                gs[i] = *(const f32x4*)(G + gB * DM + c) * (*(const f32x4*)(mod + mScale * DM + c) + *(const f32x4*)(mod + 27648 + mScale * DM + c) + 1.0f);
                sh[i] = *(const f32x4*)(mod + mShift * DM + c) + *(const f32x4*)(mod + 27648 + mShift * DM + c);
            }
            float ss[RW];
#pragma unroll
            for (int r = 0; r < RW; ++r) {
                ss[r] = 0.f;
#pragma unroll
                for (int i = 0; i < 4; ++i) ss[r] += x[r][i][0] * x[r][i][0] + x[r][i][1] * x[r][i][1] + x[r][i][2] * x[r][i][2] + x[r][i][3] * x[r][i][3];
            }
#pragma unroll
            for (int o = 32; o > 0; o >>= 1) {
#pragma unroll
                for (int r = 0; r < RW; ++r) ss[r] += __shfl_xor(ss[r], o);
            }
#pragma unroll
            for (int r = 0; r < RW; ++r) {
                const float rstd = rsqrtf(ss[r] * (1.0f / DM) + 1e-6f);
#pragma unroll
                for (int i = 0; i < 4; ++i) {
                    const int c = (i * 64 + lane) * 4;
                    const f32x4 h = (x[r][i] * rstd) * gs[i] + sh[i];
                    u32x2 o; o[0] = pk_bf16(h[0], h[1]); o[1] = pk_bf16(h[2], h[3]);
                    st_wt8_nc(hdst + (size_t)(row0 + r) * DM + c, o);
                }
            }
        }
    }
}

constexpr int BM = 256, BK = 64, HALF = 128, HT = HALF * BK;
__device__ __forceinline__ int lds_byte(int r, int c) {
    const int st = (r >> 4) * 2 + (c >> 5), rr = r & 15, cc = c & 31, ob = rr * 64 + cc * 2;
    return st * 1024 + (ob ^ (((ob >> 9) & 1) << 5));
}
__device__ __forceinline__ void stage_rc(int b, int& R, int& C) {
    const int st = b / 1024, sb = b % 1024, swz = sb ^ (((sb >> 9) & 1) << 5);
    R = (st >> 1) * 16 + swz / 64; C = (st & 1) * 32 + (swz % 64) / 2;
}
__device__ __forceinline__ void unit_map(int wgid, int nM, int nN, int& pm, int& pn) {
    const int NXCD = 8, WGM = 8, nwg = nM * nN;
    { const int q = nwg / NXCD, r = nwg % NXCD, xcd = wgid % NXCD, off = wgid / NXCD; wgid = (xcd < r ? xcd * (q + 1) : r * (q + 1) + (xcd - r) * q) + off; }
    const int nig = WGM * nN, gid = wgid / nig, fm = gid * WGM, gsz = min(nM - fm, WGM);
    pm = fm + ((wgid % nig) % gsz); pn = (wgid % nig) / gsz;
}

#define LAS __attribute__((address_space(3)))
constexpr int HTB = HALF * BK * 2;
__device__ __forceinline__ void gemm_tile(char* shmc, const bf16_t* __restrict__ A, int lda, const bf16_t* __restrict__ Bt, int ldb,
                                          int brow, int bcol, int nt, f32x4 (&acc)[2][2][4][2], const int tid) {
    LAS unsigned char* lds = (LAS unsigned char*)shmc;
    const int wid = __builtin_amdgcn_readfirstlane(tid >> 6), lane = tid & 63, wr = wid >> 2, wc = wid & 3, fr = lane & 15, fq = lane >> 4;
    unsigned voffA[2], voffB[2];
#pragma unroll
    for (int i = 0; i < 2; ++i) { int R, C; stage_rc(tid * 16 + i * 8192, R, C); voffA[i] = (unsigned)(R * lda + C) * 2u; voffB[i] = (unsigned)(R * ldb + C) * 2u; }
    const size_t kstep = (size_t)(BK * 2);
    const size_t hstepA = (size_t)HALF * lda * 2, hstepB = (size_t)HALF * ldb * 2;
    const unsigned ldsw = (unsigned)wid * 1024u;
    const int aoff = lds_byte(wr * 64 + fr, fq * 8), boff = lds_byte(wc * 32 + fr, fq * 8);
    const char* cA = (const char*)A + (size_t)brow * lda * 2;
    const char* cB = (const char*)Bt + (size_t)bcol * ldb * 2;
#define SA(b, h) (((b) * 2 + (h)) * HTB)
#define SB(b, h) ((4 + (b) * 2 + (h)) * HTB)
#define STAGE(bufoff, gbase, voff) do { _Pragma("unroll") for (int _i = 0; _i < 2; ++_i) \
    __builtin_amdgcn_global_load_lds((const unsigned*)((const char*)(gbase) + (voff)[_i]), (LAS unsigned*)(lds + (bufoff) + ldsw + _i * 8192), 16, 0, 0); } while (0)
#define LDA(dst, b, h) do { _Pragma("unroll") for (int m = 0; m < 4; ++m) _Pragma("unroll") for (int k = 0; k < 2; ++k) dst[m][k] = *(const LAS bf16x8*)(lds + SA(b, h) + aoff + m * 2048 + k * 1024); } while (0)
#define LDB(dst, b, h) do { _Pragma("unroll") for (int n = 0; n < 2; ++n) _Pragma("unroll") for (int k = 0; k < 2; ++k) dst[n][k] = *(const LAS bf16x8*)(lds + SB(b, h) + boff + n * 2048 + k * 1024); } while (0)
#define MMA(ai, bj, At_, Bt_) do { __builtin_amdgcn_s_setprio(1); _Pragma("unroll") for (int m = 0; m < 4; ++m) _Pragma("unroll") for (int n = 0; n < 2; ++n) _Pragma("unroll") for (int k = 0; k < 2; ++k) \
      acc[ai][bj][m][n] = __builtin_amdgcn_mfma_f32_16x16x32_bf16(Bt_[n][k], At_[m][k], acc[ai][bj][m][n], 0, 0, 0); \
    __builtin_amdgcn_s_setprio(0); } while (0)
#define WAIT_V(n) asm volatile("s_waitcnt vmcnt(" #n ")" ::: "memory")
#define WAIT_L(n) asm volatile("s_waitcnt lgkmcnt(" #n ")" ::: "memory")
#define BAR __builtin_amdgcn_s_barrier()
#define SCHED __builtin_amdgcn_sched_barrier(0)
#pragma unroll
    for (int a = 0; a < 2; ++a)
#pragma unroll
        for (int b = 0; b < 2; ++b)
#pragma unroll
            for (int m = 0; m < 4; ++m)
#pragma unroll
                for (int n = 0; n < 2; ++n) acc[a][b][m][n] = (f32x4){0.f, 0.f, 0.f, 0.f};
    bf16x8 At[4][2], B0[2][2], B1[2][2];
    STAGE(SB(0, 0), cB, voffB); STAGE(SA(0, 0), cA, voffA); STAGE(SB(0, 1), cB + hstepB, voffB); STAGE(SA(0, 1), cA + hstepA, voffA);
    if (wr == 1) BAR;
    WAIT_V(4); BAR;
    STAGE(SB(1, 0), cB + kstep, voffB); STAGE(SA(1, 0), cA + kstep, voffA); STAGE(SB(1, 1), cB + hstepB + kstep, voffB);
    WAIT_V(6); BAR;
    for (int t = 0; t < nt - 2; t += 2) {
        const char* a1 = cA + (size_t)(t + 1) * kstep;
        const char* a2 = cA + (size_t)(t + 2) * kstep; const char* b2 = cB + (size_t)(t + 2) * kstep;
        const char* a3 = a2 + kstep; const char* b3 = b2 + kstep;
        LDB(B0, 0, 0); SCHED; LDA(At, 0, 0); STAGE(SA(1, 1), a1 + hstepA, voffA);
        WAIT_L(8); BAR; WAIT_L(0); MMA(0, 0, At, B0); BAR; SCHED;
        LDB(B1, 0, 1); STAGE(SB(0, 0), b2, voffB);
        BAR; WAIT_L(0); MMA(0, 1, At, B1); BAR;
        LDA(At, 0, 1); STAGE(SA(0, 0), a2, voffA);
        BAR; WAIT_L(0); MMA(1, 0, At, B0); BAR; SCHED;
        STAGE(SB(0, 1), b2 + hstepB, voffB);
        WAIT_V(6); BAR; MMA(1, 1, At, B1); BAR;
        LDB(B0, 1, 0); SCHED; LDA(At, 1, 0); STAGE(SA(0, 1), a2 + hstepA, voffA);
        WAIT_L(8); BAR; WAIT_L(0); MMA(0, 0, At, B0); BAR; SCHED;
        LDB(B1, 1, 1); STAGE(SB(1, 0), b3, voffB);
        BAR; WAIT_L(0); MMA(0, 1, At, B1); BAR;
        LDA(At, 1, 1); STAGE(SA(1, 0), a3, voffA);
        BAR; WAIT_L(0); MMA(1, 0, At, B0); BAR; SCHED;
        STAGE(SB(1, 1), b3 + hstepB, voffB);
        WAIT_V(6); BAR; MMA(1, 1, At, B1); BAR;
    }
    { const char* a1 = cA + (size_t)(nt - 1) * kstep;
      LDB(B0, 0, 0); LDA(At, 0, 0); STAGE(SA(1, 1), a1 + hstepA, voffA);
      BAR; WAIT_L(0); MMA(0, 0, At, B0); BAR;
      LDB(B1, 0, 1); BAR; WAIT_L(0); MMA(0, 1, At, B1); BAR;
      LDA(At, 0, 1); WAIT_V(4); BAR; WAIT_L(0); MMA(1, 0, At, B0); MMA(1, 1, At, B1); BAR; }
    { LDB(B0, 1, 0); LDA(At, 1, 0); WAIT_V(2); BAR; WAIT_L(0); MMA(0, 0, At, B0); BAR;
      LDB(B1, 1, 1); WAIT_V(0); BAR; WAIT_L(0); MMA(0, 1, At, B1); BAR;
      LDA(At, 1, 1); BAR; WAIT_L(0); MMA(1, 0, At, B0); MMA(1, 1, At, B1); BAR; }
    if (wr == 0) BAR;
#undef SA
#undef SB
#undef STAGE
#undef LDA
#undef LDB
#undef MMA
}

struct GemmJob {
    const bf16_t* A0; const bf16_t* A1; const bf16_t* Bt0; const bf16_t* Bt1;
    int lda, ldb, nN, nsplit, nt, kstride, mode, pad;
    void* o1; void* o2; const bf16_t* Z;
};
__device__ void phase_gemm(char* shm, const GemmJob& J) {
    const int tid = tid_l();
    const int wid = __builtin_amdgcn_readfirstlane(tid >> 6), wr = wid >> 2, wc = wid & 3;
    const int nM = 32, nN = J.nN, nMN = nM * nN;
    const int mode = J.mode;
    for (int u = blockIdx.x; u < nMN * J.nsplit; u += gridDim.x) {
        const int ks = u / nMN;
        int pm, pn; unit_map(u - ks * nMN, nM, nN, pm, pn);
        {
            const int sub = ks;
            f32x4 acc[2][2][4][2];
            const size_t koff = (size_t)ks * J.kstride;
            gemm_tile(shm, (ks ? J.A1 : J.A0) + koff, J.lda, (ks ? J.Bt1 : J.Bt0) + koff, J.ldb, pm * BM, pn * BM, J.nt, acc, tid);
            int lane_e = tid & 63; asm volatile("" : "+v"(lane_e));
            const int fr = lane_e & 15, fq = lane_e >> 4;
            const int NBJ = (mode == 0) ? 1 : 2;
            const int W8 = NBJ * 16;
            const int pitch = NBJ * 256 + 32;
            bf16_t* obase; int old_, col0;
            if (mode == 0)      { obase = (bf16_t*)J.o1; old_ = DFF; col0 = pn * 128; }
            else if (mode == 1) { obase = (bf16_t*)J.o1 + (size_t)ks * NTOK * DM; old_ = DM; col0 = pn * BM; }
            else if (mode == 2) { obase = (bf16_t*)J.o1; old_ = ZLD; col0 = pn * BM; }
            else                { obase = (bf16_t*)(sub ? J.o2 : J.o1); old_ = DM; col0 = pn * BM; }
            const bf16_t* Zg = J.Z + (sub ? 4608 : 3584);
#pragma unroll
            for (int ai = 0; ai < 2; ++ai) {
#pragma unroll
                for (int m = 0; m < 4; ++m) {
                    const int rloc = wr * 64 + m * 16 + fr;
                    const int row = pm * BM + ai * HALF + rloc;
#pragma unroll
                    for (int n = 0; n < 2; ++n) {
                        if (mode == 0) {
                            const f32x4 g = acc[ai][0][m][n], up = acc[ai][1][m][n];
                            float o[4];
#pragma unroll
                            for (int j = 0; j < 4; ++j) o[j] = g[j] * sigm(g[j]) * up[j];
                            u32x2 v; v[0] = pk_bf16(o[0], o[1]); v[1] = pk_bf16(o[2], o[3]);
                            *(u32x2*)(shm + rloc * pitch + (wc * 32 + n * 16 + fq * 4) * 2) = v;
                        } else {
#pragma unroll
                            for (int bj = 0; bj < 2; ++bj) {
                                const int cl = bj * HALF + wc * 32 + n * 16 + fq * 4;
                                f32x4 a = acc[ai][bj][m][n];
                                if (mode == 3) {
                                    const u32x2 gz = *(const u32x2*)(Zg + (size_t)row * ZLD + col0 + cl);
                                    a[0] *= sigm(bflo(gz[0])); a[1] *= sigm(bfhi(gz[0])); a[2] *= sigm(bflo(gz[1])); a[3] *= sigm(bfhi(gz[1]));
                                }
                                u32x2 v; v[0] = pk_bf16(a[0], a[1]); v[1] = pk_bf16(a[2], a[3]);
                                *(u32x2*)(shm + rloc * pitch + cl * 2) = v;
                            }
                        }
                    }
                }
                __syncthreads();
                const int w8sh = (mode == 0) ? 4 : 5;
                for (int c = tid; c < 128 * W8; c += NTHREADS) {
                    const int r = c >> w8sh, cc = c & (W8 - 1);
                    const u32x4 v = *(const u32x4*)(shm + r * pitch + cc * 16);
                    st_wt16(obase + (size_t)(pm * BM + ai * HALF + r) * old_ + col0 + cc * 8, v);
                }
                __syncthreads();
            }
        }
    }
}

__device__ void phase_prep(char* shm) {
    KParams* kp = kargs();
    const int tid = tid_l(), lane = tid & 63, wave = tid >> 6, fr = lane & 15, fq = lane >> 4;
    float* wt = (float*)shm + wave * (16 * 68);
    const bf16_t* Z = (const bf16_t*)(kp->ws + OFF_R1);
    const bf16_t* L2T = (const bf16_t*)(kp->ws + OFF_L2);
    bf16_t* KK = (bf16_t*)(kp->ws + OFF_R2 + R2_KK);
    float* WD = (float*)(kp->ws + OFF_R2 + R2_WD);
    bf16_t* KD = (bf16_t*)(kp->ws + OFF_R2 + R2_KD);
    bf16_t* BB = (bf16_t*)(kp->ws + OFF_R2 + R2_BB);
    float* BONUS = (float*)(kp->ws + OFF_BONUS);
    for (int unit = blockIdx.x * 8 + wave; unit < 2048; unit += gridDim.x * 8) {
        const int hq = unit & 1, d = (unit >> 1) & 1, tg = unit >> 2;
        const int row = tg * 16 + fr;
        const bool lat = row >= NCTX;
        const int pos = lat ? ((row - NCTX) & 2047) : (row & 255);
        const int T = lat ? 2048 : 256;
        const bool valid = d == 0 ? (pos > 0) : (pos < T - 1);
        const int srow = valid ? (d == 0 ? row - 1 : row + 1) : row;
        bf16x8 Bz[2][2];
#pragma unroll
        for (int l = 0; l < 2; ++l)
#pragma unroll
            for (int ks = 0; ks < 2; ++ks) {
                const int k = ks * 32 + fq * 8;
                const u32x4 Pv = *(const u32x4*)(Z + (size_t)row * ZLD + 5632 + ((d * 2 + l) * 2 + 0) * 64 + k);
                u32x4 Qv = *(const u32x4*)(Z + (size_t)srow * ZLD + 5632 + ((d * 2 + l) * 2 + 1) * 64 + k);
                if (!valid) Qv = (u32x4){0u, 0u, 0u, 0u};
                u32x4 o;
#pragma unroll
                for (int i = 0; i < 4; ++i) {
                    float z0 = bflo(Pv[i]) + bflo(Qv[i]), z1 = bfhi(Pv[i]) + bfhi(Qv[i]);
                    if (l == 0) {
                        z0 = 1.0f - 2.0f * __builtin_amdgcn_rcpf(__expf(2.0f * z0) + 1.0f);
                        z1 = 1.0f - 2.0f * __builtin_amdgcn_rcpf(__expf(2.0f * z1) + 1.0f);
                    }
                    o[i] = pk_bf16(z0, z1);
                }
                Bz[l][ks] = __builtin_bit_cast(bf16x8, o);
            }
        for (int hh = hq * 4; hh < hq * 4 + 4; ++hh) {
            f32x4 accw[4], acca[4];
#pragma unroll
            for (int mt = 0; mt < 4; ++mt) {
                accw[mt] = (f32x4){0.f, 0.f, 0.f, 0.f}; acca[mt] = (f32x4){0.f, 0.f, 0.f, 0.f};
#pragma unroll
                for (int ks = 0; ks < 2; ++ks) {
                    const bf16x8 Aw = *(const bf16x8*)(L2T + ((size_t)(d * 2 + 0) * 512 + hh * 64 + mt * 16 + fr) * 64 + ks * 32 + fq * 8);
                    const bf16x8 Aa = *(const bf16x8*)(L2T + ((size_t)(d * 2 + 1) * 512 + hh * 64 + mt * 16 + fr) * 64 + ks * 32 + fq * 8);
                    accw[mt] = __builtin_amdgcn_mfma_f32_16x16x32_bf16(Aw, Bz[0][ks], accw[mt], 0, 0, 0);
                    acca[mt] = __builtin_amdgcn_mfma_f32_16x16x32_bf16(Aa, Bz[1][ks], acca[mt], 0, 0, 0);
                }
            }
            float ss = 0.f, bon = 0.f;
            f32x4 kkr[4], kd[4];
#pragma unroll
            for (int mt = 0; mt < 4; ++mt) {
                const int c = hh * 64 + mt * 16 + fq * 4;
                const f32x4 w0 = *(const f32x4*)(kp->in[14] + d * 512 + c), a0 = *(const f32x4*)(kp->in[17] + d * 512 + c);
                const f32x4 kkp = *(const f32x4*)(kp->in[20] + c), kap = *(const f32x4*)(kp->in[21] + c), rkp = *(const f32x4*)(kp->in[22] + c);
                const u32x2 kz = *(const u32x2*)(Z + (size_t)row * ZLD + 512 + c), rz = *(const u32x2*)(Z + (size_t)row * ZLD + c);
                const float kv[4] = {bflo(kz[0]), bfhi(kz[0]), bflo(kz[1]), bfhi(kz[1])};
                const float rv[4] = {bflo(rz[0]), bfhi(rz[0]), bflo(rz[1]), bfhi(rz[1])};
#pragma unroll
                for (int j = 0; j < 4; ++j) {
                    const float xw = accw[mt][j] + w0[j];
                    accw[mt][j] = __expf(-0.60653065971f * sigm(xw));
                    const float a = sigm(acca[mt][j] + a0[j]);
                    acca[mt][j] = a;
                    const float kr = kv[j] * kkp[j];
                    kkr[mt][j] = kr; ss += kr * kr;
                    const float kdd = kv[j] * (1.0f + (a - 1.0f) * kap[j]);
                    kd[mt][j] = kdd;
                    bon += rv[j] * kdd * rkp[j];
                }
            }
            ss += __shfl_xor(ss, 16); ss += __shfl_xor(ss, 32);
            bon += __shfl_xor(bon, 16); bon += __shfl_xor(bon, 32);
            const float inv = rsqrtf(ss + 1e-12f);
            const int row0 = tg * 16;
#pragma unroll
            for (int pass = 0; pass < 4; ++pass) {
                if (pass == 3 && d != 0) break;
#pragma unroll
                for (int mt = 0; mt < 4; ++mt) {
                    f32x4 val;
                    if (pass == 0) val = accw[mt];
                    else if (pass == 1) val = kd[mt];
                    else if (pass == 2) val = kkr[mt] * inv * acca[mt];
                    else val = kkr[mt] * inv;
                    *(f32x4*)(wt + fr * 68 + mt * 16 + fq * 4) = val;
                }
                asm volatile("s_waitcnt lgkmcnt(0)" ::: "memory");
#pragma unroll
                for (int i = 0; i < 4; ++i) {
                    const int id = i * 64 + lane, tk = id >> 4, c4 = (id & 15) * 4;
                    const f32x4 val = *(const f32x4*)(wt + tk * 68 + c4);
                    const size_t o = ((size_t)d * NTOK + row0 + tk) * DR + hh * 64 + c4;
                    if (pass == 0) *(f32x4*)(WD + o) = val;
                    else {
                        u32x2 v; v[0] = pk_bf16(val[0], val[1]); v[1] = pk_bf16(val[2], val[3]);
                        if (pass == 1) *(u32x2*)(KD + o) = v;
                        else if (pass == 2) *(u32x2*)(BB + o) = v;
                        else *(u32x2*)(KK + (size_t)(row0 + tk) * DR + hh * 64 + c4) = v;
                    }
                }
                asm volatile("s_waitcnt lgkmcnt(0)" ::: "memory");
            }
            if (fq == 0) BONUS[((size_t)d * NTOK + row) * 8 + hh] = bon;
        }
    }
}

__device__ __forceinline__ float red16x4(float p0, float p1, float p2, float p3, const bool b0, const bool b1) {
    const float own01 = b0 ? p1 : p0, snd01 = b0 ? p0 : p1;
    const float own23 = b0 ? p3 : p2, snd23 = b0 ? p2 : p3;
    const float r01 = own01 + dppf<0xB1>(snd01);
    const float r23 = own23 + dppf<0xB1>(snd23);
    const float own = b1 ? r23 : r01, snd = b1 ? r01 : r23;
    float r = own + dppf<0x4E>(snd);
    r += dppf<0x124>(r);
    r += dppf<0x128>(r);
    return r;
}
constexpr int TC = 32, STEP_F = 352;
typedef float f32x2 __attribute__((ext_vector_type(2)));
constexpr int SCAN_IN_F = TC * STEP_F;
constexpr int SCAN_Y_OFF = 2 * SCAN_IN_F;
constexpr int SCAN_VT_OFF = SCAN_Y_OFF + 2 * TC * 32;
struct ChunkDesc { int base, T, d, h, rq, c, b; bool first, last; };
template <bool LAT> __device__ __forceinline__ ChunkDesc chunk_desc(int slot, int g) {
    ChunkDesc q;
    if (LAT) {
        const int chain = slot >> 2; q.rq = slot & 3; q.b = chain >> 4; q.h = (chain >> 1) & 7; q.d = chain & 1;
        q.T = 2048; q.base = NCTX + q.b * 2048; q.c = g; q.first = g == 0; q.last = false;
    } else {
        const int u = slot * 4 + (g >> 3), chain = u >> 1; q.rq = u & 1; q.b = chain >> 4; q.h = (chain >> 1) & 7; q.d = chain & 1;
        q.T = 256; q.base = q.b * 256; q.c = g & 7; q.first = q.c == 0; q.last = q.c == 7;
    }
    return q;
}
__device__ __forceinline__ void st4(float* dst, unsigned a, unsigned b) {
    *(f32x4*)dst = (f32x4){bflo(a), bfhi(a), bflo(b), bfhi(b)};
}
struct LReg { u32x4 r8, k8, kk8, b8, v8; f32x4 w0, w1; };

template <bool LAT> __device__ __forceinline__ void scan_pass(char* shm, const int tid, const int slot) {
    constexpr int NSW = 4, RPL = LAT ? 1 : 2, RB = NSW * 4 * RPL, NCH = LAT ? 64 : 32;
    KParams* kp = kargs();
    float* lds = (float*)shm;
    const int wave = __builtin_amdgcn_readfirstlane(tid >> 6), lane = tid & 63;
    const bf16_t* Z = (const bf16_t*)(kp->ws + OFF_R1);
    const bf16_t* KK = (const bf16_t*)(kp->ws + OFF_R2 + R2_KK);
    const float* WD = (const float*)(kp->ws + OFF_R2 + R2_WD);
    const bf16_t* KD = (const bf16_t*)(kp->ws + OFF_R2 + R2_KD);
    const bf16_t* BB = (const bf16_t*)(kp->ws + OFF_R2 + R2_BB);
    bf16_t* Y = (bf16_t*)(kp->ws + OFF_H);
    float* OST = kp->out + (size_t)NTOK * DM;
    const float* ST0 = kp->in[3];
    {
        if (wave >= 4) {
            const int lt = tid - 256, s = lt >> 3, cg8 = (lt & 7) * 8;
            constexpr int NV = TC * RB / 8;
            LReg R;
            auto ld_chunk = [&](int g) {
                const ChunkDesc q = chunk_desc<LAT>(slot, g);
                const int tt = q.c * TC + s, t = q.d ? q.T - 1 - tt : tt, row = q.base + t;
                const int ch = q.h * 64 + cg8;
                const size_t od = ((size_t)q.d * NTOK + row) * DR + ch;
                R.r8 = *(const u32x4*)(Z + (size_t)row * ZLD + ch);
                R.w0 = *(const f32x4*)(WD + od); R.w1 = *(const f32x4*)(WD + od + 4);
                R.k8 = *(const u32x4*)(KD + od);
                R.kk8 = *(const u32x4*)(KK + (size_t)row * DR + ch);
                R.b8 = *(const u32x4*)(BB + od);
                if (lt < NV) {
                    const int s2 = lt / (RB / 8), hf = lt % (RB / 8);
                    const int tt2 = q.c * TC + s2, t2 = q.d ? q.T - 1 - tt2 : tt2, row2 = q.base + t2;
                    R.v8 = *(const u32x4*)(Z + (size_t)row2 * ZLD + 1024 + q.h * 64 + q.rq * RB + hf * 8);
                }
            };
            ld_chunk(0);
            for (int g = -1; g <= NCH; ++g) {
                if (g + 1 <= NCH - 1) {
                    float* buf = lds + ((g + 1) & 1) * SCAN_IN_F;
                    float* L = buf + s * STEP_F + cg8;
                    st4(L, R.r8[0], R.r8[1]); st4(L + 4, R.r8[2], R.r8[3]);
                    *(f32x4*)(L + 64) = R.w0; *(f32x4*)(L + 68) = R.w1;
                    st4(L + 128, R.k8[0], R.k8[1]); st4(L + 132, R.k8[2], R.k8[3]);
                    st4(L + 192, R.kk8[0], R.kk8[1]); st4(L + 196, R.kk8[2], R.kk8[3]);
                    st4(L + 256, R.b8[0], R.b8[1]); st4(L + 260, R.b8[2], R.b8[3]);
                    if (lt < NV) {
                        const int s2 = lt / (RB / 8), hf = lt % (RB / 8);
                        float* Vt = lds + SCAN_VT_OFF + ((g + 1) & 1) * (32 * TC) + (hf * 8) * TC + s2;
#pragma unroll
                        for (int i = 0; i < 4; ++i) { Vt[(2 * i) * TC] = bflo(R.v8[i]); Vt[(2 * i + 1) * TC] = bfhi(R.v8[i]); }
                    }
                }
                if (g + 2 <= NCH - 1) ld_chunk(g + 2);
                if (g >= 1) {
                    const ChunkDesc q = chunk_desc<LAT>(slot, g - 1);
                    const float* yb = lds + SCAN_Y_OFF + ((g - 1) & 1) * (TC * RB);
#pragma unroll
                    for (int i = lt; i < TC * RB / 2; i += 256) {
                        const int sy = i / (RB / 2), r2 = (i % (RB / 2)) * 2;
                        const int tt = q.c * TC + sy, t = q.d ? q.T - 1 - tt : tt, row = q.base + t;
                        const f32x2 yv = *(const f32x2*)(yb + sy * RB + r2);
                        *(unsigned*)(Y + ((size_t)q.d * NTOK + row) * DR + q.h * 64 + q.rq * RB + r2) = pk_bf16(yv[0], yv[1]);
                    }
                }
                __syncthreads();
            }
        } else if (wave < NSW) {
            const int rl = lane >> 4, qq = lane & 15;
            f32x2 Sa[RPL], Sb[RPL];
#pragma unroll
            for (int j = 0; j < RPL; ++j) { Sa[j] = (f32x2){0.f, 0.f}; Sb[j] = (f32x2){0.f, 0.f}; }
            __syncthreads();
            for (int g = 0; g <= NCH - 1; ++g) {
                const ChunkDesc q = chunk_desc<LAT>(slot, g);
                const float* buf = lds + (g & 1) * SCAN_IN_F;
                const int rloc = wave * RPL * 4 + rl;
                float* yb = lds + SCAN_Y_OFF + (g & 1) * (TC * RB) + rloc;
                if (q.first) {
#pragma unroll
                    for (int j = 0; j < RPL; ++j) {
                        if (LAT) {
                            const int irow = q.rq * RB + rloc + 4 * j;
                            const f32x4 s = *(const f32x4*)(ST0 + ((size_t)((q.b * 2 + q.d) * 8 + q.h) * 64 + irow) * 64 + qq * 4);
                            Sa[j] = (f32x2){s[0], s[1]}; Sb[j] = (f32x2){s[2], s[3]};
                        } else { Sa[j] = (f32x2){0.f, 0.f}; Sb[j] = (f32x2){0.f, 0.f}; }
                    }
                }
                const float* Lq = buf + qq * 4;
                const float* Lv = lds + SCAN_VT_OFF + (g & 1) * (32 * TC) + rloc * TC;
                f32x4 r4 = *(const f32x4*)(Lq), w4 = *(const f32x4*)(Lq + 64), k4 = *(const f32x4*)(Lq + 128), n4 = *(const f32x4*)(Lq + 192), b4 = *(const f32x4*)(Lq + 256);
                f32x4 r4n = *(const f32x4*)(Lq + STEP_F), w4n = *(const f32x4*)(Lq + STEP_F + 64), k4n = *(const f32x4*)(Lq + STEP_F + 128), n4n = *(const f32x4*)(Lq + STEP_F + 192), b4n = *(const f32x4*)(Lq + STEP_F + 256);
                f32x4 v4[RPL], v4n[RPL], v4m[RPL];
                float yp[RPL][4];
                const bool qb0 = (qq & 1) != 0, qb1 = (qq & 2) != 0;
                float* ybq = yb + (qq & 3) * RB;
#pragma unroll
                for (int j = 0; j < RPL; ++j) { v4[j] = *(const f32x4*)(Lv + 4 * j * TC); v4n[j] = *(const f32x4*)(Lv + 4 * j * TC + 4); }
#pragma unroll
                for (int s = 0; s < TC; ++s) {
                    const int s2 = (s + 2 < TC) ? s + 2 : TC - 1;
                    const float* Ln = Lq + s2 * STEP_F;
                    const f32x4 r4m = *(const f32x4*)(Ln), w4m = *(const f32x4*)(Ln + 64), k4m = *(const f32x4*)(Ln + 128), n4m = *(const f32x4*)(Ln + 192), b4m = *(const f32x4*)(Ln + 256);
                    if ((s & 3) == 0) {
                        const int sg = (s + 8 < TC) ? s + 8 : TC - 4;
#pragma unroll
                        for (int j = 0; j < RPL; ++j) v4m[j] = *(const f32x4*)(Lv + 4 * j * TC + sg);
                    }
#pragma unroll
                    for (int j = 0; j < RPL; ++j) {
                        f32x2 pp = Sa[j] * (f32x2){n4[0], n4[1]};
                        pp = Sb[j] * (f32x2){n4[2], n4[3]} + pp;
                        float pd = pp[0] + pp[1];
                        const float vj = v4[j][s & 3];
                        const f32x2 vv = {vj, vj};
                        f32x2 Ta = (f32x2){k4[0], k4[1]} * vv, Tb = (f32x2){k4[2], k4[3]} * vv;
                        Ta = Sa[j] * (f32x2){w4[0], w4[1]} + Ta; Tb = Sb[j] * (f32x2){w4[2], w4[3]} + Tb;
                        pd = red16(pd);
                        const f32x2 np = {-pd, -pd};
                        Sa[j] = (f32x2){b4[0], b4[1]} * np + Ta; Sb[j] = (f32x2){b4[2], b4[3]} * np + Tb;
                        f32x2 yy = Sa[j] * (f32x2){r4[0], r4[1]};
                        yy = Sb[j] * (f32x2){r4[2], r4[3]} + yy;
                        yp[j][s & 3] = yy[0] + yy[1];
                        if ((s & 3) == 3) ybq[(s - 3) * RB + 4 * j] = red16x4(yp[j][0], yp[j][1], yp[j][2], yp[j][3], qb0, qb1);
                    }
                    r4 = r4n; w4 = w4n; k4 = k4n; n4 = n4n; b4 = b4n;
                    r4n = r4m; w4n = w4m; k4n = k4m; n4n = n4m; b4n = b4m;
#pragma unroll
                    for (int j = 0; j < RPL; ++j) { if ((s & 3) == 3) { v4[j] = v4n[j]; v4n[j] = v4m[j]; } }
                }
                if (!LAT && q.last) {
#pragma unroll
                    for (int j = 0; j < RPL; ++j) {
                        const int irow = q.rq * RB + rloc + 4 * j;
                        *(f32x4*)(OST + ((size_t)((q.b * 2 + q.d) * 8 + q.h) * 64 + irow) * 64 + qq * 4) = (f32x4){Sa[j][0], Sa[j][1], Sb[j][0], Sb[j][1]};
                    }
                }
                __syncthreads();
            }
            __syncthreads();
        } else {
            for (int g = -1; g <= NCH; ++g) __syncthreads();
        }
    }
}
__device__ void phase_scan(char* shm) {
    const int tid = tid_l();
    for (int slot = blockIdx.x; slot < 256; slot += gridDim.x) {
        if (slot < 128) scan_pass<true>(shm, tid, slot);
        else scan_pass<false>(shm, tid, slot - 128);
        __syncthreads();
    }
}

__device__ void phase_post() {
    KParams* kp = kargs();
    const int tid = tid_l(), lane = tid & 63, wave = tid >> 6;
    const bf16_t* Z = (const bf16_t*)(kp->ws + OFF_R1);
    const bf16_t* Y = (const bf16_t*)(kp->ws + OFF_H);
    const float* BONUS = (const float*)(kp->ws + OFF_BONUS);
    bf16_t* YA = (bf16_t*)(kp->ws + OFF_R2 + R2_YA);
    bf16_t* YB = (bf16_t*)(kp->ws + OFF_R2 + R2_YB);
    const int c = lane * 8, head = lane >> 3;
    for (int row = blockIdx.x * 8 + wave; row < NTOK; row += gridDim.x * 8) {
        const u32x4 y0 = *(const u32x4*)(Y + (size_t)row * DR + c), y1 = *(const u32x4*)(Y + ((size_t)NTOK + row) * DR + c);
        float y[8];
#pragma unroll
        for (int i = 0; i < 4; ++i) { y[2 * i] = bflo(y0[i]) + bflo(y1[i]); y[2 * i + 1] = bfhi(y0[i]) + bfhi(y1[i]); }
        float s = 0.f;
#pragma unroll
        for (int i = 0; i < 8; ++i) s += y[i];
        s += __shfl_xor(s, 1); s += __shfl_xor(s, 2); s += __shfl_xor(s, 4);
        const float mean = s * (1.0f / 64.0f);
        float vs = 0.f;
#pragma unroll
        for (int i = 0; i < 8; ++i) { y[i] -= mean; vs += y[i] * y[i]; }
        vs += __shfl_xor(vs, 1); vs += __shfl_xor(vs, 2); vs += __shfl_xor(vs, 4);
        const float rs = rsqrtf(vs * (1.0f / 64.0f) + 64e-5f);
        const float bon = BONUS[(size_t)row * 8 + head] + BONUS[((size_t)NTOK + row) * 8 + head];
        const u32x4 vz = *(const u32x4*)(Z + (size_t)row * ZLD + 1024 + c), gz = *(const u32x4*)(Z + (size_t)row * ZLD + 1536 + c);
        const f32x4 gn0 = *(const f32x4*)(kp->in[23] + c), gn1 = *(const f32x4*)(kp->in[23] + c + 4);
        const f32x4 gb0 = *(const f32x4*)(kp->in[24] + c), gb1 = *(const f32x4*)(kp->in[24] + c + 4);
        float o[8];
#pragma unroll
        for (int i = 0; i < 8; ++i) {
            const float vv = (i & 1) ? bfhi(vz[i >> 1]) : bflo(vz[i >> 1]);
            const float gg = (i & 1) ? bfhi(gz[i >> 1]) : bflo(gz[i >> 1]);
            const float gain = i < 4 ? gn0[i & 3] : gn1[i & 3], bias = i < 4 ? gb0[i & 3] : gb1[i & 3];
            o[i] = (y[i] * rs * gain + bias + bon * vv) * sigm(gg);
        }
        u32x4 ov;
#pragma unroll
        for (int i = 0; i < 4; ++i) ov[i] = pk_bf16(o[2 * i], o[2 * i + 1]);
        *(u32x4*)(YA + (size_t)row * DR + c) = ov;
    }
}

__device__ void phase_convb(int gw, int nw) {
    KParams* kp = kargs();
    const int tid = tid_l(), lane = tid & 63;
    const bf16_t* Z = (const bf16_t*)(kp->ws + OFF_R1);
    bf16_t* YB = (bf16_t*)(kp->ws + OFF_YB2);
    const int c = lane * 8;
    for (int row = gw; row < NTOK; row += nw) {
        float o[8]; u32x4 ov;
        const bool lat = row >= NCTX;
        const int pos = lat ? ((row - NCTX) & 63) : (row & 255);
        const int last = lat ? 63 : 255;
        const bool vl = pos > 0, vr = pos < last;
        const int rl = vl ? row - 1 : row, rr = vr ? row + 1 : row;
        const u32x4 ccm = *(const u32x4*)(Z + (size_t)row * ZLD + 2560 + c), xcm = *(const u32x4*)(Z + (size_t)row * ZLD + 3072 + c);
        const u32x4 ccl = *(const u32x4*)(Z + (size_t)rl * ZLD + 2560 + c), xcl = *(const u32x4*)(Z + (size_t)rl * ZLD + 3072 + c);
        const u32x4 ccr = *(const u32x4*)(Z + (size_t)rr * ZLD + 2560 + c), xcr = *(const u32x4*)(Z + (size_t)rr * ZLD + 3072 + c);
        const u32x4 cbz = *(const u32x4*)(Z + (size_t)row * ZLD + 2048 + c);
        const float fl = vl ? 1.f : 0.f, frr = vr ? 1.f : 0.f;
#pragma unroll
        for (int i = 0; i < 8; ++i) {
            const int w = i >> 1; const bool hi = i & 1;
            const float um = (hi ? bfhi(ccm[w]) : bflo(ccm[w])) * (hi ? bfhi(xcm[w]) : bflo(xcm[w]));
            const float ul = (hi ? bfhi(ccl[w]) : bflo(ccl[w])) * (hi ? bfhi(xcl[w]) : bflo(xcl[w])) * fl;
            const float ur = (hi ? bfhi(ccr[w]) : bflo(ccr[w])) * (hi ? bfhi(xcr[w]) : bflo(xcr[w])) * frr;
            const float cb = hi ? bfhi(cbz[w]) : bflo(cbz[w]);
            const float cv = ul * kp->in[25][c + i] + um * kp->in[25][512 + c + i] + ur * kp->in[25][1024 + c + i] + kp->in[26][c + i];
            o[i] = cb * cv;
        }
#pragma unroll
        for (int i = 0; i < 4; ++i) ov[i] = pk_bf16(o[2 * i], o[2 * i + 1]);
        *(u32x4*)(YB + (size_t)row * DR + c) = ov;
    }
}

#define XB_TMO      128
#define XB_XCNT(j)  (256  + 64 * (j))
#define XB_XSUB(j)  (1280 + 64 * (j))
#define XB_XGEN(j)  (2304 + 64 * (j))
#define XB_TOP      3328
#define XB_TOPGEN   3392
#define XCD_BAR_WORDS 3456
#define XB_SPIN_CAP (1u << 18)
#define XLAS __attribute__((address_space(3)))
__device__ __forceinline__ unsigned xb_ld(unsigned* p)              { return __hip_atomic_load(p, __ATOMIC_RELAXED, __HIP_MEMORY_SCOPE_AGENT); }
__device__ __forceinline__ unsigned xb_add(unsigned* p, unsigned v) { return __hip_atomic_fetch_add(p, v, __ATOMIC_RELAXED, __HIP_MEMORY_SCOPE_AGENT); }
__device__ __forceinline__ unsigned xb_xcc_id() { return (unsigned)__builtin_amdgcn_s_getreg((3 << 11) | 20) & 0xFu; }
#define XB_SPIN(cond, bar) do { unsigned _sp = 0; while (cond) { __builtin_amdgcn_s_sleep(1); \
    if ((++_sp & 255u) == 0u) { if (xb_ld(&(bar)[XB_TMO])) break; if (_sp > XB_SPIN_CAP) { atomicAdd(&(bar)[XB_TMO], 1u); break; } } } } while (0)
struct XcdBarrier { unsigned* bar; unsigned x; volatile XLAS unsigned* st; };
__device__ __forceinline__ XcdBarrier xcd_barrier_post(unsigned* bar, volatile XLAS unsigned* st) {
    XcdBarrier b; b.bar = bar; b.x = xb_xcc_id(); b.st = st;
    if (threadIdx.x == 0) (void)xb_add(&bar[XB_XCNT(b.x)], 1u);
    return b;
}
__device__ __forceinline__ void xcd_barrier_complete(unsigned* bar, unsigned x, unsigned& nloc, unsigned& nx) {
    const unsigned G = gridDim.x * gridDim.y * gridDim.z;
    unsigned sum, cnt, mine, sp = 0u;
    for (;;) {
        sum = 0u; cnt = 0u; mine = 0u;
#pragma unroll
        for (unsigned j = 0; j < 16; ++j) { const unsigned c = xb_ld(&bar[XB_XCNT(j)]); sum += c; cnt += (c > 0u) ? 1u : 0u; mine = (j == x) ? c : mine; }
        if (sum == G) break;
        __builtin_amdgcn_s_sleep(1);
        if ((++sp & 255u) == 0u) { if (xb_ld(&bar[XB_TMO])) break; if (sp > XB_SPIN_CAP) { atomicAdd(&bar[XB_TMO], 1u); break; } }
    }
    nloc = mine > 0u ? mine : 1u; nx = cnt > 0u ? cnt : 1u;
}
__device__ __forceinline__ void xcd_barrier(const XcdBarrier& b) {
    asm volatile("s_waitcnt vmcnt(0)" ::: "memory");
    __syncthreads();
    if (threadIdx.x == 0) {
        unsigned* bar = b.bar;
        __builtin_amdgcn_s_waitcnt(0);
        unsigned nloc = b.st[0], nx = b.st[1];
        if (nloc == 0u) { xcd_barrier_complete(bar, b.x, nloc, nx); b.st[0] = nloc; b.st[1] = nx; }
        const unsigned old = xb_add(&bar[XB_XSUB(b.x)], 1u);
        const unsigned gen = old / nloc;
        if (old + 1u == (gen + 1u) * nloc) {
            __builtin_amdgcn_fence(__ATOMIC_RELEASE, "agent");
            asm volatile("s_waitcnt vmcnt(0)" ::: "memory");
            const unsigned og = xb_add(&bar[XB_TOP], 1u);
            const unsigned tg = og / nx;
            if (og + 1u == (tg + 1u) * nx) xb_add(&bar[XB_TOPGEN], 1u);
            else XB_SPIN(xb_ld(&bar[XB_TOPGEN]) == tg, bar);
            __builtin_amdgcn_fence(__ATOMIC_ACQUIRE, "agent");
            xb_add(&bar[XB_XGEN(b.x)], 1u);
            asm volatile("s_waitcnt vmcnt(0)" ::: "memory");
        } else {
            XB_SPIN(xb_ld(&bar[XB_XGEN(b.x)]) == gen, bar);
            __builtin_amdgcn_fence(__ATOMIC_ACQUIRE, "agent");
            asm volatile("s_waitcnt vmcnt(0)" ::: "memory");
        }
    }
    __syncthreads();
}

struct RowJob { const float* xc; const float* xl; const bf16_t* P; float* xdst; bf16_t* hdst; int gA, mGate, gB, mShift, mScale; float sA; };

__global__ void __launch_bounds__(NTHREADS) fwd_megakernel(Params p) {
    extern __shared__ __attribute__((aligned(16))) char shm[];
    volatile XLAS unsigned* st = (volatile XLAS unsigned*)((XLAS unsigned char*)shm + LDS_STAGE);
    if (threadIdx.x < 4) st[threadIdx.x] = 0u;
    __syncthreads();
    const XcdBarrier xb = xcd_barrier_post((unsigned*)(kargs()->ws + OFF_BAR), st);
    const int ph_lo = kargs()->phase_lo, ph_hi = kargs()->phase_hi;
    for (int ph = ph_lo; ph < ph_hi; ++ph) {
        KParams* kp0 = kargs();
        char* ws = kp0->ws;
        bf16_t* H = (bf16_t*)(ws + OFF_H);
        bf16_t* R1 = (bf16_t*)(ws + OFF_R1);
        float* R2f = (float*)(ws + OFF_R2);
        float* out = kp0->out;
        const float* xlat_out = out + (size_t)NCTX * DM;
        int kind = 0;
        int cv_set = -1, cv_first = 0;
        RowJob R{}; GemmJob J{};
        switch (ph) {
        case 1: kind = 1; R = RowJob{kargs()->in[0], kargs()->in[1], nullptr, nullptr, H, 0, 0, 0, 0, 1, 0.f}; break;
        case 4: kind = 1; R = RowJob{kargs()->in[0], kargs()->in[1], (const bf16_t*)R2f, out, H, 1, 2, 2, 3, 4, 0.5f}; break;
        case 11: kind = 1; R = RowJob{out, xlat_out, (const bf16_t*)R1, out, H, 3, 5, 4, 6, 7, 1.0f}; break;
        case 14: kind = 1; R = RowJob{out, xlat_out, (const bf16_t*)R2f, out, nullptr, 5, 8, 0, 0, 0, 0.5f}; break;
        case 2: case 12: kind = 2;
            J.A0 = J.A1 = H; J.Bt0 = J.Bt1 = (const bf16_t*)(ws + (ph == 2 ? OFF_W13A : OFF_W13B)); J.lda = DM; J.ldb = DM; J.nN = 22; J.nsplit = 1; J.nt = DM / BK; J.kstride = 0; J.mode = 0; J.o1 = R1; break;
        case 3: case 13: kind = 2;
            J.A0 = J.A1 = R1; J.Bt0 = J.Bt1 = (const bf16_t*)(ws + (ph == 3 ? OFF_W2A : OFF_W2B)); J.lda = DFF; J.ldb = DFF; J.nN = 4; J.nsplit = 2; J.nt = 22; J.kstride = 22 * BK; J.mode = 1; J.o1 = R2f; break;
        case 5: kind = 2;
            J.A0 = J.A1 = H; J.Bt0 = J.Bt1 = (const bf16_t*)(ws + OFF_WIN); J.lda = DM; J.ldb = DM; J.nN = 24; J.nsplit = 1; J.nt = DM / BK; J.kstride = 0; J.mode = 2; J.o1 = R1; break;
        case 9: kind = 2;
            J.A0 = (const bf16_t*)(ws + OFF_R2 + R2_YA); J.A1 = (const bf16_t*)(ws + OFF_YB2); J.Bt0 = (const bf16_t*)(ws + OFF_WA); J.Bt1 = (const bf16_t*)(ws + OFF_WB);
            J.lda = DR; J.ldb = DR; J.nN = 4; J.nsplit = 2; J.nt = DR / BK; J.kstride = 0; J.mode = 3; J.o1 = ws + OFF_R2 + R2_GA; J.o2 = ws + OFF_R2 + R2_GB; J.Z = R1; break;
        case 10: kind = 2;
            J.A0 = (const bf16_t*)(ws + OFF_R2 + R2_GA); J.A1 = (const bf16_t*)(ws + OFF_R2 + R2_GB); J.Bt0 = J.Bt1 = (const bf16_t*)(ws + OFF_WO); J.lda = DM; J.ldb = DM; J.nN = 4; J.nsplit = 2; J.nt = DM / BK; J.kstride = 0; J.mode = 1; J.o1 = R1; break;
        default: break;
        }
        for (int rep = 0; rep <= ((REPEAT_MASK >> ph) & 1); ++rep) {
        if (rep) xcd_barrier(xb);
        if (kind == 1) phase_rowop(R.xc, R.xl, R.P, R.gA, R.mGate, R.sA, R.xdst, R.gB, R.mShift, R.mScale, R.hdst);
        else if (kind == 2) phase_gemm(shm, J);
        else if (ph == 0) { phase_convert(shm); cv_set = 0; cv_first = 0; }
        else if (ph == 6) phase_prep(shm);
        else if (ph == 7) { phase_scan(shm); cv_set = 1; cv_first = ((int)gridDim.x == 256) ? 128 : 0; }
        else if (ph == 8) phase_post();
        }
        if (cv_set >= 0 && (int)blockIdx.x >= cv_first)
            convert_tiles(shm, cv_set, ((int)blockIdx.x - cv_first) * 8 + (int)(threadIdx.x >> 6), ((int)gridDim.x - cv_first) * 8);
        if (ph == 7 && (int)blockIdx.x >= cv_first)
            phase_convb(((int)blockIdx.x - cv_first) * 8 + (int)(threadIdx.x >> 6), ((int)gridDim.x - cv_first) * 8);
        if (ph + 1 < ph_hi) xcd_barrier(xb);
    }
}

extern "C" void kernel_launch(void* const* d_in, const int* in_sizes, int n_in, void* d_out, int out_size, void* d_ws, size_t ws_size, hipStream_t stream) {
    static int grid_blocks = 0;
    if (grid_blocks == 0) {
        if (ws_size < WS_END) { fprintf(stderr, "kernel_launch: workspace too small: %zu < %zu\n", ws_size, (size_t)WS_END); grid_blocks = -1; return; }
        int dev = 0, cus = 0, per_cu = 0;
        hipGetDevice(&dev);
        hipDeviceGetAttribute(&cus, hipDeviceAttributeMultiprocessorCount, dev);
        if (hipFuncSetAttribute((const void*)fwd_megakernel, hipFuncAttributeMaxDynamicSharedMemorySize, LDS_BYTES) != hipSuccess) { fprintf(stderr, "hipFuncSetAttribute failed\n"); grid_blocks = -1; return; }
        hipOccupancyMaxActiveBlocksPerMultiprocessor(&per_cu, (const void*)fwd_megakernel, NTHREADS, LDS_BYTES);
        if (per_cu < 1) { fprintf(stderr, "occupancy query says %d\n", per_cu); per_cu = 1; }
        if (per_cu > 1) per_cu = 1;
        grid_blocks = cus * per_cu;
    }
    if (grid_blocks < 0) return;
    Params p{};
    for (int i = 0; i < 30; ++i) p.in[i] = (const float*)d_in[i];
    p.out = (float*)d_out; p.ws = (char*)d_ws; p.phase_lo = 0; p.phase_hi = 15;
    if (hipMemsetAsync((char*)d_ws + OFF_BAR, 0, 16384, stream) != hipSuccess) { fprintf(stderr, "memset of barrier words failed\n"); return; }
    void* args[] = {&p};
    hipError_t e = hipLaunchCooperativeKernel((const void*)fwd_megakernel, dim3(grid_blocks), dim3(NTHREADS), args, LDS_BYTES, stream);
    if (e != hipSuccess) fprintf(stderr, "cooperative launch failed: %s (grid %d)\n", hipGetErrorString(e), grid_blocks);
}
```
